# Optimizing an MI355X kernel written in HIP

```python
import math
import jax, jax.numpy as jnp
from jax import lax
import numpy as np

D_MODEL = 1024
BATCH = 8
SEQ = 4096
DEPTH = 2

HEAD_DIM = 64
A_GROUPS = ((128, 1), (512, 4), (2048, 16))
A_HEADS_PER_GROUP = 4
A_N_GROUPS = len(A_GROUPS)
A_WIDTH = A_N_GROUPS * A_HEADS_PER_GROUP * HEAD_DIM
A_OUT = A_HEADS_PER_GROUP * HEAD_DIM
BLK = 128
B_CHUNK = 128
B_GROUPS = 4
B_WIDTH = 512
B_GROUP_DIM = B_WIDTH // B_GROUPS
C_WINDOWS = (2, 4, 8, 16)
C_GROUPS = len(C_WINDOWS)
C_WIDTH = 512
C_GROUP_DIM = C_WIDTH // C_GROUPS
N_BRANCH = 3
D_FF = 2816
EPS = 1e-6

Q_OFF = 0
K_OFF = Q_OFF + A_WIDTH
V_OFF = K_OFF + A_WIDTH
UB_OFF = V_OFF + A_WIDTH
VB_OFF = UB_OFF + B_WIDTH
C_OFF = VB_OFF + B_WIDTH
G_OFF = C_OFF + C_WIDTH
IN_WIDTH = G_OFF + N_BRANCH * D_MODEL

kernel_name = "hybrid_dilated_gmlp_pool_macaron"


def rms_norm(x, g):
    xf = x.astype(jnp.float32)
    y = xf * lax.rsqrt(jnp.mean(xf * xf, axis=-1, keepdims=True) + EPS)
    return (y * g.astype(jnp.float32)).astype(x.dtype)


def layer_norm(x, g, b):
    xf = x.astype(jnp.float32)
    mu = jnp.mean(xf, axis=-1, keepdims=True)
    xc = xf - mu
    y = xc * lax.rsqrt(jnp.mean(xc * xc, axis=-1, keepdims=True) + EPS)
    return (y * g.astype(jnp.float32) + b.astype(jnp.float32)).astype(x.dtype)


def swiglu(h, w_gate, w_up, w_down):
    return (jax.nn.silu(h @ w_gate) * (h @ w_up)) @ w_down


def dilated_window_attention(q, k, v, window, dil):
    Bn, S, H, Dh = q.shape
    span = window // dil
    unit = dil * BLK
    S_pad = -(-S // unit) * unit
    L = S_pad // dil
    nb = L // BLK

    def to_strided(t):
        t = jnp.pad(t, ((0, 0), (0, S_pad - S), (0, 0), (0, 0)))
        t = t.reshape(Bn, L, dil, H, Dh).transpose(0, 2, 3, 1, 4)
        return t.reshape(Bn, dil, H, nb, BLK, Dh)

    qs, ks, vs = to_strided(q), to_strided(k), to_strided(v)
    prev = lambda t: jnp.pad(t, ((0, 0), (0, 0), (0, 0), (1, 0), (0, 0), (0, 0)))[:, :, :, :-1]
    kb = jnp.concatenate([prev(ks), ks], axis=4)
    vb = jnp.concatenate([prev(vs), vs], axis=4)

    qi = jnp.arange(BLK)[:, None] + BLK
    kj = jnp.arange(2 * BLK)[None, :]
    dist = qi - kj
    band = (dist >= 0) & (dist <= span)
    blk = jnp.arange(nb)[:, None, None]
    valid = band[None] & ~((blk == 0) & (kj[None] < BLK))

    scale = 1.0 / math.sqrt(Dh)
    s = jnp.einsum('brhnqc,brhnkc->brhnqk', qs, kb,
                   preferred_element_type=jnp.float32) * scale
    s = jnp.where(valid, s, -1e30)
    m = jnp.max(s, axis=-1, keepdims=True)
    p = jnp.exp(s - m)
    l = jnp.sum(p, axis=-1, keepdims=True)
    o = jnp.einsum('brhnqk,brhnkc->brhnqc', p, vb.astype(jnp.float32)) / l
    lse = (m + jnp.log(l))[..., 0]

    o = o.reshape(Bn, dil, H, L, Dh).transpose(0, 3, 1, 2, 4).reshape(Bn, S_pad, H, Dh)[:, :S]
    lse = lse.reshape(Bn, dil, H, L).transpose(0, 3, 1, 2).reshape(Bn, S_pad, H)[:, :S]
    return o, lse


def dilated_attention_mixture(q, k, v):
    outs, lses = [], []
    for g, (window, dil) in enumerate(A_GROUPS):
        o, lse = dilated_window_attention(q[:, :, g], k[:, :, g], v[:, :, g], window, dil)
        outs.append(o)
        lses.append(lse)
    w = jax.nn.softmax(jnp.stack(lses, axis=0), axis=0)
    o = jnp.sum(w[..., None] * jnp.stack(outs, axis=0), axis=0)
    Bn, S = o.shape[:2]
    return o.reshape(Bn, S, A_OUT).astype(q.dtype)


def spatial_gating(u, v, w_s, b_s, ln_g, ln_b):
    v = layer_norm(v, ln_g, ln_b)
    Bn, S, _ = v.shape
    nc = S // B_CHUNK
    vc = v.reshape(Bn, nc, B_CHUNK, B_GROUPS, B_GROUP_DIM)
    causal = jnp.tril(jnp.ones((B_CHUNK, B_CHUNK), dtype=bool))
    w = jnp.where(causal[None], w_s, 0.0).astype(v.dtype)
    mixed = jnp.einsum('gts,bnsgc->bntgc', w, vc) + b_s.T[None, None, :, :, None]
    return u * mixed.reshape(Bn, S, B_WIDTH)


def multiscale_pool(xc, w_c, scale_c):
    Bn, S, _ = xc.shape
    xg = xc.reshape(Bn, S, C_GROUPS, C_GROUP_DIM).astype(jnp.float32)
    cs = jnp.cumsum(xg, axis=1)
    t1 = jnp.arange(1, S + 1, dtype=jnp.float32)
    pooled = []
    for gi, w in enumerate(C_WINDOWS):
        c = cs[:, :, gi]
        shifted = jnp.pad(c, ((0, 0), (w, 0), (0, 0)))[:, :S]
        cnt = jnp.minimum(t1, float(w))[None, :, None]
        pooled.append((c - shifted) / cnt - xg[:, :, gi])
    pooled = jnp.stack(pooled, axis=2)
    y = jnp.einsum('bsgc,gcd->bsgd', pooled, w_c.astype(jnp.float32)) * scale_c.astype(jnp.float32)
    return y.reshape(Bn, S, C_WIDTH).astype(xc.dtype)


def setup_inputs(seed: int = 0) -> dict:
    key = jax.random.key(seed)
    ks = jax.random.split(key, 32)
    f32 = jnp.float32
    nrm = lambda k, shape, fan_in: jax.random.normal(k, shape, f32) * (fan_in ** -0.5)
    gain = lambda k, shape: 1.0 + 0.05 * jax.random.normal(k, shape, f32)
    small = lambda k, shape: 0.01 * jax.random.normal(k, shape, f32)
    L = DEPTH
    return {
        "x": jax.random.normal(ks[0], (BATCH, SEQ, D_MODEL), f32),
        "ffn1_norm": gain(ks[1], (L, D_MODEL)),
        "ffn1_w_gate": nrm(ks[2], (L, D_MODEL, D_FF), D_MODEL),
        "ffn1_w_up": nrm(ks[3], (L, D_MODEL, D_FF), D_MODEL),
        "ffn1_w_down": nrm(ks[4], (L, D_FF, D_MODEL), D_FF),
        "mix_norm": gain(ks[5], (L, D_MODEL)),
        "w_in": nrm(ks[6], (L, D_MODEL, IN_WIDTH), D_MODEL),
        "b_gate": small(ks[7], (L, N_BRANCH * D_MODEL)),
        "b_ln_g": gain(ks[8], (L, B_WIDTH)),
        "b_ln_b": small(ks[9], (L, B_WIDTH)),
        "b_w_s": nrm(ks[10], (L, B_GROUPS, B_CHUNK, B_CHUNK), B_CHUNK),
        "b_b_s": gain(ks[11], (L, B_GROUPS, B_CHUNK)),
        "c_w": nrm(ks[12], (L, C_GROUPS, C_GROUP_DIM, C_GROUP_DIM), C_GROUP_DIM),
        "c_scale": gain(ks[13], (L, C_GROUPS, C_GROUP_DIM)),
        "w_proj_a": nrm(ks[14], (L, A_OUT, D_MODEL), A_OUT),
        "w_proj_b": nrm(ks[15], (L, B_WIDTH, D_MODEL), B_WIDTH),
        "w_proj_c": nrm(ks[16], (L, C_WIDTH, D_MODEL), C_WIDTH),
        "w_out": nrm(ks[17], (L, D_MODEL, D_MODEL), D_MODEL),
        "ffn2_norm": gain(ks[18], (L, D_MODEL)),
        "ffn2_w_gate": nrm(ks[19], (L, D_MODEL, D_FF), D_MODEL),
        "ffn2_w_up": nrm(ks[20], (L, D_MODEL, D_FF), D_MODEL),
        "ffn2_w_down": nrm(ks[21], (L, D_FF, D_MODEL), D_FF),
        "final_norm": gain(ks[22], (D_MODEL,)),
    }


def reference(x, ffn1_norm, ffn1_w_gate, ffn1_w_up, ffn1_w_down, mix_norm, w_in, b_gate,
              b_ln_g, b_ln_b, b_w_s, b_b_s, c_w, c_scale, w_proj_a, w_proj_b, w_proj_c,
              w_out, ffn2_norm, ffn2_w_gate, ffn2_w_up, ffn2_w_down, final_norm):
    Bn, S, D = x.shape
    for i in range(DEPTH):
        x = x + 0.5 * swiglu(rms_norm(x, ffn1_norm[i]), ffn1_w_gate[i], ffn1_w_up[i], ffn1_w_down[i])

        h = rms_norm(x, mix_norm[i])
        z = h @ w_in[i]
        qkv_shape = (Bn, S, A_N_GROUPS, A_HEADS_PER_GROUP, HEAD_DIM)
        q = z[..., Q_OFF:K_OFF].reshape(qkv_shape)
        k = z[..., K_OFF:V_OFF].reshape(qkv_shape)
        v = z[..., V_OFF:UB_OFF].reshape(qkv_shape)
        y_a = dilated_attention_mixture(q, k, v)

        uv = jax.nn.gelu(z[..., UB_OFF:C_OFF], approximate=False)
        y_b = spatial_gating(uv[..., :B_WIDTH], uv[..., B_WIDTH:], b_w_s[i], b_b_s[i],
                             b_ln_g[i], b_ln_b[i])

        y_c = multiscale_pool(z[..., C_OFF:G_OFF], c_w[i], c_scale[i])

        gates = jax.nn.sigmoid(z[..., G_OFF:] + b_gate[i]).reshape(Bn, S, N_BRANCH, D)
        merged = (gates[:, :, 0] * (y_a @ w_proj_a[i])
                  + gates[:, :, 1] * (y_b @ w_proj_b[i])
                  + gates[:, :, 2] * (y_c @ w_proj_c[i]))
        x = x + merged @ w_out[i]

        x = x + 0.5 * swiglu(rms_norm(x, ffn2_norm[i]), ffn2_w_gate[i], ffn2_w_up[i], ffn2_w_down[i])
    return rms_norm(x, final_norm)
```

```cpp
#include <hip/hip_runtime.h>
#include <hip/hip_cooperative_groups.h>
#include <cstdio>
#include <cstdint>
namespace pg8 {
#define PG8_LAS __attribute__((address_space(3)))
typedef unsigned short bf16_t;
typedef short bf16x8 __attribute__((ext_vector_type(8)));
typedef float f32x4 __attribute__((ext_vector_type(4)));
typedef unsigned u32x4 __attribute__((ext_vector_type(4)));
constexpr int BM = 256, BK = 64, HALF = 128, HTB = HALF * BK * 2  , STAGE_BYTES = 8 * HTB, NXCD = 8, WGM = 8;

__host__ __device__ __forceinline__ int lds_byte(int r, int c) { const int st = (r >> 4) * 2 + (c >> 5), rr = r & 15, cc = c & 31, ob = rr * 64 + cc * 2; return st * 1024 + (ob ^ (((ob >> 9) & 1) << 5)); }
__host__ __device__ __forceinline__ void stage_rc(int b, int& R, int& C) { const int st = b / 1024, sb = b % 1024, swz = sb ^ (((sb >> 9) & 1) << 5); R = (st >> 1) * 16 + swz / 64; C = (st & 1) * 32 + (swz % 64) / 2; }
__host__ __device__ __forceinline__ int perm32(int rho) { const int n = rho >> 4, i = rho & 15; return 8 * (i >> 2) + 4 * n + (i & 3); }

struct Unit { int pm, pn; };
struct Gemm { const bf16_t* A; const bf16_t* Bt; int M, N, K; };

struct StaticOrder {
    int nM, nN, nwg, G, c;
    __host__ __device__ void init(int M, int N, int G_, int c_) { nM = M / BM; nN = N / BM; nwg = nM * nN; G = G_; c = c_; }
    __host__ __device__ bool next(int i, Unit& u) const {
        const long L = (long)i * G + c; if (L >= nwg) return false;
        int wgid = (int)L; { const int q = nwg / NXCD, r = nwg % NXCD, xcd = wgid % NXCD, off = wgid / NXCD; wgid = (xcd < r ? xcd * (q + 1) : r * (q + 1) + (xcd - r) * q) + off; }
        const int nig = WGM * nN, gid = wgid / nig, fm = gid * WGM, gsz = (nM - fm) < WGM ? (nM - fm) : WGM;
        u.pm = fm + ((wgid % nig) % gsz); u.pn = (wgid % nig) / gsz; return true;
    }
    __device__ __forceinline__ void a_ready(const Unit&) const {}
    __device__ __forceinline__ void done(const Unit&) const {}
};

typedef float f32x2 __attribute__((ext_vector_type(2)));
typedef __bf16 bf16x2_c __attribute__((ext_vector_type(2)));
__device__ __forceinline__ unsigned cvt_pk_bf16(float lo, float hi) { const f32x2 v = {lo, hi}; const bf16x2_c b = __builtin_convertvector(v, bf16x2_c); return __builtin_bit_cast(unsigned, b); }
__device__ __forceinline__ f32x2 gelu_pk(f32x2 v) {
    const f32x2 av = __builtin_elementwise_abs(v), d = av * 0.2316418882f + 1.0f;
    f32x2 t; t.x = __builtin_amdgcn_rcpf(d.x); t.y = __builtin_amdgcn_rcpf(d.y);
    f32x2 q = t * 0.5307027145f + (-0.7265760135f); q = q * t + 0.7107068705f; q = q * t + (-0.142248368f); q = q * t + 0.127414796f; q = q * t;
    const f32x2 s = (v * v) * (-0.72134752044f);
    f32x2 e; e.x = __builtin_amdgcn_exp2f(s.x); e.y = __builtin_amdgcn_exp2f(s.y);
    const f32x2 m = v * (q * e), r = v - m;
    f32x2 o; o.x = v.x < 0.f ? m.x : r.x; o.y = v.y < 0.f ? m.y : r.y; return o;
}
typedef unsigned u32x2 __attribute__((ext_vector_type(2)));
__device__ __forceinline__ float bf_lo(unsigned u) { return __uint_as_float(u << 16); }
__device__ __forceinline__ float bf_hi(unsigned u) { return __uint_as_float(u & 0xffff0000u); }
__device__ __forceinline__ float sigmoidf_(float v) { return __builtin_amdgcn_rcpf(1.0f + __expf(-v)); }
constexpr float RMS_EPS = 1e-6f;
enum { EM_SWIGLU = 0, EM_RESID = 1, EM_Z1 = 2, EM_GATE = 3, EM_PROJ0 = 4, EM_PROJ1 = 5 };
struct EpiMix {
    static constexpr bool PERM = true, AFTER_DRAIN = false;
    int mode;
    float* rs;
    const void* aux;
    float* xout;
    bf16_t* ob; int ldo;
    __device__ __forceinline__ void operator()(const f32x4 (&acc)[2][2][4][2], const Unit& u, int wr, int wc, int fr, int fq) const {
        const int row0 = u.pm * BM + wr * 64 + fr;
        const int cw = wc * 32 + 8 * fq;
        const float* rowss = rs; float* rowss_out = rs; const float* xin = (const float*)aux; const float* bias = (const float*)aux; const bf16_t* gate = (const bf16_t*)aux;
        if (mode == EM_SWIGLU) {
#pragma unroll
            for (int ai = 0; ai < 2; ++ai)
#pragma unroll
                for (int m = 0; m < 4; ++m) {
                    const int r = row0 + ai * HALF + m * 16;
                    const float rs = rsqrtf(rowss[r] * (1.0f / 1024.0f) + RMS_EPS);
                    float h[8];
#pragma unroll
                    for (int n = 0; n < 2; ++n)
#pragma unroll
                        for (int e = 0; e < 4; ++e) { const float g = acc[ai][0][m][n][e] * rs, up = acc[ai][1][m][n][e] * rs; h[n * 4 + e] = g * sigmoidf_(g) * up; }
                    u32x4 w; w.x = cvt_pk_bf16(h[0], h[1]); w.y = cvt_pk_bf16(h[2], h[3]); w.z = cvt_pk_bf16(h[4], h[5]); w.w = cvt_pk_bf16(h[6], h[7]);
                    *(u32x4*)(ob + (size_t)r * ldo + u.pn * HALF + cw) = w;
                }
        } else if (mode == EM_RESID) {
#pragma unroll
            for (int ai = 0; ai < 2; ++ai)
#pragma unroll
                for (int m = 0; m < 4; ++m) {
                    const int r = row0 + ai * HALF + m * 16; float ss = 0.f;
#pragma unroll
                    for (int bj = 0; bj < 2; ++bj) {
                        const size_t off = (size_t)r * 1024 + u.pn * BM + bj * HALF + cw;
                        const f32x4 x0 = *(const f32x4*)(xin + off), x1 = *(const f32x4*)(xin + off + 4);
                        const f32x4 v0 = x0 + acc[ai][bj][m][0], v1 = x1 + acc[ai][bj][m][1];
                        *(f32x4*)(xout + off) = v0; *(f32x4*)(xout + off + 4) = v1;
                        u32x4 w; w.x = cvt_pk_bf16(v0[0], v0[1]); w.y = cvt_pk_bf16(v0[2], v0[3]); w.z = cvt_pk_bf16(v1[0], v1[1]); w.w = cvt_pk_bf16(v1[2], v1[3]);
                        *(u32x4*)(ob + off) = w;
                        ss += (v0[0] * v0[0] + v0[1] * v0[1]) + (v0[2] * v0[2] + v0[3] * v0[3]) + (v1[0] * v1[0] + v1[1] * v1[1]) + (v1[2] * v1[2] + v1[3] * v1[3]);
                    }
                    ss += __shfl_xor(ss, 16); ss += __shfl_xor(ss, 32);
                    if (fq == 0) unsafeAtomicAdd(rowss_out + r, ss);
                }
        } else if (mode == EM_Z1) {
            const float sc = (u.pn < 3) ? 0.125f : 1.0f; const bool act = (u.pn >= 9 && u.pn <= 12);
#pragma unroll
            for (int ai = 0; ai < 2; ++ai)
#pragma unroll
                for (int m = 0; m < 4; ++m) {
                    const int r = row0 + ai * HALF + m * 16;
                    const float rs = rsqrtf(rowss[r] * (1.0f / 1024.0f) + RMS_EPS) * sc;
#pragma unroll
                    for (int bj = 0; bj < 2; ++bj) {
                        f32x4 v0 = acc[ai][bj][m][0] * rs, v1 = acc[ai][bj][m][1] * rs;
                        if (act) { const f32x2 a = gelu_pk((f32x2){v0[0], v0[1]}), b = gelu_pk((f32x2){v0[2], v0[3]}), c = gelu_pk((f32x2){v1[0], v1[1]}), d = gelu_pk((f32x2){v1[2], v1[3]});
                            v0 = (f32x4){a.x, a.y, b.x, b.y}; v1 = (f32x4){c.x, c.y, d.x, d.y}; }
                        u32x4 w; w.x = cvt_pk_bf16(v0[0], v0[1]); w.y = cvt_pk_bf16(v0[2], v0[3]); w.z = cvt_pk_bf16(v1[0], v1[1]); w.w = cvt_pk_bf16(v1[2], v1[3]);
                        *(u32x4*)(ob + (size_t)r * ldo + u.pn * BM + bj * HALF + cw) = w;
                    }
                }
        } else if (mode == EM_GATE) {
#pragma unroll
            for (int ai = 0; ai < 2; ++ai)
#pragma unroll
                for (int m = 0; m < 4; ++m) {
                    const int r = row0 + ai * HALF + m * 16;
                    const float rs = rsqrtf(rowss[r] * (1.0f / 1024.0f) + RMS_EPS);
#pragma unroll
                    for (int bj = 0; bj < 2; ++bj) {
                        const int c = u.pn * BM + bj * HALF + cw;
                        const f32x4 b0 = *(const f32x4*)(bias + c), b1 = *(const f32x4*)(bias + c + 4);
                        const f32x4 v0 = acc[ai][bj][m][0] * rs + b0, v1 = acc[ai][bj][m][1] * rs + b1;
                        u32x4 w; w.x = cvt_pk_bf16(sigmoidf_(v0[0]), sigmoidf_(v0[1])); w.y = cvt_pk_bf16(sigmoidf_(v0[2]), sigmoidf_(v0[3]));
                        w.z = cvt_pk_bf16(sigmoidf_(v1[0]), sigmoidf_(v1[1])); w.w = cvt_pk_bf16(sigmoidf_(v1[2]), sigmoidf_(v1[3]));
                        *(u32x4*)(ob + (size_t)r * ldo + c) = w;
                    }
                }
        } else {
            const bool accum = (mode == EM_PROJ1);
#pragma unroll
            for (int ai = 0; ai < 2; ++ai)
#pragma unroll
                for (int m = 0; m < 4; ++m) {
                    const int r = row0 + ai * HALF + m * 16;
#pragma unroll
                    for (int bj = 0; bj < 2; ++bj) {
                        const int c = u.pn * BM + bj * HALF + cw;
                        const u32x4 gv = *(const u32x4*)(gate + (size_t)r * 3072 + c);
                        bf16_t* op = ob + (size_t)r * 1024 + c;
                        u32x4 old = (u32x4){0u, 0u, 0u, 0u}; if (accum) old = *(const u32x4*)op;
                        const f32x4 a0 = acc[ai][bj][m][0], a1 = acc[ai][bj][m][1];
                        u32x4 w;
                        w.x = cvt_pk_bf16(bf_lo(old.x) + bf_lo(gv.x) * a0[0], bf_hi(old.x) + bf_hi(gv.x) * a0[1]);
                        w.y = cvt_pk_bf16(bf_lo(old.y) + bf_lo(gv.y) * a0[2], bf_hi(old.y) + bf_hi(gv.y) * a0[3]);
                        w.z = cvt_pk_bf16(bf_lo(old.z) + bf_lo(gv.z) * a1[0], bf_hi(old.z) + bf_hi(gv.z) * a1[1]);
                        w.w = cvt_pk_bf16(bf_lo(old.w) + bf_lo(gv.w) * a1[2], bf_hi(old.w) + bf_hi(gv.w) * a1[3]);
                        *(u32x4*)op = w;
                    }
                }
        }
    }
};

template <class Epi, class Sched, bool ALIGN_EPI = false, bool SP2 = false>
__device__ __forceinline__ void gemm_phase(PG8_LAS unsigned char* lds, const Gemm g, const Sched& S, const Epi& E) {
    const int tid = threadIdx.x, wid = __builtin_amdgcn_readfirstlane(tid >> 6), lane = tid & 63, wr = wid >> 2, wc = wid & 3, fr = lane & 15, fq = lane >> 4;
    const int K = g.K, nt = K / BK;
    unsigned voffA[2], voffB[2];
#pragma unroll
    for (int i = 0; i < 2; ++i) { int R, C; stage_rc(tid * 16 + i * 8192, R, C); const int Rb = Epi::PERM ? ((R & ~31) + perm32(R & 31)) : R;
        voffA[i] = (unsigned)(R * K + C) * 2u; voffB[i] = (unsigned)(Rb * K + C) * 2u; }
    const size_t kstep = (size_t)(BK * 2);
    const size_t hstep = (size_t)HALF * K * 2;
    const size_t tstep = 2 * hstep;
    const unsigned ldsw = (unsigned)wid * 1024u;
    const int aoff = lds_byte(wr * 64 + fr, fq * 8), boff = lds_byte(wc * 32 + fr, fq * 8);
#define PG8_SA(b, h) (((b) * 2 + (h)) * HTB)
#define PG8_SB(b, h) ((4 + (b) * 2 + (h)) * HTB)
#define PG8_STAGE(bufoff, gbase, voff) do { _Pragma("unroll") for (int _i = 0; _i < 2; ++_i) \
        __builtin_amdgcn_global_load_lds((const unsigned*)((const char*)(gbase) + (voff)[_i]), (PG8_LAS unsigned*)(lds + (bufoff) + ldsw + _i * 8192), 16, 0, 0); } while (0)
#define PG8_LDA(dst, b, h) do { _Pragma("unroll") for (int m = 0; m < 4; ++m) _Pragma("unroll") for (int k = 0; k < 2; ++k) dst[m][k] = *(const PG8_LAS bf16x8*)(lds + PG8_SA(b, h) + aoff + m * 2048 + k * 1024); } while (0)
#define PG8_LDB(dst, b, h) do { _Pragma("unroll") for (int n = 0; n < 2; ++n) _Pragma("unroll") for (int k = 0; k < 2; ++k) dst[n][k] = *(const PG8_LAS bf16x8*)(lds + PG8_SB(b, h) + boff + n * 2048 + k * 1024); } while (0)
#define PG8_MMA(ai, bj, At, Bt) do { __builtin_amdgcn_s_setprio(1); _Pragma("unroll") for (int m = 0; m < 4; ++m) _Pragma("unroll") for (int n = 0; n < 2; ++n) _Pragma("unroll") for (int k = 0; k < 2; ++k) \
        acc[ai][bj][m][n] = __builtin_amdgcn_mfma_f32_16x16x32_bf16(Bt[n][k], At[m][k], acc[ai][bj][m][n], 0, 0, 0); __builtin_amdgcn_s_setprio(0); } while (0)
#define PG8_WAIT_V(n) asm volatile("s_waitcnt vmcnt(" #n ")" ::: "memory")
#define PG8_WAIT_L(n) asm volatile("s_waitcnt lgkmcnt(" #n ")" ::: "memory")
#define PG8_BAR __builtin_amdgcn_s_barrier()
#define PG8_SCHED __builtin_amdgcn_sched_barrier(0)
    Unit cur, nxt; int ui = 0;
    if (!S.next(0, cur)) return;
    f32x4 acc[2][2][4][2];
#pragma unroll
    for (int a = 0; a < 2; ++a)
#pragma unroll
        for (int b = 0; b < 2; ++b)
#pragma unroll
            for (int m = 0; m < 4; ++m)
#pragma unroll
                for (int n = 0; n < 2; ++n) acc[a][b][m][n] = (f32x4){0.f, 0.f, 0.f, 0.f};
    bf16x8 At[4][2], B0[2][2], B1[2][2];
    const char* cA = (const char*)g.A + (size_t)cur.pm * tstep; const char* cB = (const char*)g.Bt + (size_t)cur.pn * tstep;
    S.a_ready(cur);
    if constexpr (SP2) {
        PG8_STAGE(PG8_SB(0, 0), cB, voffB); PG8_STAGE(PG8_SB(0, 1), cB + hstep, voffB); PG8_STAGE(PG8_SA(0, 0), cA, voffA); PG8_STAGE(PG8_SA(0, 1), cA + hstep, voffA);
        if (wr == 1) PG8_BAR;
        PG8_WAIT_V(2); PG8_BAR;
        PG8_STAGE(PG8_SB(1, 0), cB + kstep, voffB); PG8_STAGE(PG8_SA(1, 0), cA + kstep, voffA); PG8_STAGE(PG8_SB(1, 1), cB + hstep + kstep, voffB);
        PG8_WAIT_V(6); PG8_BAR;
    } else {
        PG8_STAGE(PG8_SB(0, 0), cB, voffB); PG8_STAGE(PG8_SA(0, 0), cA, voffA); PG8_STAGE(PG8_SB(0, 1), cB + hstep, voffB); PG8_STAGE(PG8_SA(0, 1), cA + hstep, voffA);
        if (wr == 1) PG8_BAR;
        PG8_WAIT_V(4); PG8_BAR;
        PG8_STAGE(PG8_SB(1, 0), cB + kstep, voffB); PG8_STAGE(PG8_SA(1, 0), cA + kstep, voffA); PG8_STAGE(PG8_SB(1, 1), cB + hstep + kstep, voffB);
        PG8_WAIT_V(6); PG8_BAR;
    }
    for (;;) {
        const bool has_next = S.next(ui + 1, nxt);
        const char* nA = has_next ? (const char*)g.A + (size_t)nxt.pm * tstep : cA; const char* nB = has_next ? (const char*)g.Bt + (size_t)nxt.pn * tstep : cB;
        for (int t = 0; t < nt; t += 2) {
            const bool last = (t == nt - 2);
            const char* a1 = cA + (size_t)(t + 1) * kstep;
            const char* a2 = last ? nA : cA + (size_t)(t + 2) * kstep; const char* b2 = last ? nB : cB + (size_t)(t + 2) * kstep;
            const char* a3 = a2 + kstep; const char* b3 = b2 + kstep;
            if (last && has_next) S.a_ready(nxt);
            if constexpr (SP2) {
            PG8_LDB(B0, 0, 0); PG8_LDB(B1, 0, 1); PG8_SCHED; PG8_LDA(At, 0, 0); PG8_STAGE(PG8_SA(1, 1), a1 + hstep, voffA);
            PG8_WAIT_V(8); PG8_WAIT_L(0); PG8_BAR; PG8_MMA(0, 0, At, B0); PG8_MMA(0, 1, At, B1); PG8_BAR; PG8_SCHED;
            PG8_LDA(At, 0, 1); PG8_STAGE(PG8_SB(0, 0), b2, voffB); PG8_STAGE(PG8_SB(0, 1), b2 + hstep, voffB); PG8_STAGE(PG8_SA(0, 0), a2, voffA);
            PG8_WAIT_V(8); PG8_WAIT_L(0); PG8_BAR; PG8_MMA(1, 0, At, B0); PG8_MMA(1, 1, At, B1); PG8_BAR; PG8_SCHED;
            PG8_LDB(B0, 1, 0); PG8_LDB(B1, 1, 1); PG8_SCHED; PG8_LDA(At, 1, 0); PG8_STAGE(PG8_SA(0, 1), a2 + hstep, voffA);
            PG8_WAIT_V(8); PG8_WAIT_L(0); PG8_BAR; PG8_MMA(0, 0, At, B0); PG8_MMA(0, 1, At, B1); PG8_BAR; PG8_SCHED;
            PG8_LDA(At, 1, 1); PG8_STAGE(PG8_SB(1, 0), b3, voffB); PG8_STAGE(PG8_SB(1, 1), b3 + hstep, voffB); PG8_STAGE(PG8_SA(1, 0), a3, voffA);
            PG8_WAIT_V(8); PG8_WAIT_L(0); PG8_BAR; PG8_MMA(1, 0, At, B0); PG8_MMA(1, 1, At, B1); PG8_BAR; PG8_SCHED;
            } else {
            PG8_LDB(B0, 0, 0); PG8_SCHED; PG8_LDA(At, 0, 0); PG8_STAGE(PG8_SA(1, 1), a1 + hstep, voffA);
            PG8_WAIT_L(8); PG8_BAR; PG8_WAIT_L(0); PG8_MMA(0, 0, At, B0); PG8_BAR; PG8_SCHED;
            PG8_LDB(B1, 0, 1); PG8_STAGE(PG8_SB(0, 0), b2, voffB);
            PG8_BAR; PG8_WAIT_L(0); PG8_MMA(0, 1, At, B1); PG8_BAR;
            PG8_LDA(At, 0, 1); PG8_STAGE(PG8_SA(0, 0), a2, voffA);
            PG8_BAR; PG8_WAIT_L(0); PG8_MMA(1, 0, At, B0); PG8_BAR; PG8_SCHED;
            PG8_STAGE(PG8_SB(0, 1), b2 + hstep, voffB);
            PG8_WAIT_V(6); PG8_BAR; PG8_MMA(1, 1, At, B1); PG8_BAR;
            PG8_LDB(B0, 1, 0); PG8_SCHED; PG8_LDA(At, 1, 0); PG8_STAGE(PG8_SA(0, 1), a2 + hstep, voffA);
            PG8_WAIT_L(8); PG8_BAR; PG8_WAIT_L(0); PG8_MMA(0, 0, At, B0); PG8_BAR; PG8_SCHED;
            PG8_LDB(B1, 1, 1); PG8_STAGE(PG8_SB(1, 0), b3, voffB);
            PG8_BAR; PG8_WAIT_L(0); PG8_MMA(0, 1, At, B1); PG8_BAR;
            PG8_LDA(At, 1, 1); PG8_STAGE(PG8_SA(1, 0), a3, voffA);
            PG8_BAR; PG8_WAIT_L(0); PG8_MMA(1, 0, At, B0); PG8_BAR; PG8_SCHED;
            PG8_STAGE(PG8_SB(1, 1), b3 + hstep, voffB);
            PG8_WAIT_V(6); PG8_BAR; PG8_MMA(1, 1, At, B1); PG8_BAR;
            }
        }
        if constexpr (ALIGN_EPI) { if (wr == 0) PG8_BAR; }
        if constexpr (!Epi::AFTER_DRAIN) { E(acc, cur, wr, wc, fr, fq); S.done(cur); }
        if (!has_next) break;
#pragma unroll
        for (int a = 0; a < 2; ++a)
#pragma unroll
            for (int b = 0; b < 2; ++b)
#pragma unroll
                for (int m = 0; m < 4; ++m)
#pragma unroll
                    for (int n = 0; n < 2; ++n) acc[a][b][m][n] = (f32x4){0.f, 0.f, 0.f, 0.f};
        cur = nxt; cA = nA; cB = nB; ++ui;
        if constexpr (ALIGN_EPI) { if (wr == 1) PG8_BAR; }
    }
    PG8_WAIT_V(0);
    if constexpr (!ALIGN_EPI) { if (wr == 0) PG8_BAR; }
    PG8_BAR;
    if constexpr (Epi::AFTER_DRAIN) { E.fused(acc, cur, wr, wc, fr, fq, lds, wid, lane); S.done(cur); }
#undef PG8_SA
#undef PG8_SB
#undef PG8_STAGE
#undef PG8_LDA
#undef PG8_LDB
#undef PG8_MMA
#undef PG8_WAIT_V
#undef PG8_WAIT_L
#undef PG8_BAR
#undef PG8_SCHED
}
}
namespace cg = cooperative_groups;
#define LAS __attribute__((address_space(3)))
using pg8::bf16_t; using pg8::bf16x8; using pg8::f32x4; using pg8::u32x4; using pg8::u32x2; using pg8::f32x2;
using pg8::bf_lo; using pg8::bf_hi;
using pg8::cvt_pk_bf16;

constexpr int NT = 32768, DM = 1024, FF = 2816, SEQ = 4096;
constexpr int ZP = 3840;
constexpr int NTHREADS = 512, LDS_BYTES = 131072;
constexpr size_t MiB = 1u << 20;
constexpr size_t WS_ROWSS = 0;
constexpr size_t WS_BAR = 960 * 1024;
constexpr size_t WS_LSE = 1 * MiB;
constexpr size_t WS_WST = 3 * MiB;
constexpr size_t WS_WCT = 3 * MiB + 256 * 1024;
constexpr size_t WS_W = 4 * MiB;
constexpr size_t W_LAYER = 26738688;
constexpr size_t WO_GU1 = 0, WO_D1 = 5767168, WO_IN = 8650752, WO_PA = 15728640, WO_PB = 15990784, WO_PC = 16515072, WO_OUT = 17039360, WO_GU2 = 18087936, WO_D2 = 23855104;
constexpr size_t WS_XB = 106 * MiB;
constexpr size_t WS_YA = 170 * MiB, WS_YB = 186 * MiB, WS_YC = 218 * MiB;
constexpr size_t WS_A = 250 * MiB;
constexpr size_t WS_MERGED = WS_A + 192 * MiB;
constexpr size_t WS_END = 506 * MiB;

__device__ __forceinline__ float wave_sum(float v) {
#pragma unroll
    for (int o = 1; o < 64; o <<= 1) v += __shfl_xor(v, o);
    return v;
}
__device__ __forceinline__ f32x4 mfma16(bf16x8 a, bf16x8 b, f32x4 c) { return __builtin_amdgcn_mfma_f32_16x16x32_bf16(a, b, c, 0, 0, 0); }

__device__ __forceinline__ void transpose_item(const float* W, int K, int N, bf16_t* WT, int n0, int drow0, int k0, const float* kscale, float cs, LAS float* scr, int lane) {
#pragma unroll 8
    for (int i = 0; i < 32; ++i) { const int kk = 2 * i + (lane >> 5); const float s = kscale ? kscale[k0 + kk] * cs : cs; scr[kk * 33 + (lane & 31)] = W[(size_t)(k0 + kk) * N + n0 + (lane & 31)] * s; }
    asm volatile("s_waitcnt lgkmcnt(0)" ::: "memory");
    const int c = lane & 7;
#pragma unroll
    for (int j = 0; j < 4; ++j) { const int n = (lane >> 3) + 8 * j; const LAS float* s = scr + (8 * c) * 33 + n;
        u32x4 o; o.x = cvt_pk_bf16(s[0 * 33], s[1 * 33]); o.y = cvt_pk_bf16(s[2 * 33], s[3 * 33]); o.z = cvt_pk_bf16(s[4 * 33], s[5 * 33]); o.w = cvt_pk_bf16(s[6 * 33], s[7 * 33]);
        *(u32x4*)(WT + (size_t)(drow0 + n) * K + k0 + 8 * c) = o; }
    asm volatile("s_waitcnt lgkmcnt(0)" ::: "memory");
}

__device__ __forceinline__ void mm128(const LAS unsigned char* A, const LAS unsigned char* B, int w, int fr, int fq, f32x4 (&acc)[8]) {
    bf16x8 bw[4];
#pragma unroll
    for (int ks = 0; ks < 4; ++ks) bw[ks] = *(const LAS bf16x8*)(B + (16 * w + fr) * 272 + ks * 64 + fq * 16);
#pragma unroll
    for (int ct = 0; ct < 8; ++ct) {
        f32x4 c = (f32x4){0.f, 0.f, 0.f, 0.f};
#pragma unroll
        for (int ks = 0; ks < 4; ++ks) { const bf16x8 a = *(const LAS bf16x8*)(A + (16 * ct + fr) * 272 + ks * 64 + fq * 16); c = mfma16(a, bw[ks], c); }
        acc[ct] = c;
    }
}

__device__ __forceinline__ void attn_unit(LAS unsigned char* lds, bf16_t* Z1, float* lse, int unit, int tid) {
    asm volatile("" : "+v"(tid));
    const int lane = tid & 63, w = __builtin_amdgcn_readfirstlane(tid >> 6), fr = lane & 15, fq = lane >> 4;
    const int g = unit >> 10; int rem = unit & 1023; const int b = rem >> 7; rem &= 127; const int j = rem >> 5; const int rn = rem & 31;
    const int sh = 2 * g, dil = 1 << sh, nbm = (32 >> sh) - 1;
    const int r = rn >> (5 - sh), n = rn & nbm;
    const int colq = g * 256 + j * 64;
    const size_t tok_b = (size_t)b * SEQ + r;
#pragma unroll
    for (int it = 0; it < 4; ++it) {
        const int c = tid + NTHREADS * it; const int key = c & 255, dc = c >> 8;
        const int p = (n - 1) * 128 + key;
        u32x4 kv = (u32x4){0u, 0u, 0u, 0u}, vv = (u32x4){0u, 0u, 0u, 0u};
        if (p >= 0) { const bf16_t* src = Z1 + (tok_b + (size_t)p * dil) * ZP + colq + dc * 8; kv = *(const u32x4*)(src + 768); vv = *(const u32x4*)(src + 1536); }
        *(LAS u32x4*)(lds + key * 144 + dc * 16) = kv;
        const int k32 = key & 31; const int pos = (key & ~31) + 8 * ((k32 & 15) >> 2) + 4 * (k32 >> 4) + (k32 & 3);
        LAS bf16_t* vt = (LAS bf16_t*)(lds + 36864) + (dc * 8) * 264 + pos;
        vt[0 * 264] = (bf16_t)(vv.x & 0xffffu); vt[1 * 264] = (bf16_t)(vv.x >> 16); vt[2 * 264] = (bf16_t)(vv.y & 0xffffu); vt[3 * 264] = (bf16_t)(vv.y >> 16);
        vt[4 * 264] = (bf16_t)(vv.z & 0xffffu); vt[5 * 264] = (bf16_t)(vv.z >> 16); vt[6 * 264] = (bf16_t)(vv.w & 0xffffu); vt[7 * 264] = (bf16_t)(vv.w >> 16);
    }
    const int qi = 16 * w + fr;
    bf16_t* qp = Z1 + (tok_b + (size_t)(n * 128 + qi) * dil) * ZP + colq;
    const bf16x8 q0 = *(const bf16x8*)(qp + fq * 8), q1 = *(const bf16x8*)(qp + 32 + fq * 8);
    __syncthreads();
    const int kt0 = (w < 6 ? w : 6) & ~1;
    f32x4 s[10];
#pragma unroll
    for (int t = 0; t < 10; ++t) {
        const LAS unsigned char* kp = lds + (16 * (kt0 + t) + fr) * 144 + fq * 16;
        const bf16x8 a0 = *(const LAS bf16x8*)kp, a1 = *(const LAS bf16x8*)(kp + 64);
        s[t] = mfma16(a0, q0, (f32x4){0.f, 0.f, 0.f, 0.f}); s[t] = mfma16(a1, q1, s[t]);
    }
    constexpr float L2E = 1.4426950408889634f;
    float mx = -1e30f;
#pragma unroll
    for (int t = 0; t < 10; ++t)
#pragma unroll
        for (int i = 0; i < 4; ++i) {
            const int kj = 16 * (kt0 + t) + 4 * fq + i; const int dist = qi + 128 - kj;
            const bool valid = (dist >= 0) && (dist <= 128) && !(n == 0 && kj < 128);
            const float v = valid ? s[t][i] * L2E : -1e30f; s[t][i] = v; mx = fmaxf(mx, v);
        }
    mx = fmaxf(mx, __shfl_xor(mx, 16)); mx = fmaxf(mx, __shfl_xor(mx, 32));
    float l = 0.f;
#pragma unroll
    for (int t = 0; t < 10; ++t)
#pragma unroll
        for (int i = 0; i < 4; ++i) { const float p = __builtin_amdgcn_exp2f(s[t][i] - mx); s[t][i] = p; l += p; }
    l += __shfl_xor(l, 16); l += __shfl_xor(l, 32);
    f32x4 o[4];
#pragma unroll
    for (int dt = 0; dt < 4; ++dt) o[dt] = (f32x4){0.f, 0.f, 0.f, 0.f};
#pragma unroll
    for (int G = 0; G < 5; ++G) {
        u32x4 pw; pw.x = cvt_pk_bf16(s[2 * G][0], s[2 * G][1]); pw.y = cvt_pk_bf16(s[2 * G][2], s[2 * G][3]); pw.z = cvt_pk_bf16(s[2 * G + 1][0], s[2 * G + 1][1]); pw.w = cvt_pk_bf16(s[2 * G + 1][2], s[2 * G + 1][3]);
        const bf16x8 pb = __builtin_bit_cast(bf16x8, pw);
#pragma unroll
        for (int dt = 0; dt < 4; ++dt) {
            const bf16x8 va = *(const LAS bf16x8*)(lds + 36864 + (16 * dt + fr) * 528 + (32 * (kt0 / 2 + G) + 8 * fq) * 2);
            o[dt] = mfma16(va, pb, o[dt]);
        }
    }
    const float rl = 1.0f / l;
#ifndef DBG_ATTN_NOSTORE
#pragma unroll
    for (int dt = 0; dt < 4; ++dt) { u32x2 wv; wv.x = cvt_pk_bf16(o[dt][0] * rl, o[dt][1] * rl); wv.y = cvt_pk_bf16(o[dt][2] * rl, o[dt][3] * rl); *(u32x2*)(qp + 16 * dt + 4 * fq) = wv; }
    if (fq == 0) lse[(size_t)((g * 4 + j) * 8 + b) * SEQ + r * (SEQ >> sh) + n * 128 + qi] = (mx + __log2f(l)) * 0.6931471805599453f;
#else
    if (rl == 123.456f) lse[0] = o[0][0] + o[1][1] + o[2][2] + o[3][3];
#endif
    __syncthreads();
}

__device__ __forceinline__ void gate_unit(LAS unsigned char* lds, const bf16_t* Z1, bf16_t* yb, const bf16_t* wsT, const float* lng, const float* lnb, const float* bbs, int ch, int tid) {
    asm volatile("" : "+v"(tid));
    const int lane = tid & 63, w = __builtin_amdgcn_readfirstlane(tid >> 6), fr = lane & 15, fq = lane >> 4;
    const size_t t0 = (size_t)ch * 128;
    LAS float* st = (LAS float*)lds;
    for (int i = 0; i < 16; ++i) {
        const int t = 16 * w + i;
        const u32x4 raw = *(const u32x4*)(Z1 + (t0 + t) * ZP + 2816 + lane * 8);
        float x[8] = {bf_lo(raw.x), bf_hi(raw.x), bf_lo(raw.y), bf_hi(raw.y), bf_lo(raw.z), bf_hi(raw.z), bf_lo(raw.w), bf_hi(raw.w)};
        float sm = 0.f;
#pragma unroll
        for (int e = 0; e < 8; ++e) sm += x[e];
        const float mean = wave_sum(sm) * (1.0f / 512.0f); float q = 0.f;
#pragma unroll
        for (int e = 0; e < 8; ++e) { const float d = x[e] - mean; q += d * d; }
        const float rstd = rsqrtf(wave_sum(q) * (1.0f / 512.0f) + 1e-6f);
        if (lane == 0) { st[2 * t] = mean; st[2 * t + 1] = rstd; }
    }
    __syncthreads();
    for (int g = 0; g < 4; ++g) {
#pragma unroll
        for (int it = 0; it < 4; ++it) {
            const int c = tid + NTHREADS * it; const int row = c >> 4, c8 = c & 15;
            *(LAS u32x4*)(lds + 1024 + row * 272 + c8 * 16) = *(const u32x4*)(wsT + (size_t)(g * 128 + row) * 128 + c8 * 8);
        }
#pragma unroll
        for (int it = 0; it < 4; ++it) {
            const int c = tid + NTHREADS * it; const int sidx = c & 127, c8 = c >> 7;
            const u32x4 raw = *(const u32x4*)(Z1 + (t0 + sidx) * ZP + 2816 + g * 128 + c8 * 8);
            const float mean = st[2 * sidx], rstd = st[2 * sidx + 1];
            const int chn = g * 128 + c8 * 8;
            const f32x4 g0 = *(const f32x4*)(lng + chn), g1 = *(const f32x4*)(lng + chn + 4), b0 = *(const f32x4*)(lnb + chn), b1 = *(const f32x4*)(lnb + chn + 4);
            const float x[8] = {bf_lo(raw.x), bf_hi(raw.x), bf_lo(raw.y), bf_hi(raw.y), bf_lo(raw.z), bf_hi(raw.z), bf_lo(raw.w), bf_hi(raw.w)};
            const float gg[8] = {g0[0], g0[1], g0[2], g0[3], g1[0], g1[1], g1[2], g1[3]}; const float bb[8] = {b0[0], b0[1], b0[2], b0[3], b1[0], b1[1], b1[2], b1[3]};
            LAS bf16_t* vt = (LAS bf16_t*)(lds + 35840) + (c8 * 8) * 136 + sidx;
#pragma unroll
            for (int e = 0; e < 8; e += 2) { const unsigned pk = cvt_pk_bf16((x[e] - mean) * rstd * gg[e] + bb[e], (x[e + 1] - mean) * rstd * gg[e + 1] + bb[e + 1]); vt[e * 136] = (bf16_t)(pk & 0xffffu); vt[(e + 1) * 136] = (bf16_t)(pk >> 16); }
        }
        __syncthreads();
        f32x4 acc[8];
        mm128(lds + 35840, lds + 1024, w, fr, fq, acc);
        const int t = 16 * w + fr; const float bias = bbs[g * 128 + t];
#pragma unroll
        for (int ct = 0; ct < 8; ++ct) {
            const int chn = g * 128 + 16 * ct + 4 * fq;
            const u32x2 uu = *(const u32x2*)(Z1 + (t0 + t) * ZP + 2304 + chn);
            u32x2 o; o.x = cvt_pk_bf16(bf_lo(uu.x) * (acc[ct][0] + bias), bf_hi(uu.x) * (acc[ct][1] + bias)); o.y = cvt_pk_bf16(bf_lo(uu.y) * (acc[ct][2] + bias), bf_hi(uu.y) * (acc[ct][3] + bias));
            *(u32x2*)(yb + (t0 + t) * 512 + chn) = o;
        }
        __syncthreads();
    }
}

__device__ __forceinline__ void pool_unit(LAS unsigned char* lds, const bf16_t* Z1, bf16_t* yc, const bf16_t* wcT, const float* cscale, int unit, int tid) {
    asm volatile("" : "+v"(tid));
    const int lane = tid & 63, w = __builtin_amdgcn_readfirstlane(tid >> 6), fr = lane & 15, fq = lane >> 4;
    const int tile = unit >> 2, gi = unit & 3; const size_t t0 = (size_t)tile * 128; const int tpos0 = (int)(t0 & (SEQ - 1)); const int win = 2 << gi;
    for (int c = tid; c < 143 * 16; c += NTHREADS) {
        const int row = c >> 4, c8 = c & 15; const int tt = row - 15;
        u32x4 v = (u32x4){0u, 0u, 0u, 0u};
        if (tpos0 + tt >= 0) v = *(const u32x4*)(Z1 + (size_t)((long)t0 + tt) * ZP + 3328 + gi * 128 + c8 * 8);
        *(LAS u32x4*)(lds + row * 272 + c8 * 16) = v;
    }
#pragma unroll
    for (int it = 0; it < 4; ++it) {
        const int c = tid + NTHREADS * it; const int row = c >> 4, c8 = c & 15;
        *(LAS u32x4*)(lds + 73728 + row * 272 + c8 * 16) = *(const u32x4*)(wcT + (size_t)(gi * 128 + row) * 128 + c8 * 8);
    }
    __syncthreads();
#pragma unroll
    for (int it = 0; it < 4; ++it) {
        const int c = tid + NTHREADS * it; const int t = c >> 4, c8 = c & 15;
        const int cnt = (tpos0 + t + 1 < win) ? (tpos0 + t + 1) : win;
        float sm[8] = {0.f, 0.f, 0.f, 0.f, 0.f, 0.f, 0.f, 0.f};
        for (int i = 0; i < cnt; ++i) { const u32x4 raw = *(const LAS u32x4*)(lds + (t + 15 - i) * 272 + c8 * 16);
            sm[0] += bf_lo(raw.x); sm[1] += bf_hi(raw.x); sm[2] += bf_lo(raw.y); sm[3] += bf_hi(raw.y); sm[4] += bf_lo(raw.z); sm[5] += bf_hi(raw.z); sm[6] += bf_lo(raw.w); sm[7] += bf_hi(raw.w); }
        const u32x4 xt = *(const LAS u32x4*)(lds + (t + 15) * 272 + c8 * 16); const float ic = 1.0f / (float)cnt;
        u32x4 o; o.x = cvt_pk_bf16(sm[0] * ic - bf_lo(xt.x), sm[1] * ic - bf_hi(xt.x)); o.y = cvt_pk_bf16(sm[2] * ic - bf_lo(xt.y), sm[3] * ic - bf_hi(xt.y));
        o.z = cvt_pk_bf16(sm[4] * ic - bf_lo(xt.z), sm[5] * ic - bf_hi(xt.z)); o.w = cvt_pk_bf16(sm[6] * ic - bf_lo(xt.w), sm[7] * ic - bf_hi(xt.w));
        *(LAS u32x4*)(lds + 38912 + t * 272 + c8 * 16) = o;
    }
    __syncthreads();
    f32x4 acc[8];
    mm128(lds + 73728, lds + 38912, w, fr, fq, acc);
    const int t = 16 * w + fr;
#pragma unroll
    for (int dt = 0; dt < 8; ++dt) {
        const int d = gi * 128 + 16 * dt + 4 * fq; const f32x4 sc = *(const f32x4*)(cscale + d);
        u32x2 o; o.x = cvt_pk_bf16(acc[dt][0] * sc[0], acc[dt][1] * sc[1]); o.y = cvt_pk_bf16(acc[dt][2] * sc[2], acc[dt][3] * sc[3]);
        *(u32x2*)(yc + (t0 + t) * 512 + d) = o;
    }
    __syncthreads();
}

__device__ __forceinline__ void grid_seam(unsigned* bar, unsigned target) {
    asm volatile("s_waitcnt vmcnt(0) lgkmcnt(0)" ::: "memory");
    __syncthreads();
    if (threadIdx.x == 0) {
        __builtin_amdgcn_fence(__ATOMIC_RELEASE, "agent"); asm volatile("s_waitcnt vmcnt(0)" ::: "memory");
        __hip_atomic_fetch_add(bar, 1u, __ATOMIC_RELAXED, __HIP_MEMORY_SCOPE_AGENT);
        unsigned spins = 0;
        while (__hip_atomic_load(bar, __ATOMIC_RELAXED, __HIP_MEMORY_SCOPE_AGENT) < target) { __builtin_amdgcn_s_sleep(2); if (++spins > (1u << 24)) break; }
        __builtin_amdgcn_fence(__ATOMIC_ACQUIRE, "agent"); asm volatile("s_waitcnt vmcnt(0)" ::: "memory");
    }
    __syncthreads();
}

#ifndef DBG_SEAM_ALL
#define DBG_SEAM_ALL 0
#endif
struct Args { const float* in[23]; float* out; unsigned char* ws; int ph_lo, ph_hi; };

__global__ void __launch_bounds__(NTHREADS, 2) mega_fwd(Args a) {
    extern __shared__ __attribute__((aligned(16))) unsigned char lds_raw[];
    cg::grid_group grid = cg::this_grid();
    LAS unsigned char* lds = (LAS unsigned char*)lds_raw;
    const int G = gridDim.x, bid = blockIdx.x;
    const int ph_lo = a.ph_lo, ph_hi = a.ph_hi;
    if (ph_hi - ph_lo == 26) grid.sync();

    if (ph_lo <= 0) {
        int tid = threadIdx.x; asm volatile("" : "+v"(tid));
        const int lane = tid & 63, wave = __builtin_amdgcn_readfirstlane(tid >> 6);
        unsigned char* ws = a.ws;
        bf16_t* Wb = (bf16_t*)(ws + WS_W); bf16_t* wcT = (bf16_t*)(ws + WS_WCT); bf16_t* wsT = (bf16_t*)(ws + WS_WST); bf16_t* xb = (bf16_t*)(ws + WS_XB); float* rowss = (float*)(ws + WS_ROWSS);
        const int gw = bid * 8 + wave, NGW = G * 8;
        LAS float* scr = (LAS float*)(lds + wave * 16384);
        for (int mi = 0; mi < 30; ++mi) {
            const float* src; bf16_t* dst; const float* ksc = nullptr; float cs = 1.f; int K, N, map = 0;
            if (mi < 22) {
                const int l = mi / 11, k = mi % 11; bf16_t* Wl = Wb + (size_t)l * W_LAYER;
                switch (k) {
                    case 0: src = a.in[2] + (size_t)l * DM * FF; K = DM; N = FF; dst = Wl + WO_GU1; ksc = a.in[1] + l * DM; map = 1; break;
                    case 1: src = a.in[3] + (size_t)l * DM * FF; K = DM; N = FF; dst = Wl + WO_GU1; ksc = a.in[1] + l * DM; map = 2; break;
                    case 2: src = a.in[4] + (size_t)l * DM * FF; K = FF; N = DM; dst = Wl + WO_D1; cs = 0.5f; break;
                    case 3: src = a.in[6] + (size_t)l * DM * 6912; K = DM; N = 6912; dst = Wl + WO_IN; ksc = a.in[5] + l * DM; break;
                    case 4: src = a.in[14] + (size_t)l * 256 * DM; K = 256; N = DM; dst = Wl + WO_PA; break;
                    case 5: src = a.in[15] + (size_t)l * 512 * DM; K = 512; N = DM; dst = Wl + WO_PB; break;
                    case 6: src = a.in[16] + (size_t)l * 512 * DM; K = 512; N = DM; dst = Wl + WO_PC; break;
                    case 7: src = a.in[17] + (size_t)l * DM * DM; K = DM; N = DM; dst = Wl + WO_OUT; break;
                    case 8: src = a.in[19] + (size_t)l * DM * FF; K = DM; N = FF; dst = Wl + WO_GU2; ksc = a.in[18] + l * DM; map = 1; break;
                    case 9: src = a.in[20] + (size_t)l * DM * FF; K = DM; N = FF; dst = Wl + WO_GU2; ksc = a.in[18] + l * DM; map = 2; break;
                    default: src = a.in[21] + (size_t)l * DM * FF; K = FF; N = DM; dst = Wl + WO_D2; cs = 0.5f; break;
                }
            } else { const int q = mi - 22; src = a.in[12] + (size_t)q * 16384; K = 128; N = 128; dst = wcT + (size_t)q * 16384; }
            const int nblk = N / 32, nitems = (K / 64) * nblk;
            for (int it = gw; it < nitems; it += NGW) {
                const int kb = it / nblk, nb = it % nblk, n0 = 32 * nb;
                const int drow0 = (map == 0) ? n0 : ((n0 >> 7) * 256 + (n0 & 127) + (map == 2 ? 128 : 0));
                transpose_item(src, K, N, dst, n0, drow0, 64 * kb, ksc, cs, scr, lane);
            }
        }
        const int xcd = bid & 7, slot = bid >> 3, nslot = G >> 3;
        for (int arr = 1; arr < 7; ++arr) for (int m = xcd * SEQ + slot * NTHREADS + tid; m < (xcd + 1) * SEQ; m += nslot * NTHREADS) rowss[(size_t)arr * NT + m] = 0.f;
        for (int i = bid * NTHREADS + tid; i < 2 * 4 * 128 * 128; i += G * NTHREADS) {
            const int t = (i >> 7) & 127, s = i & 127; const float v = (s <= t) ? a.in[10][i] : 0.f;
            wsT[i] = (bf16_t)(cvt_pk_bf16(v, 0.f) & 0xffffu);
        }
        const float* x = a.in[0];
        for (int m = xcd * SEQ + slot * 8 + wave; m < (xcd + 1) * SEQ; m += nslot * 8) {
            const f32x4* xr = (const f32x4*)(x + (size_t)m * DM) + lane; u32x2* o8 = (u32x2*)(xb + (size_t)m * DM) + lane; float ss = 0.f;
#pragma unroll
            for (int jj = 0; jj < 4; ++jj) { const f32x4 v = xr[64 * jj]; ss += (v[0] * v[0] + v[1] * v[1]) + (v[2] * v[2] + v[3] * v[3]); u32x2 o; o.x = cvt_pk_bf16(v[0], v[1]); o.y = cvt_pk_bf16(v[2], v[3]); o8[64 * jj] = o; }
            ss = wave_sum(ss); if (lane == 0) rowss[m] = ss;
        }
    }
    unsigned nseam = 0;
    if (ph_lo <= 0 && ph_hi > 1) grid_seam((unsigned*)(a.ws + WS_BAR), (++nseam) * (unsigned)G);

    for (int lst = 0; lst < 24; ++lst) {
        if (lst + 1 < ph_lo || lst + 1 >= ph_hi) continue;
        int lq = __builtin_amdgcn_readfirstlane(lst / 12), st = __builtin_amdgcn_readfirstlane(lst % 12), zoff = __builtin_amdgcn_readfirstlane(0);
        asm volatile("" : "+s"(lq), "+s"(st), "+s"(zoff));
        unsigned char* ws = a.ws + zoff;
        const int l = lq;
        float* rowss = (float*)(ws + WS_ROWSS);
        bf16_t* RA = (bf16_t*)(ws + WS_A);
        const bf16_t* Wl = (const bf16_t*)(ws + WS_W) + (size_t)l * W_LAYER;
        bool isg = true, sync = true;
        pg8::Gemm g{nullptr, nullptr, NT, 0, 0};
        pg8::EpiMix e{}; e.mode = 0; e.rs = nullptr; e.aux = nullptr; e.xout = nullptr; e.ob = nullptr; e.ldo = 0;
        switch (st) {
            case 0: g.A = (bf16_t*)(ws + WS_XB); g.Bt = Wl + WO_GU1; g.N = 2 * FF; g.K = DM; e.mode = pg8::EM_SWIGLU; e.rs = rowss + (size_t)(3 * l) * NT; e.ob = RA; e.ldo = FF; break;
            case 1: g.A = RA; g.Bt = Wl + WO_D1; g.N = DM; g.K = FF; e.mode = pg8::EM_RESID; e.aux = (l == 0) ? (const void*)a.in[0] : (const void*)a.out; e.xout = a.out; e.ob = (bf16_t*)(ws + WS_XB); e.ldo = DM; e.rs = rowss + (size_t)(3 * l + 1) * NT; break;
            case 2: g.A = (bf16_t*)(ws + WS_XB); g.Bt = Wl + WO_IN; g.N = ZP; g.K = DM; e.mode = pg8::EM_Z1; e.rs = rowss + (size_t)(3 * l + 1) * NT; e.ob = RA; e.ldo = ZP; break;
            case 3: isg = false; break;
            case 4: isg = false; break;
            case 5: g.A = (bf16_t*)(ws + WS_XB); g.Bt = Wl + WO_IN + (size_t)ZP * DM; g.N = 3072; g.K = DM; e.mode = pg8::EM_GATE; e.rs = rowss + (size_t)(3 * l + 1) * NT; e.aux = a.in[7] + l * 3072; e.ob = RA; e.ldo = 3072; break;
            case 6: g.A = (bf16_t*)(ws + WS_YA); g.Bt = Wl + WO_PA; g.N = DM; g.K = 256; e.mode = pg8::EM_PROJ0; e.aux = RA; e.ob = (bf16_t*)(ws + WS_MERGED); e.ldo = DM; sync = (DBG_SEAM_ALL != 0); break;
            case 7: g.A = (bf16_t*)(ws + WS_YB); g.Bt = Wl + WO_PB; g.N = DM; g.K = 512; e.mode = pg8::EM_PROJ1; e.aux = RA + 1024; e.ob = (bf16_t*)(ws + WS_MERGED); e.ldo = DM; sync = (DBG_SEAM_ALL != 0); break;
            case 8: g.A = (bf16_t*)(ws + WS_YC); g.Bt = Wl + WO_PC; g.N = DM; g.K = 512; e.mode = pg8::EM_PROJ1; e.aux = RA + 2048; e.ob = (bf16_t*)(ws + WS_MERGED); e.ldo = DM; break;
            case 9: g.A = (bf16_t*)(ws + WS_MERGED); g.Bt = Wl + WO_OUT; g.N = DM; g.K = DM; e.mode = pg8::EM_RESID; e.aux = a.out; e.xout = a.out; e.ob = (bf16_t*)(ws + WS_XB); e.ldo = DM; e.rs = rowss + (size_t)(3 * l + 2) * NT; break;
            case 10: g.A = (bf16_t*)(ws + WS_XB); g.Bt = Wl + WO_GU2; g.N = 2 * FF; g.K = DM; e.mode = pg8::EM_SWIGLU; e.rs = rowss + (size_t)(3 * l + 2) * NT; e.ob = RA; e.ldo = FF; break;
            default: g.A = RA; g.Bt = Wl + WO_D2; g.N = DM; g.K = FF; e.mode = pg8::EM_RESID; e.aux = a.out; e.xout = a.out; e.ob = (bf16_t*)(ws + WS_XB); e.ldo = DM; e.rs = rowss + (size_t)(3 * l + 3) * NT; break;
        }
        if (isg) {
            pg8::StaticOrder S; S.init(NT, g.N, G, bid);
            pg8::gemm_phase<pg8::EpiMix, pg8::StaticOrder, true, true>(lds, g, S, e);
        } else if (st == 3) {
#ifndef DBG_NO_MIX
            const int tid = threadIdx.x;
            float* lse = (float*)(ws + WS_LSE);
            const int xcd = bid & 7, slot = bid >> 3, nslot = G >> 3;
#ifndef DBG_NO_ATTN
            for (int k = slot; k < 384; k += nslot) attn_unit(lds, RA, lse, ((k >> 7) << 10) + (xcd << 7) + (k & 127), tid);
#endif
#ifndef DBG_NO_GATE
            for (int k = slot; k < 32; k += nslot) gate_unit(lds, RA, (bf16_t*)(ws + WS_YB), (const bf16_t*)(ws + WS_WST) + (size_t)l * 65536, a.in[8] + l * 512, a.in[9] + l * 512, a.in[11] + l * 512, xcd * 32 + k, tid);
#endif
#ifndef DBG_NO_POOL
            for (int k = slot; k < 128; k += nslot) pool_unit(lds, RA, (bf16_t*)(ws + WS_YC), (const bf16_t*)(ws + WS_WCT) + (size_t)l * 65536, a.in[13] + l * 512, xcd * 128 + k, tid);
#endif
#endif
        } else {
#ifndef DBG_NO_COMB
            int tid = threadIdx.x; asm volatile("" : "+v"(tid));
            const float* lse = (const float*)(ws + WS_LSE); bf16_t* ya = (bf16_t*)(ws + WS_YA);
            const int xcd = bid & 7, slot = bid >> 3, nslot = G >> 3;
            for (int i = xcd * (SEQ * 32) + slot * NTHREADS + tid; i < (xcd + 1) * (SEQ * 32); i += nslot * NTHREADS) {
                const int tok = i >> 5, j = (i >> 3) & 3, d8 = i & 7;
                const int bb = tok >> 12, tq = tok & (SEQ - 1);
                const float l0 = lse[(size_t)((0 * 4 + j) * 8 + bb) * SEQ + tq], l1 = lse[(size_t)((1 * 4 + j) * 8 + bb) * SEQ + (tq & 3) * (SEQ >> 2) + (tq >> 2)], l2 = lse[(size_t)((2 * 4 + j) * 8 + bb) * SEQ + (tq & 15) * (SEQ >> 4) + (tq >> 4)];
                const float mx = fmaxf(l0, fmaxf(l1, l2)); float e0 = __expf(l0 - mx), e1 = __expf(l1 - mx), e2 = __expf(l2 - mx); const float inv = 1.0f / (e0 + e1 + e2); e0 *= inv; e1 *= inv; e2 *= inv;
                const bf16_t* op = RA + (size_t)tok * ZP + j * 64 + d8 * 8;
                const u32x4 o0 = *(const u32x4*)op, o1 = *(const u32x4*)(op + 256), o2 = *(const u32x4*)(op + 512);
                u32x4 r;
#ifdef DBG_COPY_YA
                e0 = 0.f; e1 = 0.f; e2 = 1.f; (void)l0; (void)l1; (void)l2;
                { const u32x4 kk = *(const u32x4*)(op + 768); (void)o0; (void)o1; (void)o2; r = kk; *(u32x4*)(ya + (size_t)tok * 256 + j * 64 + d8 * 8) = r; continue; }
#endif
                r.x = cvt_pk_bf16(e0 * bf_lo(o0.x) + e1 * bf_lo(o1.x) + e2 * bf_lo(o2.x), e0 * bf_hi(o0.x) + e1 * bf_hi(o1.x) + e2 * bf_hi(o2.x));
                r.y = cvt_pk_bf16(e0 * bf_lo(o0.y) + e1 * bf_lo(o1.y) + e2 * bf_lo(o2.y), e0 * bf_hi(o0.y) + e1 * bf_hi(o1.y) + e2 * bf_hi(o2.y));
                r.z = cvt_pk_bf16(e0 * bf_lo(o0.z) + e1 * bf_lo(o1.z) + e2 * bf_lo(o2.z), e0 * bf_hi(o0.z) + e1 * bf_hi(o1.z) + e2 * bf_hi(o2.z));
                r.w = cvt_pk_bf16(e0 * bf_lo(o0.w) + e1 * bf_lo(o1.w) + e2 * bf_lo(o2.w), e0 * bf_hi(o0.w) + e1 * bf_hi(o1.w) + e2 * bf_hi(o2.w));
                *(u32x4*)(ya + (size_t)tok * 256 + j * 64 + d8 * 8) = r;
            }
#endif
        }
        if (sync && lst + 2 < ph_hi) grid_seam((unsigned*)(a.ws + WS_BAR), (++nseam) * (unsigned)G);
    }
    if (ph_hi > 25) {
        int tid = threadIdx.x; asm volatile("" : "+v"(tid));
        const int lane = tid & 63, wave = __builtin_amdgcn_readfirstlane(tid >> 6);
        const int gw = bid * 8 + wave, NGW = G * 8; const float* fn = a.in[22]; const float* rs6 = (const float*)(a.ws + WS_ROWSS) + (size_t)6 * NT; float* X = a.out;
        const int xcd = bid & 7, slot = bid >> 3, nslot = G >> 3;
        for (int m = xcd * SEQ + slot * 8 + wave; m < (xcd + 1) * SEQ; m += nslot * 8) {
            const float rs = rsqrtf(rs6[m] * (1.0f / 1024.0f) + 1e-6f);
            f32x4* xr = (f32x4*)(X + (size_t)m * DM) + lane; const f32x4* gr = (const f32x4*)fn + lane;
#pragma unroll
            for (int jj = 0; jj < 4; ++jj) { const f32x4 v = xr[64 * jj]; xr[64 * jj] = v * rs * gr[64 * jj]; }
        }
    }
}

extern "C" void kernel_launch(void* const* d_in, const int* in_sizes, int n_in, void* d_out, int out_size, void* d_ws, size_t ws_size, hipStream_t stream) {
    static int grid = 0;
    if (grid == 0) {
        if (n_in != 23 || in_sizes[0] != NT * DM || out_size != NT * DM || ws_size < WS_END) { fprintf(stderr, "kernel_launch: unexpected problem (n_in %d, in0 %d, out %d, ws %zu)\n", n_in, n_in > 0 ? in_sizes[0] : -1, out_size, ws_size); grid = -1; return; }
        int dev = 0, cus = 0, per_cu = 0;
        if (hipGetDevice(&dev) != hipSuccess || hipDeviceGetAttribute(&cus, hipDeviceAttributeMultiprocessorCount, dev) != hipSuccess) { grid = -1; return; }
        if (hipFuncSetAttribute((const void*)mega_fwd, hipFuncAttributeMaxDynamicSharedMemorySize, LDS_BYTES) != hipSuccess) { fprintf(stderr, "kernel_launch: hipFuncSetAttribute failed\n"); grid = -1; return; }
        if (hipOccupancyMaxActiveBlocksPerMultiprocessor(&per_cu, (const void*)mega_fwd, NTHREADS, LDS_BYTES) != hipSuccess || per_cu < 1) { fprintf(stderr, "kernel_launch: occupancy query says %d\n", per_cu); per_cu = 1; }
        (void)hipGetLastError();
        grid = cus & ~7;
    }
    if (grid < 0) return;
    (void)hipMemsetAsync((char*)d_ws + WS_BAR, 0, 256, stream);
    Args a{};
    for (int i = 0; i < 23; ++i) a.in[i] = (const float*)d_in[i];
    a.out = (float*)d_out; a.ws = (unsigned char*)d_ws;
#ifndef MK_N_LAUNCHES
#define MK_N_LAUNCHES 1
#endif
#if MK_N_LAUNCHES == 1
    a.ph_lo = 0; a.ph_hi = 26;
    void* args[] = {&a};
    hipError_t e = hipLaunchCooperativeKernel((const void*)mega_fwd, dim3(grid), dim3(NTHREADS), args, LDS_BYTES, stream);
    if (e != hipSuccess) fprintf(stderr, "cooperative launch failed: %s (grid %d)\n", hipGetErrorString(e), grid);
#else
    for (int ph = 0; ph < 26; ++ph) {
        int hi = ph + 1; const int stp = (ph >= 1 && ph <= 24) ? (ph - 1) % 12 : -1; if (stp == 6) hi = ph + 3;
        a.ph_lo = ph; a.ph_hi = hi;
        hipLaunchKernelGGL(mega_fwd, dim3(grid), dim3(NTHREADS), LDS_BYTES, stream, a);
        ph = hi - 1;
    }
#endif
}
```

```cpp
#include <hip/hip_runtime.h>
#include <hip/hip_cooperative_groups.h>
#include <cstdio>
#include <cstdint>
namespace pg8 {
#define PG8_LAS __attribute__((address_space(3)))
typedef unsigned short bf16_t;
typedef short bf16x8 __attribute__((ext_vector_type(8)));
typedef float f32x4 __attribute__((ext_vector_type(4)));
typedef unsigned u32x4 __attribute__((ext_vector_type(4)));
constexpr int BM = 256, BK = 64, HALF = 128, HTB = HALF * BK * 2  , STAGE_BYTES = 8 * HTB, NXCD = 8, WGM = 8;

__host__ __device__ __forceinline__ int lds_byte(int r, int c) { const int st = (r >> 4) * 2 + (c >> 5), rr = r & 15, cc = c & 31, ob = rr * 64 + cc * 2; return st * 1024 + (ob ^ (((ob >> 9) & 1) << 5)); }
__host__ __device__ __forceinline__ void stage_rc(int b, int& R, int& C) { const int st = b / 1024, sb = b % 1024, swz = sb ^ (((sb >> 9) & 1) << 5); R = (st >> 1) * 16 + swz / 64; C = (st & 1) * 32 + (swz % 64) / 2; }
__host__ __device__ __forceinline__ int perm32(int rho) { const int n = rho >> 4, i = rho & 15; return 8 * (i >> 2) + 4 * n + (i & 3); }

struct Unit { int pm, pn; };
struct Gemm { const bf16_t* A; const bf16_t* Bt; int M, N, K; };

struct StaticOrder {
    int nM, nN, nwg, G, c;
    __host__ __device__ void init(int M, int N, int G_, int c_) { nM = M / BM; nN = N / BM; nwg = nM * nN; G = G_; c = c_; }
    __host__ __device__ bool next(int i, Unit& u) const {
        const long L = (long)i * G + c; if (L >= nwg) return false;
        int wgid = (int)L; { const int q = nwg / NXCD, r = nwg % NXCD, xcd = wgid % NXCD, off = wgid / NXCD; wgid = (xcd < r ? xcd * (q + 1) : r * (q + 1) + (xcd - r) * q) + off; }
        const int nig = WGM * nN, gid = wgid / nig, fm = gid * WGM, gsz = (nM - fm) < WGM ? (nM - fm) : WGM;
        u.pm = fm + ((wgid % nig) % gsz); u.pn = (wgid % nig) / gsz; return true;
    }
    __device__ __forceinline__ void a_ready(const Unit&) const {}
    __device__ __forceinline__ void done(const Unit&) const {}
};

typedef float f32x2 __attribute__((ext_vector_type(2)));
typedef __bf16 bf16x2_c __attribute__((ext_vector_type(2)));
__device__ __forceinline__ unsigned cvt_pk_bf16(float lo, float hi) { const f32x2 v = {lo, hi}; const bf16x2_c b = __builtin_convertvector(v, bf16x2_c); return __builtin_bit_cast(unsigned, b); }
__device__ __forceinline__ f32x2 gelu_pk(f32x2 v) {
    const f32x2 av = __builtin_elementwise_abs(v), d = av * 0.2316418882f + 1.0f;
    f32x2 t; t.x = __builtin_amdgcn_rcpf(d.x); t.y = __builtin_amdgcn_rcpf(d.y);
    f32x2 q = t * 0.5307027145f + (-0.7265760135f); q = q * t + 0.7107068705f; q = q * t + (-0.142248368f); q = q * t + 0.127414796f; q = q * t;
    const f32x2 s = (v * v) * (-0.72134752044f);
    f32x2 e; e.x = __builtin_amdgcn_exp2f(s.x); e.y = __builtin_amdgcn_exp2f(s.y);
    const f32x2 m = v * (q * e), r = v - m;
    f32x2 o; o.x = v.x < 0.f ? m.x : r.x; o.y = v.y < 0.f ? m.y : r.y; return o;
}
typedef unsigned u32x2 __attribute__((ext_vector_type(2)));
__device__ __forceinline__ float bf_lo(unsigned u) { return __uint_as_float(u << 16); }
__device__ __forceinline__ float bf_hi(unsigned u) { return __uint_as_float(u & 0xffff0000u); }
__device__ __forceinline__ float sigmoidf_(float v) { return __builtin_amdgcn_rcpf(1.0f + __expf(-v)); }
constexpr float RMS_EPS = 1e-6f;
enum { EM_SWIGLU = 0, EM_RESID = 1, EM_Z1 = 2, EM_GATE = 3, EM_PROJ0 = 4, EM_PROJ1 = 5 };
struct EpiMix {
    static constexpr bool PERM = true, AFTER_DRAIN = false;
    int mode;
    float* rs;
    const void* aux;
    float* xout;
    bf16_t* ob; int ldo;
    __device__ __forceinline__ void operator()(const f32x4 (&acc)[2][2][4][2], const Unit& u, int wr, int wc, int fr, int fq) const {
        const int row0 = u.pm * BM + wr * 64 + fr;
        const int cw = wc * 32 + 8 * fq;
        const float* rowss = rs; float* rowss_out = rs; const float* xin = (const float*)aux; const float* bias = (const float*)aux; const bf16_t* gate = (const bf16_t*)aux;
        if (mode == EM_SWIGLU) {
#pragma unroll
            for (int ai = 0; ai < 2; ++ai)
#pragma unroll
                for (int m = 0; m < 4; ++m) {
                    const int r = row0 + ai * HALF + m * 16;
                    const float rs = rsqrtf(rowss[r] * (1.0f / 1024.0f) + RMS_EPS);
                    float h[8];
#pragma unroll
                    for (int n = 0; n < 2; ++n)
#pragma unroll
                        for (int e = 0; e < 4; ++e) { const float g = acc[ai][0][m][n][e] * rs, up = acc[ai][1][m][n][e] * rs; h[n * 4 + e] = g * sigmoidf_(g) * up; }
                    u32x4 w; w.x = cvt_pk_bf16(h[0], h[1]); w.y = cvt_pk_bf16(h[2], h[3]); w.z = cvt_pk_bf16(h[4], h[5]); w.w = cvt_pk_bf16(h[6], h[7]);
                    *(u32x4*)(ob + (size_t)r * ldo + u.pn * HALF + cw) = w;
                }
        } else if (mode == EM_RESID) {
#pragma unroll
            for (int ai = 0; ai < 2; ++ai)
#pragma unroll
                for (int m = 0; m < 4; ++m) {
                    const int r = row0 + ai * HALF + m * 16; float ss = 0.f;
#pragma unroll
                    for (int bj = 0; bj < 2; ++bj) {
                        const size_t off = (size_t)r * 1024 + u.pn * BM + bj * HALF + cw;
                        const f32x4 x0 = *(const f32x4*)(xin + off), x1 = *(const f32x4*)(xin + off + 4);
                        const f32x4 v0 = x0 + acc[ai][bj][m][0], v1 = x1 + acc[ai][bj][m][1];
                        *(f32x4*)(xout + off) = v0; *(f32x4*)(xout + off + 4) = v1;
                        u32x4 w; w.x = cvt_pk_bf16(v0[0], v0[1]); w.y = cvt_pk_bf16(v0[2], v0[3]); w.z = cvt_pk_bf16(v1[0], v1[1]); w.w = cvt_pk_bf16(v1[2], v1[3]);
                        *(u32x4*)(ob + off) = w;
                        ss += (v0[0] * v0[0] + v0[1] * v0[1]) + (v0[2] * v0[2] + v0[3] * v0[3]) + (v1[0] * v1[0] + v1[1] * v1[1]) + (v1[2] * v1[2] + v1[3] * v1[3]);
                    }
                    ss += __shfl_xor(ss, 16); ss += __shfl_xor(ss, 32);
                    if (fq == 0) unsafeAtomicAdd(rowss_out + r, ss);
                }
        } else if (mode == EM_Z1) {
            const float sc = (u.pn < 3) ? 0.125f : 1.0f; const bool act = (u.pn >= 9 && u.pn <= 12);
#pragma unroll
            for (int ai = 0; ai < 2; ++ai)
#pragma unroll
                for (int m = 0; m < 4; ++m) {
                    const int r = row0 + ai * HALF + m * 16;
                    const float rs = rsqrtf(rowss[r] * (1.0f / 1024.0f) + RMS_EPS) * sc;
#pragma unroll
                    for (int bj = 0; bj < 2; ++bj) {
                        f32x4 v0 = acc[ai][bj][m][0] * rs, v1 = acc[ai][bj][m][1] * rs;
                        if (act) { const f32x2 a = gelu_pk((f32x2){v0[0], v0[1]}), b = gelu_pk((f32x2){v0[2], v0[3]}), c = gelu_pk((f32x2){v1[0], v1[1]}), d = gelu_pk((f32x2){v1[2], v1[3]});
                            v0 = (f32x4){a.x, a.y, b.x, b.y}; v1 = (f32x4){c.x, c.y, d.x, d.y}; }
                        u32x4 w; w.x = cvt_pk_bf16(v0[0], v0[1]); w.y = cvt_pk_bf16(v0[2], v0[3]); w.z = cvt_pk_bf16(v1[0], v1[1]); w.w = cvt_pk_bf16(v1[2], v1[3]);
                        *(u32x4*)(ob + (size_t)r * ldo + u.pn * BM + bj * HALF + cw) = w;
                    }
                }
        } else if (mode == EM_GATE) {
#pragma unroll
            for (int ai = 0; ai < 2; ++ai)
#pragma unroll
                for (int m = 0; m < 4; ++m) {
                    const int r = row0 + ai * HALF + m * 16;
                    const float rs = rsqrtf(rowss[r] * (1.0f / 1024.0f) + RMS_EPS);
#pragma unroll
                    for (int bj = 0; bj < 2; ++bj) {
                        const int c = u.pn * BM + bj * HALF + cw;
                        const f32x4 b0 = *(const f32x4*)(bias + c), b1 = *(const f32x4*)(bias + c + 4);
                        const f32x4 v0 = acc[ai][bj][m][0] * rs + b0, v1 = acc[ai][bj][m][1] * rs + b1;
                        u32x4 w; w.x = cvt_pk_bf16(sigmoidf_(v0[0]), sigmoidf_(v0[1])); w.y = cvt_pk_bf16(sigmoidf_(v0[2]), sigmoidf_(v0[3]));
                        w.z = cvt_pk_bf16(sigmoidf_(v1[0]), sigmoidf_(v1[1])); w.w = cvt_pk_bf16(sigmoidf_(v1[2]), sigmoidf_(v1[3]));
                        *(u32x4*)(ob + (size_t)r * ldo + c) = w;
                    }
                }
        } else {
            const bool accum = (mode == EM_PROJ1);
#pragma unroll
            for (int ai = 0; ai < 2; ++ai)
#pragma unroll
                for (int m = 0; m < 4; ++m) {
                    const int r = row0 + ai * HALF + m * 16;
#pragma unroll
                    for (int bj = 0; bj < 2; ++bj) {
                        const int c = u.pn * BM + bj * HALF + cw;
                        const u32x4 gv = *(const u32x4*)(gate + (size_t)r * 3072 + c);
                        bf16_t* op = ob + (size_t)r * 1024 + c;
                        u32x4 old = (u32x4){0u, 0u, 0u, 0u}; if (accum) old = *(const u32x4*)op;
                        const f32x4 a0 = acc[ai][bj][m][0], a1 = acc[ai][bj][m][1];
                        u32x4 w;
                        w.x = cvt_pk_bf16(bf_lo(old.x) + bf_lo(gv.x) * a0[0], bf_hi(old.x) + bf_hi(gv.x) * a0[1]);
                        w.y = cvt_pk_bf16(bf_lo(old.y) + bf_lo(gv.y) * a0[2], bf_hi(old.y) + bf_hi(gv.y) * a0[3]);
                        w.z = cvt_pk_bf16(bf_lo(old.z) + bf_lo(gv.z) * a1[0], bf_hi(old.z) + bf_hi(gv.z) * a1[1]);
                        w.w = cvt_pk_bf16(bf_lo(old.w) + bf_lo(gv.w) * a1[2], bf_hi(old.w) + bf_hi(gv.w) * a1[3]);
                        *(u32x4*)op = w;
                    }
                }
        }
    }
};

template <class Epi, class Sched, bool ALIGN_EPI = false, bool SP2 = false>
__device__ __forceinline__ void gemm_phase(PG8_LAS unsigned char* lds, const Gemm g, const Sched& S, const Epi& E) {
    const int tid = threadIdx.x, wid = __builtin_amdgcn_readfirstlane(tid >> 6), lane = tid & 63, wr = wid >> 2, wc = wid & 3, fr = lane & 15, fq = lane >> 4;
    const int K = g.K, nt = K / BK;
    unsigned voffA[2], voffB[2];
#pragma unroll
    for (int i = 0; i < 2; ++i) { int R, C; stage_rc(tid * 16 + i * 8192, R, C); const int Rb = Epi::PERM ? ((R & ~31) + perm32(R & 31)) : R;
        voffA[i] = (unsigned)(R * K + C) * 2u; voffB[i] = (unsigned)(Rb * K + C) * 2u; }
    const size_t kstep = (size_t)(BK * 2);
    const size_t hstep = (size_t)HALF * K * 2;
    const size_t tstep = 2 * hstep;
    const unsigned ldsw = (unsigned)wid * 1024u;
    const int aoff = lds_byte(wr * 64 + fr, fq * 8), boff = lds_byte(wc * 32 + fr, fq * 8);
#define PG8_SA(b, h) (((b) * 2 + (h)) * HTB)
#define PG8_SB(b, h) ((4 + (b) * 2 + (h)) * HTB)
#define PG8_STAGE(bufoff, gbase, voff) do { _Pragma("unroll") for (int _i = 0; _i < 2; ++_i) \
        __builtin_amdgcn_global_load_lds((const unsigned*)((const char*)(gbase) + (voff)[_i]), (PG8_LAS unsigned*)(lds + (bufoff) + ldsw + _i * 8192), 16, 0, 0); } while (0)
#define PG8_LDA(dst, b, h) do { _Pragma("unroll") for (int m = 0; m < 4; ++m) _Pragma("unroll") for (int k = 0; k < 2; ++k) dst[m][k] = *(const PG8_LAS bf16x8*)(lds + PG8_SA(b, h) + aoff + m * 2048 + k * 1024); } while (0)
#define PG8_LDB(dst, b, h) do { _Pragma("unroll") for (int n = 0; n < 2; ++n) _Pragma("unroll") for (int k = 0; k < 2; ++k) dst[n][k] = *(const PG8_LAS bf16x8*)(lds + PG8_SB(b, h) + boff + n * 2048 + k * 1024); } while (0)
#define PG8_MMA(ai, bj, At, Bt) do { __builtin_amdgcn_s_setprio(1); _Pragma("unroll") for (int m = 0; m < 4; ++m) _Pragma("unroll") for (int n = 0; n < 2; ++n) _Pragma("unroll") for (int k = 0; k < 2; ++k) \
        acc[ai][bj][m][n] = __builtin_amdgcn_mfma_f32_16x16x32_bf16(Bt[n][k], At[m][k], acc[ai][bj][m][n], 0, 0, 0); __builtin_amdgcn_s_setprio(0); } while (0)
#define PG8_WAIT_V(n) asm volatile("s_waitcnt vmcnt(" #n ")" ::: "memory")
#define PG8_WAIT_L(n) asm volatile("s_waitcnt lgkmcnt(" #n ")" ::: "memory")
#define PG8_BAR __builtin_amdgcn_s_barrier()
#define PG8_SCHED __builtin_amdgcn_sched_barrier(0)
    Unit cur, nxt; int ui = 0;
    if (!S.next(0, cur)) return;
    f32x4 acc[2][2][4][2];
#pragma unroll
    for (int a = 0; a < 2; ++a)
#pragma unroll
        for (int b = 0; b < 2; ++b)
#pragma unroll
            for (int m = 0; m < 4; ++m)
#pragma unroll
                for (int n = 0; n < 2; ++n) acc[a][b][m][n] = (f32x4){0.f, 0.f, 0.f, 0.f};
    bf16x8 At[4][2], B0[2][2], B1[2][2];
    const char* cA = (const char*)g.A + (size_t)cur.pm * tstep; const char* cB = (const char*)g.Bt + (size_t)cur.pn * tstep;
    S.a_ready(cur);
    if constexpr (SP2) {
        PG8_STAGE(PG8_SB(0, 0), cB, voffB); PG8_STAGE(PG8_SB(0, 1), cB + hstep, voffB); PG8_STAGE(PG8_SA(0, 0), cA, voffA); PG8_STAGE(PG8_SA(0, 1), cA + hstep, voffA);
        if (wr == 1) PG8_BAR;
        PG8_WAIT_V(2); PG8_BAR;
        PG8_STAGE(PG8_SB(1, 0), cB + kstep, voffB); PG8_STAGE(PG8_SA(1, 0), cA + kstep, voffA); PG8_STAGE(PG8_SB(1, 1), cB + hstep + kstep, voffB);
        PG8_WAIT_V(6); PG8_BAR;
    } else {
        PG8_STAGE(PG8_SB(0, 0), cB, voffB); PG8_STAGE(PG8_SA(0, 0), cA, voffA); PG8_STAGE(PG8_SB(0, 1), cB + hstep, voffB); PG8_STAGE(PG8_SA(0, 1), cA + hstep, voffA);
        if (wr == 1) PG8_BAR;
        PG8_WAIT_V(4); PG8_BAR;
        PG8_STAGE(PG8_SB(1, 0), cB + kstep, voffB); PG8_STAGE(PG8_SA(1, 0), cA + kstep, voffA); PG8_STAGE(PG8_SB(1, 1), cB + hstep + kstep, voffB);
        PG8_WAIT_V(6); PG8_BAR;
    }
    for (;;) {
        const bool has_next = S.next(ui + 1, nxt);
        const char* nA = has_next ? (const char*)g.A + (size_t)nxt.pm * tstep : cA; const char* nB = has_next ? (const char*)g.Bt + (size_t)nxt.pn * tstep : cB;
        for (int t = 0; t < nt; t += 2) {
            const bool last = (t == nt - 2);
            const char* a1 = cA + (size_t)(t + 1) * kstep;
            const char* a2 = last ? nA : cA + (size_t)(t + 2) * kstep; const char* b2 = last ? nB : cB + (size_t)(t + 2) * kstep;
            const char* a3 = a2 + kstep; const char* b3 = b2 + kstep;
            if (last && has_next) S.a_ready(nxt);
            if constexpr (SP2) {
            PG8_LDB(B0, 0, 0); PG8_LDB(B1, 0, 1); PG8_SCHED; PG8_LDA(At, 0, 0); PG8_STAGE(PG8_SA(1, 1), a1 + hstep, voffA);
            PG8_WAIT_V(8); PG8_WAIT_L(0); PG8_BAR; PG8_MMA(0, 0, At, B0); PG8_MMA(0, 1, At, B1); PG8_BAR; PG8_SCHED;
            PG8_LDA(At, 0, 1); PG8_STAGE(PG8_SB(0, 0), b2, voffB); PG8_STAGE(PG8_SB(0, 1), b2 + hstep, voffB); PG8_STAGE(PG8_SA(0, 0), a2, voffA);
            PG8_WAIT_V(8); PG8_WAIT_L(0); PG8_BAR; PG8_MMA(1, 0, At, B0); PG8_MMA(1, 1, At, B1); PG8_BAR; PG8_SCHED;
            PG8_LDB(B0, 1, 0); PG8_LDB(B1, 1, 1); PG8_SCHED; PG8_LDA(At, 1, 0); PG8_STAGE(PG8_SA(0, 1), a2 + hstep, voffA);
            PG8_WAIT_V(8); PG8_WAIT_L(0); PG8_BAR; PG8_MMA(0, 0, At, B0); PG8_MMA(0, 1, At, B1); PG8_BAR; PG8_SCHED;
            PG8_LDA(At, 1, 1); PG8_STAGE(PG8_SB(1, 0), b3, voffB); PG8_STAGE(PG8_SB(1, 1), b3 + hstep, voffB); PG8_STAGE(PG8_SA(1, 0), a3, voffA);
            PG8_WAIT_V(8); PG8_WAIT_L(0); PG8_BAR; PG8_MMA(1, 0, At, B0); PG8_MMA(1, 1, At, B1); PG8_BAR; PG8_SCHED;
            } else {
            PG8_LDB(B0, 0, 0); PG8_SCHED; PG8_LDA(At, 0, 0); PG8_STAGE(PG8_SA(1, 1), a1 + hstep, voffA);
            PG8_WAIT_L(8); PG8_BAR; PG8_WAIT_L(0); PG8_MMA(0, 0, At, B0); PG8_BAR; PG8_SCHED;
            PG8_LDB(B1, 0, 1); PG8_STAGE(PG8_SB(0, 0), b2, voffB);
            PG8_BAR; PG8_WAIT_L(0); PG8_MMA(0, 1, At, B1); PG8_BAR;
            PG8_LDA(At, 0, 1); PG8_STAGE(PG8_SA(0, 0), a2, voffA);
            PG8_BAR; PG8_WAIT_L(0); PG8_MMA(1, 0, At, B0); PG8_BAR; PG8_SCHED;
            PG8_STAGE(PG8_SB(0, 1), b2 + hstep, voffB);
            PG8_WAIT_V(6); PG8_BAR; PG8_MMA(1, 1, At, B1); PG8_BAR;
            PG8_LDB(B0, 1, 0); PG8_SCHED; PG8_LDA(At, 1, 0); PG8_STAGE(PG8_SA(0, 1), a2 + hstep, voffA);
            PG8_WAIT_L(8); PG8_BAR; PG8_WAIT_L(0); PG8_MMA(0, 0, At, B0); PG8_BAR; PG8_SCHED;
            PG8_LDB(B1, 1, 1); PG8_STAGE(PG8_SB(1, 0), b3, voffB);
            PG8_BAR; PG8_WAIT_L(0); PG8_MMA(0, 1, At, B1); PG8_BAR;
            PG8_LDA(At, 1, 1); PG8_STAGE(PG8_SA(1, 0), a3, voffA);
            PG8_BAR; PG8_WAIT_L(0); PG8_MMA(1, 0, At, B0); PG8_BAR; PG8_SCHED;
            PG8_STAGE(PG8_SB(1, 1), b3 + hstep, voffB);
            PG8_WAIT_V(6); PG8_BAR; PG8_MMA(1, 1, At, B1); PG8_BAR;
            }
        }
        if constexpr (ALIGN_EPI) { if (wr == 0) PG8_BAR; }
        if constexpr (!Epi::AFTER_DRAIN) { E(acc, cur, wr, wc, fr, fq); S.done(cur); }
        if (!has_next) break;
#pragma unroll
        for (int a = 0; a < 2; ++a)
#pragma unroll
            for (int b = 0; b < 2; ++b)
#pragma unroll
                for (int m = 0; m < 4; ++m)
#pragma unroll
                    for (int n = 0; n < 2; ++n) acc[a][b][m][n] = (f32x4){0.f, 0.f, 0.f, 0.f};
        cur = nxt; cA = nA; cB = nB; ++ui;
        if constexpr (ALIGN_EPI) { if (wr == 1) PG8_BAR; }
    }
    PG8_WAIT_V(0);
    if constexpr (!ALIGN_EPI) { if (wr == 0) PG8_BAR; }
    PG8_BAR;
    if constexpr (Epi::AFTER_DRAIN) { E.fused(acc, cur, wr, wc, fr, fq, lds, wid, lane); S.done(cur); }
#undef PG8_SA
#undef PG8_SB
#undef PG8_STAGE
#undef PG8_LDA
#undef PG8_LDB
#undef PG8_MMA
#undef PG8_WAIT_V
#undef PG8_WAIT_L
#undef PG8_BAR
#undef PG8_SCHED
}
}
namespace cg = cooperative_groups;
#define LAS __attribute__((address_space(3)))
using pg8::bf16_t; using pg8::bf16x8; using pg8::f32x4; using pg8::u32x4; using pg8::u32x2; using pg8::f32x2;
using pg8::bf_lo; using pg8::bf_hi;
using pg8::cvt_pk_bf16;

constexpr int NT = 32768, DM = 1024, FF = 2816, SEQ = 4096;
constexpr int ZP = 3840;
constexpr int NTHREADS = 512, LDS_BYTES = 131072;
constexpr size_t MiB = 1u << 20;
constexpr size_t WS_ROWSS = 0;
constexpr size_t WS_BAR = 960 * 1024;
constexpr size_t WS_LSE = 1 * MiB;
constexpr size_t WS_WST = 3 * MiB;
constexpr size_t WS_WCT = 3 * MiB + 256 * 1024;
constexpr size_t WS_W = 4 * MiB;
constexpr size_t W_LAYER = 26738688;
constexpr size_t WO_GU1 = 0, WO_D1 = 5767168, WO_IN = 8650752, WO_PA = 15728640, WO_PB = 15990784, WO_PC = 16515072, WO_OUT = 17039360, WO_GU2 = 18087936, WO_D2 = 23855104;
constexpr size_t WS_XB = 106 * MiB;
constexpr size_t WS_YA = 170 * MiB, WS_YB = 186 * MiB, WS_YC = 218 * MiB;
constexpr size_t WS_A = 250 * MiB;
constexpr size_t WS_MERGED = WS_A + 192 * MiB;
constexpr size_t WS_END = 506 * MiB;

__device__ __forceinline__ float wave_sum(float v) {
#pragma unroll
    for (int o = 1; o < 64; o <<= 1) v += __shfl_xor(v, o);
    return v;
}
__device__ __forceinline__ f32x4 mfma16(bf16x8 a, bf16x8 b, f32x4 c) { return __builtin_amdgcn_mfma_f32_16x16x32_bf16(a, b, c, 0, 0, 0); }

__device__ __forceinline__ void transpose_item(const float* W, int K, int N, bf16_t* WT, int n0, int drow0, int k0, const float* kscale, float cs, LAS float* scr, int lane) {
    const int kr = lane >> 3, n4 = (lane & 7) * 4;
    f32x4 v[8]; float sc[8];
#pragma unroll
    for (int i = 0; i < 8; ++i) { v[i] = *(const f32x4*)(W + (size_t)(k0 + 8 * i + kr) * N + n0 + n4); sc[i] = kscale ? kscale[k0 + 8 * i + kr] * cs : cs; }
#pragma unroll
    for (int i = 0; i < 8; ++i) { LAS float* d = scr + (8 * i + kr) * 33 + n4; d[0] = v[i][0] * sc[i]; d[1] = v[i][1] * sc[i]; d[2] = v[i][2] * sc[i]; d[3] = v[i][3] * sc[i]; }
    asm volatile("s_waitcnt lgkmcnt(0)" ::: "memory");
    const int c = lane & 7;
#pragma unroll
    for (int j = 0; j < 4; ++j) { const int n = (lane >> 3) + 8 * j; const LAS float* s = scr + (8 * c) * 33 + n;
        u32x4 o; o.x = cvt_pk_bf16(s[0 * 33], s[1 * 33]); o.y = cvt_pk_bf16(s[2 * 33], s[3 * 33]); o.z = cvt_pk_bf16(s[4 * 33], s[5 * 33]); o.w = cvt_pk_bf16(s[6 * 33], s[7 * 33]);
        *(u32x4*)(WT + (size_t)(drow0 + n) * K + k0 + 8 * c) = o; }
    asm volatile("s_waitcnt lgkmcnt(0)" ::: "memory");
}

__device__ __forceinline__ void mm128(const LAS unsigned char* A, const LAS unsigned char* B, int w, int fr, int fq, f32x4 (&acc)[8]) {
    bf16x8 bw[4];
#pragma unroll
    for (int ks = 0; ks < 4; ++ks) bw[ks] = *(const LAS bf16x8*)(B + (16 * w + fr) * 272 + ks * 64 + fq * 16);
#pragma unroll
    for (int ct = 0; ct < 8; ++ct) {
        f32x4 c = (f32x4){0.f, 0.f, 0.f, 0.f};
#pragma unroll
        for (int ks = 0; ks < 4; ++ks) { const bf16x8 a = *(const LAS bf16x8*)(A + (16 * ct + fr) * 272 + ks * 64 + fq * 16); c = mfma16(a, bw[ks], c); }
        acc[ct] = c;
    }
}

__device__ __forceinline__ void attn_unit(LAS unsigned char* lds, bf16_t* Z1, float* lse, int unit, int tid) {
    asm volatile("" : "+v"(tid));
    const int lane = tid & 63, w = __builtin_amdgcn_readfirstlane(tid >> 6), fr = lane & 15, fq = lane >> 4;
    const int g = unit >> 10; int rem = unit & 1023; const int b = rem >> 7; rem &= 127; const int j = rem >> 5; const int rn = rem & 31;
    const int sh = 2 * g, dil = 1 << sh, nbm = (32 >> sh) - 1;
    const int r = rn >> (5 - sh), n = rn & nbm;
    const int colq = g * 256 + j * 64;
    const size_t tok_b = (size_t)b * SEQ + r;
#pragma unroll
    for (int it = 0; it < 4; ++it) {
        const int c = tid + NTHREADS * it; const int key = c & 255, dc = c >> 8;
        const int p = (n - 1) * 128 + key;
        u32x4 kv = (u32x4){0u, 0u, 0u, 0u}, vv = (u32x4){0u, 0u, 0u, 0u};
        if (p >= 0) { const bf16_t* src = Z1 + (tok_b + (size_t)p * dil) * ZP + colq + dc * 8; kv = *(const u32x4*)(src + 768); vv = *(const u32x4*)(src + 1536); }
        *(LAS u32x4*)(lds + key * 144 + dc * 16) = kv;
        const int k32 = key & 31; const int pos = (key & ~31) + 8 * ((k32 & 15) >> 2) + 4 * (k32 >> 4) + (k32 & 3);
        LAS bf16_t* vt = (LAS bf16_t*)(lds + 36864) + (dc * 8) * 264 + pos;
        vt[0 * 264] = (bf16_t)(vv.x & 0xffffu); vt[1 * 264] = (bf16_t)(vv.x >> 16); vt[2 * 264] = (bf16_t)(vv.y & 0xffffu); vt[3 * 264] = (bf16_t)(vv.y >> 16);
        vt[4 * 264] = (bf16_t)(vv.z & 0xffffu); vt[5 * 264] = (bf16_t)(vv.z >> 16); vt[6 * 264] = (bf16_t)(vv.w & 0xffffu); vt[7 * 264] = (bf16_t)(vv.w >> 16);
    }
    const int qi = 16 * w + fr;
    bf16_t* qp = Z1 + (tok_b + (size_t)(n * 128 + qi) * dil) * ZP + colq;
    const bf16x8 q0 = *(const bf16x8*)(qp + fq * 8), q1 = *(const bf16x8*)(qp + 32 + fq * 8);
    __syncthreads();
    const int kt0 = (w < 6 ? w : 6) & ~1;
    f32x4 s[10];
#pragma unroll
    for (int t = 0; t < 10; ++t) {
        const LAS unsigned char* kp = lds + (16 * (kt0 + t) + fr) * 144 + fq * 16;
        const bf16x8 a0 = *(const LAS bf16x8*)kp, a1 = *(const LAS bf16x8*)(kp + 64);
        s[t] = mfma16(a0, q0, (f32x4){0.f, 0.f, 0.f, 0.f}); s[t] = mfma16(a1, q1, s[t]);
    }
    constexpr float L2E = 1.4426950408889634f;
    float mx = -1e30f;
#pragma unroll
    for (int t = 0; t < 10; ++t)
#pragma unroll
        for (int i = 0; i < 4; ++i) {
            const int kj = 16 * (kt0 + t) + 4 * fq + i; const int dist = qi + 128 - kj;
            const bool valid = (dist >= 0) && (dist <= 128) && !(n == 0 && kj < 128);
            const float v = valid ? s[t][i] * L2E : -1e30f; s[t][i] = v; mx = fmaxf(mx, v);
        }
    mx = fmaxf(mx, __shfl_xor(mx, 16)); mx = fmaxf(mx, __shfl_xor(mx, 32));
    float l = 0.f;
#pragma unroll
    for (int t = 0; t < 10; ++t)
#pragma unroll
        for (int i = 0; i < 4; ++i) { const float p = __builtin_amdgcn_exp2f(s[t][i] - mx); s[t][i] = p; l += p; }
    l += __shfl_xor(l, 16); l += __shfl_xor(l, 32);
    f32x4 o[4];
#pragma unroll
    for (int dt = 0; dt < 4; ++dt) o[dt] = (f32x4){0.f, 0.f, 0.f, 0.f};
#pragma unroll
    for (int G = 0; G < 5; ++G) {
        u32x4 pw; pw.x = cvt_pk_bf16(s[2 * G][0], s[2 * G][1]); pw.y = cvt_pk_bf16(s[2 * G][2], s[2 * G][3]); pw.z = cvt_pk_bf16(s[2 * G + 1][0], s[2 * G + 1][1]); pw.w = cvt_pk_bf16(s[2 * G + 1][2], s[2 * G + 1][3]);
        const bf16x8 pb = __builtin_bit_cast(bf16x8, pw);
#pragma unroll
        for (int dt = 0; dt < 4; ++dt) {
            const bf16x8 va = *(const LAS bf16x8*)(lds + 36864 + (16 * dt + fr) * 528 + (32 * (kt0 / 2 + G) + 8 * fq) * 2);
            o[dt] = mfma16(va, pb, o[dt]);
        }
    }
    const float rl = 1.0f / l;
#ifndef DBG_ATTN_NOSTORE
#pragma unroll
    for (int dt = 0; dt < 4; ++dt) { u32x2 wv; wv.x = cvt_pk_bf16(o[dt][0] * rl, o[dt][1] * rl); wv.y = cvt_pk_bf16(o[dt][2] * rl, o[dt][3] * rl); *(u32x2*)(qp + 16 * dt + 4 * fq) = wv; }
    if (fq == 0) lse[(size_t)((g * 4 + j) * 8 + b) * SEQ + r * (SEQ >> sh) + n * 128 + qi] = (mx + __log2f(l)) * 0.6931471805599453f;
#else
    if (rl == 123.456f) lse[0] = o[0][0] + o[1][1] + o[2][2] + o[3][3];
#endif
    __syncthreads();
}

__device__ __forceinline__ void gate_unit(LAS unsigned char* lds, const bf16_t* Z1, bf16_t* yb, const bf16_t* wsT, const float* lng, const float* lnb, const float* bbs, int ch, int tid) {
    asm volatile("" : "+v"(tid));
    const int lane = tid & 63, w = __builtin_amdgcn_readfirstlane(tid >> 6), fr = lane & 15, fq = lane >> 4;
    const size_t t0 = (size_t)ch * 128;
    LAS float* st = (LAS float*)lds;
    for (int i = 0; i < 16; ++i) {
        const int t = 16 * w + i;
        const u32x4 raw = *(const u32x4*)(Z1 + (t0 + t) * ZP + 2816 + lane * 8);
        float x[8] = {bf_lo(raw.x), bf_hi(raw.x), bf_lo(raw.y), bf_hi(raw.y), bf_lo(raw.z), bf_hi(raw.z), bf_lo(raw.w), bf_hi(raw.w)};
        float sm = 0.f;
#pragma unroll
        for (int e = 0; e < 8; ++e) sm += x[e];
        const float mean = wave_sum(sm) * (1.0f / 512.0f); float q = 0.f;
#pragma unroll
        for (int e = 0; e < 8; ++e) { const float d = x[e] - mean; q += d * d; }
        const float rstd = rsqrtf(wave_sum(q) * (1.0f / 512.0f) + 1e-6f);
        if (lane == 0) { st[2 * t] = mean; st[2 * t + 1] = rstd; }
    }
    __syncthreads();
    for (int g = 0; g < 4; ++g) {
#pragma unroll
        for (int it = 0; it < 4; ++it) {
            const int c = tid + NTHREADS * it; const int row = c >> 4, c8 = c & 15;
            *(LAS u32x4*)(lds + 1024 + row * 272 + c8 * 16) = *(const u32x4*)(wsT + (size_t)(g * 128 + row) * 128 + c8 * 8);
        }
#pragma unroll
        for (int it = 0; it < 4; ++it) {
            const int c = tid + NTHREADS * it; const int sidx = c & 127, c8 = c >> 7;
            const u32x4 raw = *(const u32x4*)(Z1 + (t0 + sidx) * ZP + 2816 + g * 128 + c8 * 8);
            const float mean = st[2 * sidx], rstd = st[2 * sidx + 1];
            const int chn = g * 128 + c8 * 8;
            const f32x4 g0 = *(const f32x4*)(lng + chn), g1 = *(const f32x4*)(lng + chn + 4), b0 = *(const f32x4*)(lnb + chn), b1 = *(const f32x4*)(lnb + chn + 4);
            const float x[8] = {bf_lo(raw.x), bf_hi(raw.x), bf_lo(raw.y), bf_hi(raw.y), bf_lo(raw.z), bf_hi(raw.z), bf_lo(raw.w), bf_hi(raw.w)};
            const float gg[8] = {g0[0], g0[1], g0[2], g0[3], g1[0], g1[1], g1[2], g1[3]}; const float bb[8] = {b0[0], b0[1], b0[2], b0[3], b1[0], b1[1], b1[2], b1[3]};
            LAS bf16_t* vt = (LAS bf16_t*)(lds + 35840) + (c8 * 8) * 136 + sidx;
#pragma unroll
            for (int e = 0; e < 8; e += 2) { const unsigned pk = cvt_pk_bf16((x[e] - mean) * rstd * gg[e] + bb[e], (x[e + 1] - mean) * rstd * gg[e + 1] + bb[e + 1]); vt[e * 136] = (bf16_t)(pk & 0xffffu); vt[(e + 1) * 136] = (bf16_t)(pk >> 16); }
        }
        __syncthreads();
        f32x4 acc[8];
        mm128(lds + 35840, lds + 1024, w, fr, fq, acc);
        const int t = 16 * w + fr; const float bias = bbs[g * 128 + t];
#pragma unroll
        for (int ct = 0; ct < 8; ++ct) {
            const int chn = g * 128 + 16 * ct + 4 * fq;
            const u32x2 uu = *(const u32x2*)(Z1 + (t0 + t) * ZP + 2304 + chn);
            u32x2 o; o.x = cvt_pk_bf16(bf_lo(uu.x) * (acc[ct][0] + bias), bf_hi(uu.x) * (acc[ct][1] + bias)); o.y = cvt_pk_bf16(bf_lo(uu.y) * (acc[ct][2] + bias), bf_hi(uu.y) * (acc[ct][3] + bias));
            *(u32x2*)(yb + (t0 + t) * 512 + chn) = o;
        }
        __syncthreads();
    }
}

__device__ __forceinline__ void pool_unit(LAS unsigned char* lds, const bf16_t* Z1, bf16_t* yc, const bf16_t* wcT, const float* cscale, int unit, int tid) {
    asm volatile("" : "+v"(tid));
    const int lane = tid & 63, w = __builtin_amdgcn_readfirstlane(tid >> 6), fr = lane & 15, fq = lane >> 4;
    const int tile = unit >> 2, gi = unit & 3; const size_t t0 = (size_t)tile * 128; const int tpos0 = (int)(t0 & (SEQ - 1)); const int win = 2 << gi;
    for (int c = tid; c < 143 * 16; c += NTHREADS) {
        const int row = c >> 4, c8 = c & 15; const int tt = row - 15;
        u32x4 v = (u32x4){0u, 0u, 0u, 0u};
        if (tpos0 + tt >= 0) v = *(const u32x4*)(Z1 + (size_t)((long)t0 + tt) * ZP + 3328 + gi * 128 + c8 * 8);
        *(LAS u32x4*)(lds + row * 272 + c8 * 16) = v;
    }
#pragma unroll
    for (int it = 0; it < 4; ++it) {
        const int c = tid + NTHREADS * it; const int row = c >> 4, c8 = c & 15;
        *(LAS u32x4*)(lds + 73728 + row * 272 + c8 * 16) = *(const u32x4*)(wcT + (size_t)(gi * 128 + row) * 128 + c8 * 8);
    }
    __syncthreads();
#pragma unroll
    for (int it = 0; it < 4; ++it) {
        const int c = tid + NTHREADS * it; const int t = c >> 4, c8 = c & 15;
        const int cnt = (tpos0 + t + 1 < win) ? (tpos0 + t + 1) : win;
        float sm[8] = {0.f, 0.f, 0.f, 0.f, 0.f, 0.f, 0.f, 0.f};
        for (int i = 0; i < cnt; ++i) { const u32x4 raw = *(const LAS u32x4*)(lds + (t + 15 - i) * 272 + c8 * 16);
            sm[0] += bf_lo(raw.x); sm[1] += bf_hi(raw.x); sm[2] += bf_lo(raw.y); sm[3] += bf_hi(raw.y); sm[4] += bf_lo(raw.z); sm[5] += bf_hi(raw.z); sm[6] += bf_lo(raw.w); sm[7] += bf_hi(raw.w); }
        const u32x4 xt = *(const LAS u32x4*)(lds + (t + 15) * 272 + c8 * 16); const float ic = 1.0f / (float)cnt;
        u32x4 o; o.x = cvt_pk_bf16(sm[0] * ic - bf_lo(xt.x), sm[1] * ic - bf_hi(xt.x)); o.y = cvt_pk_bf16(sm[2] * ic - bf_lo(xt.y), sm[3] * ic - bf_hi(xt.y));
        o.z = cvt_pk_bf16(sm[4] * ic - bf_lo(xt.z), sm[5] * ic - bf_hi(xt.z)); o.w = cvt_pk_bf16(sm[6] * ic - bf_lo(xt.w), sm[7] * ic - bf_hi(xt.w));
        *(LAS u32x4*)(lds + 38912 + t * 272 + c8 * 16) = o;
    }
    __syncthreads();
    f32x4 acc[8];
    mm128(lds + 73728, lds + 38912, w, fr, fq, acc);
    const int t = 16 * w + fr;
#pragma unroll
    for (int dt = 0; dt < 8; ++dt) {
        const int d = gi * 128 + 16 * dt + 4 * fq; const f32x4 sc = *(const f32x4*)(cscale + d);
        u32x2 o; o.x = cvt_pk_bf16(acc[dt][0] * sc[0], acc[dt][1] * sc[1]); o.y = cvt_pk_bf16(acc[dt][2] * sc[2], acc[dt][3] * sc[3]);
        *(u32x2*)(yc + (t0 + t) * 512 + d) = o;
    }
    __syncthreads();
}

__device__ __forceinline__ void grid_seam(unsigned* bar, unsigned target) {
#ifdef DBG_REP_SEAM
  for (int rep_ = 0; rep_ < 2; ++rep_) {
    target = 2 * target - (1 - rep_) * gridDim.x;
#endif
    asm volatile("s_waitcnt vmcnt(0) lgkmcnt(0)" ::: "memory");
    __syncthreads();
    if (threadIdx.x == 0) {
        __builtin_amdgcn_fence(__ATOMIC_RELEASE, "agent"); asm volatile("s_waitcnt vmcnt(0)" ::: "memory");
        __hip_atomic_fetch_add(bar, 1u, __ATOMIC_RELAXED, __HIP_MEMORY_SCOPE_AGENT);
        unsigned spins = 0;
        while (__hip_atomic_load(bar, __ATOMIC_RELAXED, __HIP_MEMORY_SCOPE_AGENT) < target) { __builtin_amdgcn_s_sleep(2); if (++spins > (1u << 24)) break; }
        __builtin_amdgcn_fence(__ATOMIC_ACQUIRE, "agent"); asm volatile("s_waitcnt vmcnt(0)" ::: "memory");
    }
    __syncthreads();
#ifdef DBG_REP_SEAM
    target = (target + (1 - rep_) * gridDim.x) / 2;
  }
#endif
}

#ifndef DBG_SEAM_ALL
#define DBG_SEAM_ALL 0
#endif
struct Args { const float* in[23]; float* out; unsigned char* ws; int ph_lo, ph_hi; };

__global__ void __launch_bounds__(NTHREADS, 2) mega_fwd(Args a) {
    extern __shared__ __attribute__((aligned(16))) unsigned char lds_raw[];
    cg::grid_group grid = cg::this_grid();
    LAS unsigned char* lds = (LAS unsigned char*)lds_raw;
    const int G = gridDim.x, bid = blockIdx.x;
    const int ph_lo = a.ph_lo, ph_hi = a.ph_hi;
    if (ph_hi - ph_lo == 26) grid.sync();

#ifdef DBG_REP_P0
    for (int rep_ = 0; rep_ < 2; ++rep_)
#endif
    if (ph_lo <= 0) {
        int tid = threadIdx.x; asm volatile("" : "+v"(tid));
        const int lane = tid & 63, wave = __builtin_amdgcn_readfirstlane(tid >> 6);
        unsigned char* ws = a.ws;
        bf16_t* Wb = (bf16_t*)(ws + WS_W); bf16_t* wcT = (bf16_t*)(ws + WS_WCT); bf16_t* wsT = (bf16_t*)(ws + WS_WST); bf16_t* xb = (bf16_t*)(ws + WS_XB); float* rowss = (float*)(ws + WS_ROWSS);
        const int gw = bid * 8 + wave, NGW = G * 8;
        LAS float* scr = (LAS float*)(lds + wave * 16384);
        for (int it0 = gw; it0 < 2 * 13056 + 64; it0 += NGW) {
            const float* src; bf16_t* dst; const float* ksc = nullptr; float cs = 1.f; int K, N, map = 0, it;
            if (it0 < 2 * 13056) {
                const int l = it0 >= 13056 ? 1 : 0; const int r = it0 - l * 13056; bf16_t* Wl = Wb + (size_t)l * W_LAYER;
                if (r < 1408)       { it = r;         src = a.in[2] + (size_t)l * DM * FF; K = DM; N = FF; dst = Wl + WO_GU1; ksc = a.in[1] + l * DM; map = 1; }
                else if (r < 2816)  { it = r - 1408;  src = a.in[3] + (size_t)l * DM * FF; K = DM; N = FF; dst = Wl + WO_GU1; ksc = a.in[1] + l * DM; map = 2; }
                else if (r < 4224)  { it = r - 2816;  src = a.in[4] + (size_t)l * DM * FF; K = FF; N = DM; dst = Wl + WO_D1; cs = 0.5f; }
                else if (r < 7680)  { it = r - 4224;  src = a.in[6] + (size_t)l * DM * 6912; K = DM; N = 6912; dst = Wl + WO_IN; ksc = a.in[5] + l * DM; }
                else if (r < 7808)  { it = r - 7680;  src = a.in[14] + (size_t)l * 256 * DM; K = 256; N = DM; dst = Wl + WO_PA; }
                else if (r < 8064)  { it = r - 7808;  src = a.in[15] + (size_t)l * 512 * DM; K = 512; N = DM; dst = Wl + WO_PB; }
                else if (r < 8320)  { it = r - 8064;  src = a.in[16] + (size_t)l * 512 * DM; K = 512; N = DM; dst = Wl + WO_PC; }
                else if (r < 8832)  { it = r - 8320;  src = a.in[17] + (size_t)l * DM * DM; K = DM; N = DM; dst = Wl + WO_OUT; }
                else if (r < 10240) { it = r - 8832;  src = a.in[19] + (size_t)l * DM * FF; K = DM; N = FF; dst = Wl + WO_GU2; ksc = a.in[18] + l * DM; map = 1; }
                else if (r < 11648) { it = r - 10240; src = a.in[20] + (size_t)l * DM * FF; K = DM; N = FF; dst = Wl + WO_GU2; ksc = a.in[18] + l * DM; map = 2; }
                else                { it = r - 11648; src = a.in[21] + (size_t)l * DM * FF; K = FF; N = DM; dst = Wl + WO_D2; cs = 0.5f; }
            } else { const int q = (it0 - 2 * 13056) >> 3; it = (it0 - 2 * 13056) & 7; src = a.in[12] + (size_t)q * 16384; K = 128; N = 128; dst = wcT + (size_t)q * 16384; }
            const int nblk = N / 32;
            const int kb = it / nblk, nb = it % nblk, n0 = 32 * nb;
            const int drow0 = (map == 0) ? n0 : ((n0 >> 7) * 256 + (n0 & 127) + (map == 2 ? 128 : 0));
            transpose_item(src, K, N, dst, n0, drow0, 64 * kb, ksc, cs, scr, lane);
        }
        const int xcd = bid & 7, slot = bid >> 3, nslot = G >> 3;
        for (int arr = 1; arr < 7; ++arr) for (int m = xcd * SEQ + slot * NTHREADS + tid; m < (xcd + 1) * SEQ; m += nslot * NTHREADS) rowss[(size_t)arr * NT + m] = 0.f;
        for (int i = bid * NTHREADS + tid; i < 2 * 4 * 128 * 128; i += G * NTHREADS) {
            const int t = (i >> 7) & 127, s = i & 127; const float v = (s <= t) ? a.in[10][i] : 0.f;
            wsT[i] = (bf16_t)(cvt_pk_bf16(v, 0.f) & 0xffffu);
        }
        const float* x = a.in[0];
        for (int m = xcd * SEQ + slot * 8 + wave; m < (xcd + 1) * SEQ; m += nslot * 8) {
            const f32x4* xr = (const f32x4*)(x + (size_t)m * DM) + lane; u32x2* o8 = (u32x2*)(xb + (size_t)m * DM) + lane; float ss = 0.f;
#pragma unroll
            for (int jj = 0; jj < 4; ++jj) { const f32x4 v = xr[64 * jj]; ss += (v[0] * v[0] + v[1] * v[1]) + (v[2] * v[2] + v[3] * v[3]); u32x2 o; o.x = cvt_pk_bf16(v[0], v[1]); o.y = cvt_pk_bf16(v[2], v[3]); o8[64 * jj] = o; }
            ss = wave_sum(ss); if (lane == 0) rowss[m] = ss;
        }
    }
    unsigned nseam = 0;
    if (ph_lo <= 0 && ph_hi > 1) grid_seam((unsigned*)(a.ws + WS_BAR), (++nseam) * (unsigned)G);

    for (int lst = 0; lst < 24; ++lst) {
        if (lst + 1 < ph_lo || lst + 1 >= ph_hi) continue;
        int lq = __builtin_amdgcn_readfirstlane(lst / 12), st = __builtin_amdgcn_readfirstlane(lst % 12), zoff = __builtin_amdgcn_readfirstlane(0);
        asm volatile("" : "+s"(lq), "+s"(st), "+s"(zoff));
        unsigned char* ws = a.ws + zoff;
        const int l = lq;
        float* rowss = (float*)(ws + WS_ROWSS);
        bf16_t* RA = (bf16_t*)(ws + WS_A);
        const bf16_t* Wl = (const bf16_t*)(ws + WS_W) + (size_t)l * W_LAYER;
        bool isg = true, sync = true;
        pg8::Gemm g{nullptr, nullptr, NT, 0, 0};
        pg8::EpiMix e{}; e.mode = 0; e.rs = nullptr; e.aux = nullptr; e.xout = nullptr; e.ob = nullptr; e.ldo = 0;
        switch (st) {
            case 0: g.A = (bf16_t*)(ws + WS_XB); g.Bt = Wl + WO_GU1; g.N = 2 * FF; g.K = DM; e.mode = pg8::EM_SWIGLU; e.rs = rowss + (size_t)(3 * l) * NT; e.ob = RA; e.ldo = FF; break;
            case 1: g.A = RA; g.Bt = Wl + WO_D1; g.N = DM; g.K = FF; e.mode = pg8::EM_RESID; e.aux = (l == 0) ? (const void*)a.in[0] : (const void*)a.out; e.xout = a.out; e.ob = (bf16_t*)(ws + WS_XB); e.ldo = DM; e.rs = rowss + (size_t)(3 * l + 1) * NT; break;
            case 2: g.A = (bf16_t*)(ws + WS_XB); g.Bt = Wl + WO_IN; g.N = ZP; g.K = DM; e.mode = pg8::EM_Z1; e.rs = rowss + (size_t)(3 * l + 1) * NT; e.ob = RA; e.ldo = ZP; break;
            case 3: isg = false; break;
            case 4: isg = false; break;
            case 5: g.A = (bf16_t*)(ws + WS_XB); g.Bt = Wl + WO_IN + (size_t)ZP * DM; g.N = 3072; g.K = DM; e.mode = pg8::EM_GATE; e.rs = rowss + (size_t)(3 * l + 1) * NT; e.aux = a.in[7] + l * 3072; e.ob = RA; e.ldo = 3072; break;
            case 6: g.A = (bf16_t*)(ws + WS_YA); g.Bt = Wl + WO_PA; g.N = DM; g.K = 256; e.mode = pg8::EM_PROJ0; e.aux = RA; e.ob = (bf16_t*)(ws + WS_MERGED); e.ldo = DM; sync = (DBG_SEAM_ALL != 0); break;
            case 7: g.A = (bf16_t*)(ws + WS_YB); g.Bt = Wl + WO_PB; g.N = DM; g.K = 512; e.mode = pg8::EM_PROJ1; e.aux = RA + 1024; e.ob = (bf16_t*)(ws + WS_MERGED); e.ldo = DM; sync = (DBG_SEAM_ALL != 0); break;
            case 8: g.A = (bf16_t*)(ws + WS_YC); g.Bt = Wl + WO_PC; g.N = DM; g.K = 512; e.mode = pg8::EM_PROJ1; e.aux = RA + 2048; e.ob = (bf16_t*)(ws + WS_MERGED); e.ldo = DM; break;
            case 9: g.A = (bf16_t*)(ws + WS_MERGED); g.Bt = Wl + WO_OUT; g.N = DM; g.K = DM; e.mode = pg8::EM_RESID; e.aux = a.out; e.xout = a.out; e.ob = (bf16_t*)(ws + WS_XB); e.ldo = DM; e.rs = rowss + (size_t)(3 * l + 2) * NT; break;
            case 10: g.A = (bf16_t*)(ws + WS_XB); g.Bt = Wl + WO_GU2; g.N = 2 * FF; g.K = DM; e.mode = pg8::EM_SWIGLU; e.rs = rowss + (size_t)(3 * l + 2) * NT; e.ob = RA; e.ldo = FF; break;
            default: g.A = RA; g.Bt = Wl + WO_D2; g.N = DM; g.K = FF; e.mode = pg8::EM_RESID; e.aux = a.out; e.xout = a.out; e.ob = (bf16_t*)(ws + WS_XB); e.ldo = DM; e.rs = rowss + (size_t)(3 * l + 3) * NT; break;
        }
        if (isg) {
            pg8::StaticOrder S; S.init(NT, g.N, G, bid);
#ifdef DBG_REP_GEMM0
            for (int rep_ = (st == 0 || st == 10) ? 0 : 1; rep_ < 2; ++rep_)
#endif
            pg8::gemm_phase<pg8::EpiMix, pg8::StaticOrder, true, true>(lds, g, S, e);
        } else if (st == 3) {
#ifndef DBG_NO_MIX
            const int tid = threadIdx.x;
            float* lse = (float*)(ws + WS_LSE);
            const int xcd = bid & 7, slot = bid >> 3, nslot = G >> 3;
#ifndef DBG_NO_ATTN
            for (int k = slot; k < 384; k += nslot) attn_unit(lds, RA, lse, ((k >> 7) << 10) + (xcd << 7) + (k & 127), tid);
#endif
#ifdef DBG_REP_MIX
            for (int rep_ = 0; rep_ < 2; ++rep_) {
#endif
#ifndef DBG_NO_GATE
            for (int k = slot; k < 32; k += nslot) gate_unit(lds, RA, (bf16_t*)(ws + WS_YB), (const bf16_t*)(ws + WS_WST) + (size_t)l * 65536, a.in[8] + l * 512, a.in[9] + l * 512, a.in[11] + l * 512, xcd * 32 + k, tid);
#endif
#ifndef DBG_NO_POOL
            for (int k = slot; k < 128; k += nslot) pool_unit(lds, RA, (bf16_t*)(ws + WS_YC), (const bf16_t*)(ws + WS_WCT) + (size_t)l * 65536, a.in[13] + l * 512, xcd * 128 + k, tid);
#endif
#ifdef DBG_REP_MIX
            }
#endif
#endif
        } else {
#ifndef DBG_NO_COMB
            int tid = threadIdx.x; asm volatile("" : "+v"(tid));
            const float* lse = (const float*)(ws + WS_LSE); bf16_t* ya = (bf16_t*)(ws + WS_YA);
            const int xcd = bid & 7, slot = bid >> 3, nslot = G >> 3;
#ifdef DBG_REP_MIX
            for (int rep_ = 0; rep_ < 2; ++rep_)
#endif
            for (int i = xcd * (SEQ * 32) + slot * NTHREADS + tid; i < (xcd + 1) * (SEQ * 32); i += nslot * NTHREADS) {
                const int tok = i >> 5, j = (i >> 3) & 3, d8 = i & 7;
                const int bb = tok >> 12, tq = tok & (SEQ - 1);
                const float l0 = lse[(size_t)((0 * 4 + j) * 8 + bb) * SEQ + tq], l1 = lse[(size_t)((1 * 4 + j) * 8 + bb) * SEQ + (tq & 3) * (SEQ >> 2) + (tq >> 2)], l2 = lse[(size_t)((2 * 4 + j) * 8 + bb) * SEQ + (tq & 15) * (SEQ >> 4) + (tq >> 4)];
                const float mx = fmaxf(l0, fmaxf(l1, l2)); float e0 = __expf(l0 - mx), e1 = __expf(l1 - mx), e2 = __expf(l2 - mx); const float inv = 1.0f / (e0 + e1 + e2); e0 *= inv; e1 *= inv; e2 *= inv;
                const bf16_t* op = RA + (size_t)tok * ZP + j * 64 + d8 * 8;
                const u32x4 o0 = *(const u32x4*)op, o1 = *(const u32x4*)(op + 256), o2 = *(const u32x4*)(op + 512);
                u32x4 r;
#ifdef DBG_COPY_YA
                e0 = 0.f; e1 = 0.f; e2 = 1.f; (void)l0; (void)l1; (void)l2;
                { const u32x4 kk = *(const u32x4*)(op + 768); (void)o0; (void)o1; (void)o2; r = kk; *(u32x4*)(ya + (size_t)tok * 256 + j * 64 + d8 * 8) = r; continue; }
#endif
                r.x = cvt_pk_bf16(e0 * bf_lo(o0.x) + e1 * bf_lo(o1.x) + e2 * bf_lo(o2.x), e0 * bf_hi(o0.x) + e1 * bf_hi(o1.x) + e2 * bf_hi(o2.x));
                r.y = cvt_pk_bf16(e0 * bf_lo(o0.y) + e1 * bf_lo(o1.y) + e2 * bf_lo(o2.y), e0 * bf_hi(o0.y) + e1 * bf_hi(o1.y) + e2 * bf_hi(o2.y));
                r.z = cvt_pk_bf16(e0 * bf_lo(o0.z) + e1 * bf_lo(o1.z) + e2 * bf_lo(o2.z), e0 * bf_hi(o0.z) + e1 * bf_hi(o1.z) + e2 * bf_hi(o2.z));
                r.w = cvt_pk_bf16(e0 * bf_lo(o0.w) + e1 * bf_lo(o1.w) + e2 * bf_lo(o2.w), e0 * bf_hi(o0.w) + e1 * bf_hi(o1.w) + e2 * bf_hi(o2.w));
                *(u32x4*)(ya + (size_t)tok * 256 + j * 64 + d8 * 8) = r;
            }
#endif
        }
        if (sync && lst + 2 < ph_hi) grid_seam((unsigned*)(a.ws + WS_BAR), (++nseam) * (unsigned)G);
    }
    if (ph_hi > 25) {
        int tid = threadIdx.x; asm volatile("" : "+v"(tid));
        const int lane = tid & 63, wave = __builtin_amdgcn_readfirstlane(tid >> 6);
        const int gw = bid * 8 + wave, NGW = G * 8; const float* fn = a.in[22]; const float* rs6 = (const float*)(a.ws + WS_ROWSS) + (size_t)6 * NT; float* X = a.out;
        const int xcd = bid & 7, slot = bid >> 3, nslot = G >> 3;
        for (int m = xcd * SEQ + slot * 8 + wave; m < (xcd + 1) * SEQ; m += nslot * 8) {
            const float rs = rsqrtf(rs6[m] * (1.0f / 1024.0f) + 1e-6f);
            f32x4* xr = (f32x4*)(X + (size_t)m * DM) + lane; const f32x4* gr = (const f32x4*)fn + lane;
#pragma unroll
            for (int jj = 0; jj < 4; ++jj) { const f32x4 v = xr[64 * jj]; xr[64 * jj] = v * rs * gr[64 * jj]; }
        }
    }
}

extern "C" void kernel_launch(void* const* d_in, const int* in_sizes, int n_in, void* d_out, int out_size, void* d_ws, size_t ws_size, hipStream_t stream) {
    static int grid = 0;
    if (grid == 0) {
        if (n_in != 23 || in_sizes[0] != NT * DM || out_size != NT * DM || ws_size < WS_END) { fprintf(stderr, "kernel_launch: unexpected problem (n_in %d, in0 %d, out %d, ws %zu)\n", n_in, n_in > 0 ? in_sizes[0] : -1, out_size, ws_size); grid = -1; return; }
        int dev = 0, cus = 0, per_cu = 0;
        if (hipGetDevice(&dev) != hipSuccess || hipDeviceGetAttribute(&cus, hipDeviceAttributeMultiprocessorCount, dev) != hipSuccess) { grid = -1; return; }
        if (hipFuncSetAttribute((const void*)mega_fwd, hipFuncAttributeMaxDynamicSharedMemorySize, LDS_BYTES) != hipSuccess) { fprintf(stderr, "kernel_launch: hipFuncSetAttribute failed\n"); grid = -1; return; }
        if (hipOccupancyMaxActiveBlocksPerMultiprocessor(&per_cu, (const void*)mega_fwd, NTHREADS, LDS_BYTES) != hipSuccess || per_cu < 1) { fprintf(stderr, "kernel_launch: occupancy query says %d\n", per_cu); per_cu = 1; }
        (void)hipGetLastError();
        grid = cus & ~7;
    }
    if (grid < 0) return;
    (void)hipMemsetAsync((char*)d_ws + WS_BAR, 0, 256, stream);
    Args a{};
    for (int i = 0; i < 23; ++i) a.in[i] = (const float*)d_in[i];
    a.out = (float*)d_out; a.ws = (unsigned char*)d_ws;
#ifndef MK_N_LAUNCHES
#define MK_N_LAUNCHES 1
#endif
#if MK_N_LAUNCHES == 1
    a.ph_lo = 0; a.ph_hi = 26;
    void* args[] = {&a};
    hipError_t e = hipLaunchCooperativeKernel((const void*)mega_fwd, dim3(grid), dim3(NTHREADS), args, LDS_BYTES, stream);
    if (e != hipSuccess) fprintf(stderr, "cooperative launch failed: %s (grid %d)\n", hipGetErrorString(e), grid);
#else
    for (int ph = 0; ph < 26; ++ph) {
        int hi = ph + 1; const int stp = (ph >= 1 && ph <= 24) ? (ph - 1) % 12 : -1; if (stp == 6) hi = ph + 3;
        a.ph_lo = ph; a.ph_hi = hi;
        hipLaunchKernelGGL(mega_fwd, dim3(grid), dim3(NTHREADS), LDS_BYTES, stream, a);
        ph = hi - 1;
    }
#endif
}
```

```cpp
#include <hip/hip_runtime.h>
#include <hip/hip_cooperative_groups.h>
#include <cstdio>
#include <cstdint>
namespace pg8 {
#define PG8_LAS __attribute__((address_space(3)))
typedef unsigned short bf16_t;
typedef short bf16x8 __attribute__((ext_vector_type(8)));
typedef float f32x4 __attribute__((ext_vector_type(4)));
typedef unsigned u32x4 __attribute__((ext_vector_type(4)));
constexpr int BM = 256, BK = 64, HALF = 128, HTB = HALF * BK * 2  , STAGE_BYTES = 8 * HTB, NXCD = 8, WGM = 8;

__host__ __device__ __forceinline__ int lds_byte(int r, int c) { const int st = (r >> 4) * 2 + (c >> 5), rr = r & 15, cc = c & 31, ob = rr * 64 + cc * 2; return st * 1024 + (ob ^ (((ob >> 9) & 1) << 5)); }
__host__ __device__ __forceinline__ void stage_rc(int b, int& R, int& C) { const int st = b / 1024, sb = b % 1024, swz = sb ^ (((sb >> 9) & 1) << 5); R = (st >> 1) * 16 + swz / 64; C = (st & 1) * 32 + (swz % 64) / 2; }
__host__ __device__ __forceinline__ int perm32(int rho) { const int n = rho >> 4, i = rho & 15; return 8 * (i >> 2) + 4 * n + (i & 3); }

struct Unit { int pm, pn; };
struct Gemm { const bf16_t* A; const bf16_t* Bt; int M, N, K; };

struct StaticOrder {
    int nM, nN, nwg, G, c;
    __host__ __device__ void init(int M, int N, int G_, int c_) { nM = M / BM; nN = N / BM; nwg = nM * nN; G = G_; c = c_; }
    __host__ __device__ bool next(int i, Unit& u) const {
        const long L = (long)i * G + c; if (L >= nwg) return false;
        int wgid = (int)L; { const int q = nwg / NXCD, r = nwg % NXCD, xcd = wgid % NXCD, off = wgid / NXCD; wgid = (xcd < r ? xcd * (q + 1) : r * (q + 1) + (xcd - r) * q) + off; }
        const int nig = WGM * nN, gid = wgid / nig, fm = gid * WGM, gsz = (nM - fm) < WGM ? (nM - fm) : WGM;
        u.pm = fm + ((wgid % nig) % gsz); u.pn = (wgid % nig) / gsz; return true;
    }
    __device__ __forceinline__ void a_ready(const Unit&) const {}
    __device__ __forceinline__ void done(const Unit&) const {}
};

typedef float f32x2 __attribute__((ext_vector_type(2)));
typedef __bf16 bf16x2_c __attribute__((ext_vector_type(2)));
__device__ __forceinline__ unsigned cvt_pk_bf16(float lo, float hi) { const f32x2 v = {lo, hi}; const bf16x2_c b = __builtin_convertvector(v, bf16x2_c); return __builtin_bit_cast(unsigned, b); }
__device__ __forceinline__ f32x2 gelu_pk(f32x2 v) {
    const f32x2 av = __builtin_elementwise_abs(v), d = av * 0.2316418882f + 1.0f;
    f32x2 t; t.x = __builtin_amdgcn_rcpf(d.x); t.y = __builtin_amdgcn_rcpf(d.y);
    f32x2 q = t * 0.5307027145f + (-0.7265760135f); q = q * t + 0.7107068705f; q = q * t + (-0.142248368f); q = q * t + 0.127414796f; q = q * t;
    const f32x2 s = (v * v) * (-0.72134752044f);
    f32x2 e; e.x = __builtin_amdgcn_exp2f(s.x); e.y = __builtin_amdgcn_exp2f(s.y);
    const f32x2 m = v * (q * e), r = v - m;
    f32x2 o; o.x = v.x < 0.f ? m.x : r.x; o.y = v.y < 0.f ? m.y : r.y; return o;
}
typedef unsigned u32x2 __attribute__((ext_vector_type(2)));
__device__ __forceinline__ float bf_lo(unsigned u) { return __uint_as_float(u << 16); }
__device__ __forceinline__ float bf_hi(unsigned u) { return __uint_as_float(u & 0xffff0000u); }
__device__ __forceinline__ float sigmoidf_(float v) { return __builtin_amdgcn_rcpf(1.0f + __expf(-v)); }
constexpr float RMS_EPS = 1e-6f;
__device__ __forceinline__ float rstd_of(const float* part, int r) {
    const f32x4* p = (const f32x4*)(part + (size_t)r * 16); const f32x4 a = p[0], b = p[1], c = p[2], d = p[3];
    const float s = ((a[0] + a[1]) + (a[2] + a[3])) + ((b[0] + b[1]) + (b[2] + b[3])) + (((c[0] + c[1]) + (c[2] + c[3])) + ((d[0] + d[1]) + (d[2] + d[3])));
    return rsqrtf(s * (1.0f / 1024.0f) + RMS_EPS);
}
enum { EM_SWIGLU = 0, EM_RESID = 1, EM_Z1 = 2, EM_GATE = 3, EM_PROJ0 = 4, EM_PROJ1 = 5 };
struct EpiMix {
    static constexpr bool PERM = true, AFTER_DRAIN = false;
    int mode;
    float* rs;
    const void* aux;
    bf16_t* ob; int ldo;
    __device__ __forceinline__ void operator()(const f32x4 (&acc)[2][2][4][2], const Unit& u, int wr, int wc, int fr, int fq) const {
        const int row0 = u.pm * BM + wr * 64 + fr;
        const int cw = wc * 32 + 8 * fq;
        const float* rowss = rs; float* rowss_out = rs; const float* xin = (const float*)aux; const float* bias = (const float*)aux; const bf16_t* gate = (const bf16_t*)aux;
        if (mode == EM_SWIGLU) {
#pragma unroll
            for (int ai = 0; ai < 2; ++ai)
#pragma unroll
                for (int m = 0; m < 4; ++m) {
                    const int r = row0 + ai * HALF + m * 16;
                    const float rs = rstd_of(rowss, r);
                    float h[8];
#pragma unroll
                    for (int n = 0; n < 2; ++n)
#pragma unroll
                        for (int e = 0; e < 4; ++e) { const float g = acc[ai][0][m][n][e] * rs, up = acc[ai][1][m][n][e] * rs; h[n * 4 + e] = g * sigmoidf_(g) * up; }
                    u32x4 w; w.x = cvt_pk_bf16(h[0], h[1]); w.y = cvt_pk_bf16(h[2], h[3]); w.z = cvt_pk_bf16(h[4], h[5]); w.w = cvt_pk_bf16(h[6], h[7]);
                    *(u32x4*)(ob + (size_t)r * ldo + u.pn * HALF + cw) = w;
                }
        } else if (mode == EM_RESID) {
#pragma unroll
            for (int ai = 0; ai < 2; ++ai)
#pragma unroll
                for (int m = 0; m < 4; ++m) {
                    const int r = row0 + ai * HALF + m * 16; float ss = 0.f;
#pragma unroll
                    for (int bj = 0; bj < 2; ++bj) {
                        const size_t off = (size_t)r * 1024 + u.pn * BM + bj * HALF + cw;
                        f32x4 x0, x1;
                        if (xin) { x0 = *(const f32x4*)(xin + off); x1 = *(const f32x4*)(xin + off + 4); }
                        else { const u32x4 xo = *(const u32x4*)(ob + off); x0 = (f32x4){bf_lo(xo.x), bf_hi(xo.x), bf_lo(xo.y), bf_hi(xo.y)}; x1 = (f32x4){bf_lo(xo.z), bf_hi(xo.z), bf_lo(xo.w), bf_hi(xo.w)}; }
                        const f32x4 v0 = x0 + acc[ai][bj][m][0], v1 = x1 + acc[ai][bj][m][1];
                        u32x4 w; w.x = cvt_pk_bf16(v0[0], v0[1]); w.y = cvt_pk_bf16(v0[2], v0[3]); w.z = cvt_pk_bf16(v1[0], v1[1]); w.w = cvt_pk_bf16(v1[2], v1[3]);
                        *(u32x4*)(ob + off) = w;
                        ss += (v0[0] * v0[0] + v0[1] * v0[1]) + (v0[2] * v0[2] + v0[3] * v0[3]) + (v1[0] * v1[0] + v1[1] * v1[1]) + (v1[2] * v1[2] + v1[3] * v1[3]);
                    }
                    ss += __shfl_xor(ss, 16); ss += __shfl_xor(ss, 32);
                    if (fq == 0) rowss_out[(size_t)r * 16 + u.pn * 4 + wc] = ss;
                }
        } else if (mode == EM_Z1) {
            const float sc = (u.pn < 3) ? 0.125f : 1.0f; const bool act = (u.pn >= 9 && u.pn <= 12);
#pragma unroll
            for (int ai = 0; ai < 2; ++ai)
#pragma unroll
                for (int m = 0; m < 4; ++m) {
                    const int r = row0 + ai * HALF + m * 16;
                    const float rs = rstd_of(rowss, r) * sc;
#pragma unroll
                    for (int bj = 0; bj < 2; ++bj) {
                        f32x4 v0 = acc[ai][bj][m][0] * rs, v1 = acc[ai][bj][m][1] * rs;
                        if (act) { const f32x2 a = gelu_pk((f32x2){v0[0], v0[1]}), b = gelu_pk((f32x2){v0[2], v0[3]}), c = gelu_pk((f32x2){v1[0], v1[1]}), d = gelu_pk((f32x2){v1[2], v1[3]});
                            v0 = (f32x4){a.x, a.y, b.x, b.y}; v1 = (f32x4){c.x, c.y, d.x, d.y}; }
                        u32x4 w; w.x = cvt_pk_bf16(v0[0], v0[1]); w.y = cvt_pk_bf16(v0[2], v0[3]); w.z = cvt_pk_bf16(v1[0], v1[1]); w.w = cvt_pk_bf16(v1[2], v1[3]);
                        *(u32x4*)(ob + (size_t)r * ldo + u.pn * BM + bj * HALF + cw) = w;
                    }
                }
        } else if (mode == EM_GATE) {
#pragma unroll
            for (int ai = 0; ai < 2; ++ai)
#pragma unroll
                for (int m = 0; m < 4; ++m) {
                    const int r = row0 + ai * HALF + m * 16;
                    const float rs = rstd_of(rowss, r);
#pragma unroll
                    for (int bj = 0; bj < 2; ++bj) {
                        const int c = u.pn * BM + bj * HALF + cw;
                        const f32x4 b0 = *(const f32x4*)(bias + c), b1 = *(const f32x4*)(bias + c + 4);
                        const f32x4 v0 = acc[ai][bj][m][0] * rs + b0, v1 = acc[ai][bj][m][1] * rs + b1;
                        u32x4 w; w.x = cvt_pk_bf16(sigmoidf_(v0[0]), sigmoidf_(v0[1])); w.y = cvt_pk_bf16(sigmoidf_(v0[2]), sigmoidf_(v0[3]));
                        w.z = cvt_pk_bf16(sigmoidf_(v1[0]), sigmoidf_(v1[1])); w.w = cvt_pk_bf16(sigmoidf_(v1[2]), sigmoidf_(v1[3]));
                        *(u32x4*)(ob + (size_t)r * ldo + c) = w;
                    }
                }
        } else {
            const bool accum = (mode == EM_PROJ1);
#pragma unroll
            for (int ai = 0; ai < 2; ++ai)
#pragma unroll
                for (int m = 0; m < 4; ++m) {
                    const int r = row0 + ai * HALF + m * 16;
#pragma unroll
                    for (int bj = 0; bj < 2; ++bj) {
                        const int c = u.pn * BM + bj * HALF + cw;
                        const u32x4 gv = *(const u32x4*)(gate + (size_t)r * 3072 + c);
                        bf16_t* op = ob + (size_t)r * 1024 + c;
                        u32x4 old = (u32x4){0u, 0u, 0u, 0u}; if (accum) old = *(const u32x4*)op;
                        const f32x4 a0 = acc[ai][bj][m][0], a1 = acc[ai][bj][m][1];
                        u32x4 w;
                        w.x = cvt_pk_bf16(bf_lo(old.x) + bf_lo(gv.x) * a0[0], bf_hi(old.x) + bf_hi(gv.x) * a0[1]);
                        w.y = cvt_pk_bf16(bf_lo(old.y) + bf_lo(gv.y) * a0[2], bf_hi(old.y) + bf_hi(gv.y) * a0[3]);
                        w.z = cvt_pk_bf16(bf_lo(old.z) + bf_lo(gv.z) * a1[0], bf_hi(old.z) + bf_hi(gv.z) * a1[1]);
                        w.w = cvt_pk_bf16(bf_lo(old.w) + bf_lo(gv.w) * a1[2], bf_hi(old.w) + bf_hi(gv.w) * a1[3]);
                        *(u32x4*)op = w;
                    }
                }
        }
    }
};

template <class Epi, class Sched, bool ALIGN_EPI = false, bool SP2 = false>
__device__ __forceinline__ void gemm_phase(PG8_LAS unsigned char* lds, const Gemm g, const Sched& S, const Epi& E) {
    const int tid = threadIdx.x, wid = __builtin_amdgcn_readfirstlane(tid >> 6), lane = tid & 63, wr = wid >> 2, wc = wid & 3, fr = lane & 15, fq = lane >> 4;
    const int K = g.K, nt = K / BK;
    unsigned voffA[2], voffB[2];
#pragma unroll
    for (int i = 0; i < 2; ++i) { int R, C; stage_rc(tid * 16 + i * 8192, R, C); const int Rb = Epi::PERM ? ((R & ~31) + perm32(R & 31)) : R;
        voffA[i] = (unsigned)(R * K + C) * 2u; voffB[i] = (unsigned)(Rb * K + C) * 2u; }
    const size_t kstep = (size_t)(BK * 2);
    const size_t hstep = (size_t)HALF * K * 2;
    const size_t tstep = 2 * hstep;
    const unsigned ldsw = (unsigned)wid * 1024u;
    const int aoff = lds_byte(wr * 64 + fr, fq * 8), boff = lds_byte(wc * 32 + fr, fq * 8);
#define PG8_SA(b, h) (((b) * 2 + (h)) * HTB)
#define PG8_SB(b, h) ((4 + (b) * 2 + (h)) * HTB)
#define PG8_STAGE(bufoff, gbase, voff) do { _Pragma("unroll") for (int _i = 0; _i < 2; ++_i) \
        __builtin_amdgcn_global_load_lds((const unsigned*)((const char*)(gbase) + (voff)[_i]), (PG8_LAS unsigned*)(lds + (bufoff) + ldsw + _i * 8192), 16, 0, 0); } while (0)
#define PG8_LDA(dst, b, h) do { _Pragma("unroll") for (int m = 0; m < 4; ++m) _Pragma("unroll") for (int k = 0; k < 2; ++k) dst[m][k] = *(const PG8_LAS bf16x8*)(lds + PG8_SA(b, h) + aoff + m * 2048 + k * 1024); } while (0)
#define PG8_LDB(dst, b, h) do { _Pragma("unroll") for (int n = 0; n < 2; ++n) _Pragma("unroll") for (int k = 0; k < 2; ++k) dst[n][k] = *(const PG8_LAS bf16x8*)(lds + PG8_SB(b, h) + boff + n * 2048 + k * 1024); } while (0)
#define PG8_MMA(ai, bj, At, Bt) do { __builtin_amdgcn_s_setprio(1); _Pragma("unroll") for (int m = 0; m < 4; ++m) _Pragma("unroll") for (int n = 0; n < 2; ++n) _Pragma("unroll") for (int k = 0; k < 2; ++k) \
        acc[ai][bj][m][n] = __builtin_amdgcn_mfma_f32_16x16x32_bf16(Bt[n][k], At[m][k], acc[ai][bj][m][n], 0, 0, 0); __builtin_amdgcn_s_setprio(0); } while (0)
#define PG8_WAIT_V(n) asm volatile("s_waitcnt vmcnt(" #n ")" ::: "memory")
#define PG8_WAIT_L(n) asm volatile("s_waitcnt lgkmcnt(" #n ")" ::: "memory")
#define PG8_BAR __builtin_amdgcn_s_barrier()
#define PG8_SCHED __builtin_amdgcn_sched_barrier(0)
    Unit cur, nxt; int ui = 0;
    if (!S.next(0, cur)) return;
    f32x4 acc[2][2][4][2];
#pragma unroll
    for (int a = 0; a < 2; ++a)
#pragma unroll
        for (int b = 0; b < 2; ++b)
#pragma unroll
            for (int m = 0; m < 4; ++m)
#pragma unroll
                for (int n = 0; n < 2; ++n) acc[a][b][m][n] = (f32x4){0.f, 0.f, 0.f, 0.f};
    bf16x8 At[4][2], B0[2][2], B1[2][2];
    const char* cA = (const char*)g.A + (size_t)cur.pm * tstep; const char* cB = (const char*)g.Bt + (size_t)cur.pn * tstep;
    S.a_ready(cur);
    if constexpr (SP2) {
        PG8_STAGE(PG8_SB(0, 0), cB, voffB); PG8_STAGE(PG8_SB(0, 1), cB + hstep, voffB); PG8_STAGE(PG8_SA(0, 0), cA, voffA); PG8_STAGE(PG8_SA(0, 1), cA + hstep, voffA);
        if (wr == 1) PG8_BAR;
        PG8_WAIT_V(2); PG8_BAR;
        PG8_STAGE(PG8_SB(1, 0), cB + kstep, voffB); PG8_STAGE(PG8_SA(1, 0), cA + kstep, voffA); PG8_STAGE(PG8_SB(1, 1), cB + hstep + kstep, voffB);
        PG8_WAIT_V(6); PG8_BAR;
    } else {
        PG8_STAGE(PG8_SB(0, 0), cB, voffB); PG8_STAGE(PG8_SA(0, 0), cA, voffA); PG8_STAGE(PG8_SB(0, 1), cB + hstep, voffB); PG8_STAGE(PG8_SA(0, 1), cA + hstep, voffA);
        if (wr == 1) PG8_BAR;
        PG8_WAIT_V(4); PG8_BAR;
        PG8_STAGE(PG8_SB(1, 0), cB + kstep, voffB); PG8_STAGE(PG8_SA(1, 0), cA + kstep, voffA); PG8_STAGE(PG8_SB(1, 1), cB + hstep + kstep, voffB);
        PG8_WAIT_V(6); PG8_BAR;
    }
    for (;;) {
        const bool has_next = S.next(ui + 1, nxt);
        const char* nA = has_next ? (const char*)g.A + (size_t)nxt.pm * tstep : cA; const char* nB = has_next ? (const char*)g.Bt + (size_t)nxt.pn * tstep : cB;
        for (int t = 0; t < nt; t += 2) {
            const bool last = (t == nt - 2);
            const char* a1 = cA + (size_t)(t + 1) * kstep;
            const char* a2 = last ? nA : cA + (size_t)(t + 2) * kstep; const char* b2 = last ? nB : cB + (size_t)(t + 2) * kstep;
            const char* a3 = a2 + kstep; const char* b3 = b2 + kstep;
            if (last && has_next) S.a_ready(nxt);
            if constexpr (SP2) {
            PG8_LDB(B0, 0, 0); PG8_LDB(B1, 0, 1); PG8_SCHED; PG8_LDA(At, 0, 0); PG8_STAGE(PG8_SA(1, 1), a1 + hstep, voffA);
            PG8_WAIT_V(8); PG8_WAIT_L(0); PG8_BAR; PG8_MMA(0, 0, At, B0); PG8_MMA(0, 1, At, B1); PG8_BAR; PG8_SCHED;
            PG8_LDA(At, 0, 1); PG8_STAGE(PG8_SB(0, 0), b2, voffB); PG8_STAGE(PG8_SB(0, 1), b2 + hstep, voffB); PG8_STAGE(PG8_SA(0, 0), a2, voffA);
            PG8_WAIT_V(8); PG8_WAIT_L(0); PG8_BAR; PG8_MMA(1, 0, At, B0); PG8_MMA(1, 1, At, B1); PG8_BAR; PG8_SCHED;
            PG8_LDB(B0, 1, 0); PG8_LDB(B1, 1, 1); PG8_SCHED; PG8_LDA(At, 1, 0); PG8_STAGE(PG8_SA(0, 1), a2 + hstep, voffA);
            PG8_WAIT_V(8); PG8_WAIT_L(0); PG8_BAR; PG8_MMA(0, 0, At, B0); PG8_MMA(0, 1, At, B1); PG8_BAR; PG8_SCHED;
            PG8_LDA(At, 1, 1); PG8_STAGE(PG8_SB(1, 0), b3, voffB); PG8_STAGE(PG8_SB(1, 1), b3 + hstep, voffB); PG8_STAGE(PG8_SA(1, 0), a3, voffA);
            PG8_WAIT_V(8); PG8_WAIT_L(0); PG8_BAR; PG8_MMA(1, 0, At, B0); PG8_MMA(1, 1, At, B1); PG8_BAR; PG8_SCHED;
            } else {
            PG8_LDB(B0, 0, 0); PG8_SCHED; PG8_LDA(At, 0, 0); PG8_STAGE(PG8_SA(1, 1), a1 + hstep, voffA);
            PG8_WAIT_L(8); PG8_BAR; PG8_WAIT_L(0); PG8_MMA(0, 0, At, B0); PG8_BAR; PG8_SCHED;
            PG8_LDB(B1, 0, 1); PG8_STAGE(PG8_SB(0, 0), b2, voffB);
            PG8_BAR; PG8_WAIT_L(0); PG8_MMA(0, 1, At, B1); PG8_BAR;
            PG8_LDA(At, 0, 1); PG8_STAGE(PG8_SA(0, 0), a2, voffA);
            PG8_BAR; PG8_WAIT_L(0); PG8_MMA(1, 0, At, B0); PG8_BAR; PG8_SCHED;
            PG8_STAGE(PG8_SB(0, 1), b2 + hstep, voffB);
            PG8_WAIT_V(6); PG8_BAR; PG8_MMA(1, 1, At, B1); PG8_BAR;
            PG8_LDB(B0, 1, 0); PG8_SCHED; PG8_LDA(At, 1, 0); PG8_STAGE(PG8_SA(0, 1), a2 + hstep, voffA);
            PG8_WAIT_L(8); PG8_BAR; PG8_WAIT_L(0); PG8_MMA(0, 0, At, B0); PG8_BAR; PG8_SCHED;
            PG8_LDB(B1, 1, 1); PG8_STAGE(PG8_SB(1, 0), b3, voffB);
            PG8_BAR; PG8_WAIT_L(0); PG8_MMA(0, 1, At, B1); PG8_BAR;
            PG8_LDA(At, 1, 1); PG8_STAGE(PG8_SA(1, 0), a3, voffA);
            PG8_BAR; PG8_WAIT_L(0); PG8_MMA(1, 0, At, B0); PG8_BAR; PG8_SCHED;
            PG8_STAGE(PG8_SB(1, 1), b3 + hstep, voffB);
            PG8_WAIT_V(6); PG8_BAR; PG8_MMA(1, 1, At, B1); PG8_BAR;
            }
        }
        if constexpr (ALIGN_EPI) { if (wr == 0) PG8_BAR; }
        if constexpr (!Epi::AFTER_DRAIN) { E(acc, cur, wr, wc, fr, fq); S.done(cur); }
        if (!has_next) break;
#pragma unroll
        for (int a = 0; a < 2; ++a)
#pragma unroll
            for (int b = 0; b < 2; ++b)
#pragma unroll
                for (int m = 0; m < 4; ++m)
#pragma unroll
                    for (int n = 0; n < 2; ++n) acc[a][b][m][n] = (f32x4){0.f, 0.f, 0.f, 0.f};
        cur = nxt; cA = nA; cB = nB; ++ui;
        if constexpr (ALIGN_EPI) { if (wr == 1) PG8_BAR; }
    }
    PG8_WAIT_V(0);
    if constexpr (!ALIGN_EPI) { if (wr == 0) PG8_BAR; }
    PG8_BAR;
    if constexpr (Epi::AFTER_DRAIN) { E.fused(acc, cur, wr, wc, fr, fq, lds, wid, lane); S.done(cur); }
#undef PG8_SA
#undef PG8_SB
#undef PG8_STAGE
#undef PG8_LDA
#undef PG8_LDB
#undef PG8_MMA
#undef PG8_WAIT_V
#undef PG8_WAIT_L
#undef PG8_BAR
#undef PG8_SCHED
}
}
namespace cg = cooperative_groups;
#define LAS __attribute__((address_space(3)))
using pg8::bf16_t; using pg8::bf16x8; using pg8::f32x4; using pg8::u32x4; using pg8::u32x2; using pg8::f32x2;
using pg8::bf_lo; using pg8::bf_hi;
using pg8::cvt_pk_bf16;

constexpr int NT = 32768, DM = 1024, FF = 2816, SEQ = 4096;
constexpr int ZP = 3840;
constexpr int NTHREADS = 512, LDS_BYTES = 131072;
constexpr size_t MiB = 1u << 20;
constexpr size_t WS_ROWSS = 0;
constexpr size_t WS_BAR = 960 * 1024;
constexpr size_t WS_LSE = 1 * MiB;
constexpr size_t WS_WST = 3 * MiB;
constexpr size_t WS_WCT = 3 * MiB + 256 * 1024;
constexpr size_t WS_W = 4 * MiB;
constexpr size_t W_LAYER = 26738688;
constexpr size_t WO_GU1 = 0, WO_D1 = 5767168, WO_IN = 8650752, WO_PA = 15728640, WO_PB = 15990784, WO_PC = 16515072, WO_OUT = 17039360, WO_GU2 = 18087936, WO_D2 = 23855104;
constexpr size_t WS_XB = 106 * MiB;
constexpr size_t WS_YA = 170 * MiB, WS_YB = 186 * MiB, WS_YC = 218 * MiB;
constexpr size_t WS_A = 250 * MiB;
constexpr size_t WS_MERGED = WS_A + 192 * MiB;
constexpr size_t WS_RS6 = 506 * MiB;
constexpr size_t WS_END = 508 * MiB;

__device__ __forceinline__ float wave_sum(float v) {
#pragma unroll
    for (int o = 1; o < 64; o <<= 1) v += __shfl_xor(v, o);
    return v;
}
__device__ __forceinline__ f32x4 mfma16(bf16x8 a, bf16x8 b, f32x4 c) { return __builtin_amdgcn_mfma_f32_16x16x32_bf16(a, b, c, 0, 0, 0); }

__device__ __forceinline__ void transpose_item(const float* W, int K, int N, bf16_t* WT, int n0, int drow0, int k0, const float* kscale, float cs, LAS float* scr, int lane) {
    const int kr = lane >> 3, n4 = (lane & 7) * 4;
    f32x4 v[8]; float sc[8];
#pragma unroll
    for (int i = 0; i < 8; ++i) { v[i] = *(const f32x4*)(W + (size_t)(k0 + 8 * i + kr) * N + n0 + n4); sc[i] = kscale ? kscale[k0 + 8 * i + kr] * cs : cs; }
#pragma unroll
    for (int i = 0; i < 8; ++i) { LAS float* d = scr + (8 * i + kr) * 33 + n4; d[0] = v[i][0] * sc[i]; d[1] = v[i][1] * sc[i]; d[2] = v[i][2] * sc[i]; d[3] = v[i][3] * sc[i]; }
    asm volatile("s_waitcnt lgkmcnt(0)" ::: "memory");
    const int c = lane & 7;
#pragma unroll
    for (int j = 0; j < 4; ++j) { const int n = (lane >> 3) + 8 * j; const LAS float* s = scr + (8 * c) * 33 + n;
        u32x4 o; o.x = cvt_pk_bf16(s[0 * 33], s[1 * 33]); o.y = cvt_pk_bf16(s[2 * 33], s[3 * 33]); o.z = cvt_pk_bf16(s[4 * 33], s[5 * 33]); o.w = cvt_pk_bf16(s[6 * 33], s[7 * 33]);
        *(u32x4*)(WT + (size_t)(drow0 + n) * K + k0 + 8 * c) = o; }
    asm volatile("s_waitcnt lgkmcnt(0)" ::: "memory");
}

__device__ __forceinline__ void mm128(const LAS unsigned char* A, const LAS unsigned char* B, int w, int fr, int fq, f32x4 (&acc)[8]) {
    bf16x8 bw[4];
#pragma unroll
    for (int ks = 0; ks < 4; ++ks) bw[ks] = *(const LAS bf16x8*)(B + (16 * w + fr) * 272 + ks * 64 + fq * 16);
#pragma unroll
    for (int ct = 0; ct < 8; ++ct) {
        f32x4 c = (f32x4){0.f, 0.f, 0.f, 0.f};
#pragma unroll
        for (int ks = 0; ks < 4; ++ks) { const bf16x8 a = *(const LAS bf16x8*)(A + (16 * ct + fr) * 272 + ks * 64 + fq * 16); c = mfma16(a, bw[ks], c); }
        acc[ct] = c;
    }
}

struct AttnRegs { u32x4 kv[4], vv[4]; bf16x8 q0, q1; };
__device__ __forceinline__ void attn_decode(int k, int xcd, int& g, int& j, int& sh, int& r, int& n) {
    g = k >> 7; j = (k >> 5) & 3; const int rn = k & 31; sh = 2 * g; r = rn >> (5 - sh); n = rn & ((32 >> sh) - 1); (void)xcd;
}
__device__ __forceinline__ void attn_load(AttnRegs& R, const bf16_t* Z1, int k, int xcd, int tid, int w, int fr, int fq) {
    int g, j, sh, r, n; attn_decode(k, xcd, g, j, sh, r, n);
    const int colq = g * 256 + j * 64; const size_t tok_b = (size_t)xcd * SEQ + r;
#pragma unroll
    for (int it = 0; it < 4; ++it) {
        const int c = tid + NTHREADS * it; const int key = c & 255, dc = c >> 8;
        const int p = (n - 1) * 128 + key; const int pc = p < 0 ? 0 : p;
        const bf16_t* src = Z1 + (tok_b + ((size_t)pc << sh)) * ZP + colq + dc * 8;
        R.kv[it] = *(const u32x4*)(src + 768); R.vv[it] = *(const u32x4*)(src + 1536);
    }
    const bf16_t* qp = Z1 + (tok_b + ((size_t)(n * 128 + 16 * w + fr) << sh)) * ZP + colq;
    R.q0 = *(const bf16x8*)(qp + fq * 8); R.q1 = *(const bf16x8*)(qp + 32 + fq * 8);
}
__device__ __forceinline__ void attn_stage(const AttnRegs& R, LAS unsigned char* lds, int k, int xcd, int tid) {
    int g, j, sh, r, n; attn_decode(k, xcd, g, j, sh, r, n);
#pragma unroll
    for (int it = 0; it < 4; ++it) {
        const int c = tid + NTHREADS * it; const int key = c & 255, dc = c >> 8;
        const bool ok = ((n - 1) * 128 + key) >= 0; const u32x4 z = (u32x4){0u, 0u, 0u, 0u};
        const u32x4 kv = ok ? R.kv[it] : z, vv = ok ? R.vv[it] : z;
        *(LAS u32x4*)(lds + key * 144 + dc * 16) = kv;
        const int k32 = key & 31; const int pos = (key & ~31) + 8 * ((k32 & 15) >> 2) + 4 * (k32 >> 4) + (k32 & 3);
        LAS bf16_t* vt = (LAS bf16_t*)(lds + 36864) + (dc * 8) * 264 + pos;
        vt[0 * 264] = (bf16_t)(vv.x & 0xffffu); vt[1 * 264] = (bf16_t)(vv.x >> 16); vt[2 * 264] = (bf16_t)(vv.y & 0xffffu); vt[3 * 264] = (bf16_t)(vv.y >> 16);
        vt[4 * 264] = (bf16_t)(vv.z & 0xffffu); vt[5 * 264] = (bf16_t)(vv.z >> 16); vt[6 * 264] = (bf16_t)(vv.w & 0xffffu); vt[7 * 264] = (bf16_t)(vv.w >> 16);
    }
}
__device__ __forceinline__ void attn_compute(LAS unsigned char* lds, bf16_t* Z1, float* lse, int k, int xcd, bf16x8 q0, bf16x8 q1, int w, int fr, int fq, bool dostore = true) {
    int g, j, sh, r, n; attn_decode(k, xcd, g, j, sh, r, n);
    const int colq = g * 256 + j * 64; const size_t tok_b = (size_t)xcd * SEQ + r; const int qi = 16 * w + fr;
    bf16_t* qp = Z1 + (tok_b + ((size_t)(n * 128 + qi) << sh)) * ZP + colq;
    const int kt0 = (w < 6 ? w : 6) & ~1;
    f32x4 s[10];
#pragma unroll
    for (int t = 0; t < 10; ++t) {
        const LAS unsigned char* kp = lds + (16 * (kt0 + t) + fr) * 144 + fq * 16;
        const bf16x8 a0 = *(const LAS bf16x8*)kp, a1 = *(const LAS bf16x8*)(kp + 64);
        s[t] = mfma16(a0, q0, (f32x4){0.f, 0.f, 0.f, 0.f}); s[t] = mfma16(a1, q1, s[t]);
    }
    constexpr float L2E = 1.4426950408889634f;
    float mx = -1e30f;
#pragma unroll
    for (int t = 0; t < 10; ++t)
#pragma unroll
        for (int i = 0; i < 4; ++i) {
            const int kj = 16 * (kt0 + t) + 4 * fq + i; const int dist = qi + 128 - kj;
            const bool valid = (dist >= 0) && (dist <= 128) && !(n == 0 && kj < 128);
            const float v = valid ? s[t][i] * L2E : -1e30f; s[t][i] = v; mx = fmaxf(mx, v);
        }
    mx = fmaxf(mx, __shfl_xor(mx, 16)); mx = fmaxf(mx, __shfl_xor(mx, 32));
    float l = 0.f;
#pragma unroll
    for (int t = 0; t < 10; ++t)
#pragma unroll
        for (int i = 0; i < 4; ++i) { const float p = __builtin_amdgcn_exp2f(s[t][i] - mx); s[t][i] = p; l += p; }
    l += __shfl_xor(l, 16); l += __shfl_xor(l, 32);
    f32x4 o[4];
#pragma unroll
    for (int dt = 0; dt < 4; ++dt) o[dt] = (f32x4){0.f, 0.f, 0.f, 0.f};
#pragma unroll
    for (int G = 0; G < 5; ++G) {
        u32x4 pw; pw.x = cvt_pk_bf16(s[2 * G][0], s[2 * G][1]); pw.y = cvt_pk_bf16(s[2 * G][2], s[2 * G][3]); pw.z = cvt_pk_bf16(s[2 * G + 1][0], s[2 * G + 1][1]); pw.w = cvt_pk_bf16(s[2 * G + 1][2], s[2 * G + 1][3]);
        const bf16x8 pb = __builtin_bit_cast(bf16x8, pw);
#pragma unroll
        for (int dt = 0; dt < 4; ++dt) {
            const bf16x8 va = *(const LAS bf16x8*)(lds + 36864 + (16 * dt + fr) * 528 + (32 * (kt0 / 2 + G) + 8 * fq) * 2);
            o[dt] = mfma16(va, pb, o[dt]);
        }
    }
    const float rl = 1.0f / l;
    if (!dostore) { if (rl == 123.456f) lse[0] = o[0][0] + o[1][1] + o[2][2] + o[3][3]; return; }
#pragma unroll
    for (int dt = 0; dt < 4; ++dt) { u32x2 wv; wv.x = cvt_pk_bf16(o[dt][0] * rl, o[dt][1] * rl); wv.y = cvt_pk_bf16(o[dt][2] * rl, o[dt][3] * rl); *(u32x2*)(qp + 16 * dt + 4 * fq) = wv; }
    if (fq == 0) lse[(size_t)((g * 4 + j) * 8 + xcd) * SEQ + r * (SEQ >> sh) + n * 128 + qi] = (mx + __log2f(l)) * 0.6931471805599453f;
}
__device__ __forceinline__ void attn_phase(LAS unsigned char* lds, bf16_t* Z1, float* lse, int xcd, int slot, int nslot, int tid, bool dostore = true) {
    asm volatile("" : "+v"(tid));
    const int lane = tid & 63, w = __builtin_amdgcn_readfirstlane(tid >> 6), fr = lane & 15, fq = lane >> 4;
    int k = slot; if (k >= 384) return;
    AttnRegs R; attn_load(R, Z1, k, xcd, tid, w, fr, fq);
    for (;;) {
        attn_stage(R, lds, k, xcd, tid);
        const bf16x8 q0 = R.q0, q1 = R.q1;
        __syncthreads();
        const int kn = k + nslot;
        if (kn < 384) attn_load(R, Z1, kn, xcd, tid, w, fr, fq);
        attn_compute(lds, Z1, lse, k, xcd, q0, q1, w, fr, fq, dostore);
        __syncthreads();
        if (kn >= 384) break;
        k = kn;
    }
}

__device__ __forceinline__ void gate_unit(LAS unsigned char* lds, const bf16_t* Z1, bf16_t* yb, const bf16_t* wsT, const float* lng, const float* lnb, const float* bbs, int ch, int tid) {
    asm volatile("" : "+v"(tid));
    const int lane = tid & 63, w = __builtin_amdgcn_readfirstlane(tid >> 6), fr = lane & 15, fq = lane >> 4;
    const size_t t0 = (size_t)ch * 128;
    LAS float* st = (LAS float*)lds;
    for (int i = 0; i < 16; ++i) {
        const int t = 16 * w + i;
        const u32x4 raw = *(const u32x4*)(Z1 + (t0 + t) * ZP + 2816 + lane * 8);
        float x[8] = {bf_lo(raw.x), bf_hi(raw.x), bf_lo(raw.y), bf_hi(raw.y), bf_lo(raw.z), bf_hi(raw.z), bf_lo(raw.w), bf_hi(raw.w)};
        float sm = 0.f;
#pragma unroll
        for (int e = 0; e < 8; ++e) sm += x[e];
        const float mean = wave_sum(sm) * (1.0f / 512.0f); float q = 0.f;
#pragma unroll
        for (int e = 0; e < 8; ++e) { const float d = x[e] - mean; q += d * d; }
        const float rstd = rsqrtf(wave_sum(q) * (1.0f / 512.0f) + 1e-6f);
        if (lane == 0) { st[2 * t] = mean; st[2 * t + 1] = rstd; }
    }
    __syncthreads();
    for (int g = 0; g < 4; ++g) {
#pragma unroll
        for (int it = 0; it < 4; ++it) {
            const int c = tid + NTHREADS * it; const int row = c >> 4, c8 = c & 15;
            *(LAS u32x4*)(lds + 1024 + row * 272 + c8 * 16) = *(const u32x4*)(wsT + (size_t)(g * 128 + row) * 128 + c8 * 8);
        }
#pragma unroll
        for (int it = 0; it < 4; ++it) {
            const int c = tid + NTHREADS * it; const int sidx = c & 127, c8 = c >> 7;
            const u32x4 raw = *(const u32x4*)(Z1 + (t0 + sidx) * ZP + 2816 + g * 128 + c8 * 8);
            const float mean = st[2 * sidx], rstd = st[2 * sidx + 1];
            const int chn = g * 128 + c8 * 8;
            const f32x4 g0 = *(const f32x4*)(lng + chn), g1 = *(const f32x4*)(lng + chn + 4), b0 = *(const f32x4*)(lnb + chn), b1 = *(const f32x4*)(lnb + chn + 4);
            const float x[8] = {bf_lo(raw.x), bf_hi(raw.x), bf_lo(raw.y), bf_hi(raw.y), bf_lo(raw.z), bf_hi(raw.z), bf_lo(raw.w), bf_hi(raw.w)};
            const float gg[8] = {g0[0], g0[1], g0[2], g0[3], g1[0], g1[1], g1[2], g1[3]}; const float bb[8] = {b0[0], b0[1], b0[2], b0[3], b1[0], b1[1], b1[2], b1[3]};
            LAS bf16_t* vt = (LAS bf16_t*)(lds + 35840) + (c8 * 8) * 136 + sidx;
#pragma unroll
            for (int e = 0; e < 8; e += 2) { const unsigned pk = cvt_pk_bf16((x[e] - mean) * rstd * gg[e] + bb[e], (x[e + 1] - mean) * rstd * gg[e + 1] + bb[e + 1]); vt[e * 136] = (bf16_t)(pk & 0xffffu); vt[(e + 1) * 136] = (bf16_t)(pk >> 16); }
        }
        __syncthreads();
        f32x4 acc[8];
        mm128(lds + 35840, lds + 1024, w, fr, fq, acc);
        const int t = 16 * w + fr; const float bias = bbs[g * 128 + t];
#pragma unroll
        for (int ct = 0; ct < 8; ++ct) {
            const int chn = g * 128 + 16 * ct + 4 * fq;
            const u32x2 uu = *(const u32x2*)(Z1 + (t0 + t) * ZP + 2304 + chn);
            u32x2 o; o.x = cvt_pk_bf16(bf_lo(uu.x) * (acc[ct][0] + bias), bf_hi(uu.x) * (acc[ct][1] + bias)); o.y = cvt_pk_bf16(bf_lo(uu.y) * (acc[ct][2] + bias), bf_hi(uu.y) * (acc[ct][3] + bias));
            *(u32x2*)(yb + (t0 + t) * 512 + chn) = o;
        }
        __syncthreads();
    }
}

__device__ __forceinline__ void pool_unit(LAS unsigned char* lds, const bf16_t* Z1, bf16_t* yc, const bf16_t* wcT, const float* cscale, int unit, int tid) {
    asm volatile("" : "+v"(tid));
    const int lane = tid & 63, w = __builtin_amdgcn_readfirstlane(tid >> 6), fr = lane & 15, fq = lane >> 4;
    const int tile = unit >> 2, gi = unit & 3; const size_t t0 = (size_t)tile * 128; const int tpos0 = (int)(t0 & (SEQ - 1)); const int win = 2 << gi;
    for (int c = tid; c < 143 * 16; c += NTHREADS) {
        const int row = c >> 4, c8 = c & 15; const int tt = row - 15;
        u32x4 v = (u32x4){0u, 0u, 0u, 0u};
        if (tpos0 + tt >= 0) v = *(const u32x4*)(Z1 + (size_t)((long)t0 + tt) * ZP + 3328 + gi * 128 + c8 * 8);
        *(LAS u32x4*)(lds + row * 272 + c8 * 16) = v;
    }
#pragma unroll
    for (int it = 0; it < 4; ++it) {
        const int c = tid + NTHREADS * it; const int row = c >> 4, c8 = c & 15;
        *(LAS u32x4*)(lds + 73728 + row * 272 + c8 * 16) = *(const u32x4*)(wcT + (size_t)(gi * 128 + row) * 128 + c8 * 8);
    }
    __syncthreads();
#pragma unroll
    for (int it = 0; it < 4; ++it) {
        const int c = tid + NTHREADS * it; const int t = c >> 4, c8 = c & 15;
        const int cnt = (tpos0 + t + 1 < win) ? (tpos0 + t + 1) : win;
        float sm[8] = {0.f, 0.f, 0.f, 0.f, 0.f, 0.f, 0.f, 0.f};
        for (int i = 0; i < cnt; ++i) { const u32x4 raw = *(const LAS u32x4*)(lds + (t + 15 - i) * 272 + c8 * 16);
            sm[0] += bf_lo(raw.x); sm[1] += bf_hi(raw.x); sm[2] += bf_lo(raw.y); sm[3] += bf_hi(raw.y); sm[4] += bf_lo(raw.z); sm[5] += bf_hi(raw.z); sm[6] += bf_lo(raw.w); sm[7] += bf_hi(raw.w); }
        const u32x4 xt = *(const LAS u32x4*)(lds + (t + 15) * 272 + c8 * 16); const float ic = 1.0f / (float)cnt;
        u32x4 o; o.x = cvt_pk_bf16(sm[0] * ic - bf_lo(xt.x), sm[1] * ic - bf_hi(xt.x)); o.y = cvt_pk_bf16(sm[2] * ic - bf_lo(xt.y), sm[3] * ic - bf_hi(xt.y));
        o.z = cvt_pk_bf16(sm[4] * ic - bf_lo(xt.z), sm[5] * ic - bf_hi(xt.z)); o.w = cvt_pk_bf16(sm[6] * ic - bf_lo(xt.w), sm[7] * ic - bf_hi(xt.w));
        *(LAS u32x4*)(lds + 38912 + t * 272 + c8 * 16) = o;
    }
    __syncthreads();
    f32x4 acc[8];
    mm128(lds + 73728, lds + 38912, w, fr, fq, acc);
    const int t = 16 * w + fr;
#pragma unroll
    for (int dt = 0; dt < 8; ++dt) {
        const int d = gi * 128 + 16 * dt + 4 * fq; const f32x4 sc = *(const f32x4*)(cscale + d);
        u32x2 o; o.x = cvt_pk_bf16(acc[dt][0] * sc[0], acc[dt][1] * sc[1]); o.y = cvt_pk_bf16(acc[dt][2] * sc[2], acc[dt][3] * sc[3]);
        *(u32x2*)(yc + (t0 + t) * 512 + d) = o;
    }
    __syncthreads();
}

__device__ __forceinline__ void grid_seam(unsigned* bar, unsigned target) {
#ifdef DBG_REP_SEAM
  for (int rep_ = 0; rep_ < 2; ++rep_) {
    target = 2 * target - (1 - rep_) * gridDim.x;
#endif
    asm volatile("s_waitcnt vmcnt(0) lgkmcnt(0)" ::: "memory");
    __syncthreads();
    if (threadIdx.x == 0) {
        __builtin_amdgcn_fence(__ATOMIC_RELEASE, "agent"); asm volatile("s_waitcnt vmcnt(0)" ::: "memory");
        __hip_atomic_fetch_add(bar, 1u, __ATOMIC_RELAXED, __HIP_MEMORY_SCOPE_AGENT);
        unsigned spins = 0;
        while (__hip_atomic_load(bar, __ATOMIC_RELAXED, __HIP_MEMORY_SCOPE_AGENT) < target) { __builtin_amdgcn_s_sleep(2); if (++spins > (1u << 24)) break; }
        __builtin_amdgcn_fence(__ATOMIC_ACQUIRE, "agent"); asm volatile("s_waitcnt vmcnt(0)" ::: "memory");
    }
    __syncthreads();
#ifdef DBG_REP_SEAM
    target = (target + (1 - rep_) * gridDim.x) / 2;
  }
#endif
}

#ifndef DBG_SEAM_ALL
#define DBG_SEAM_ALL 0
#endif
__device__ __forceinline__ float* rowss_arr(float* dout, unsigned char* ws, int k) { return k < 6 ? dout + (size_t)k * NT * 16 : (float*)(ws + WS_RS6); }
struct Args { const float* in[23]; float* out; unsigned char* ws; int ph_lo, ph_hi; };

__global__ void __launch_bounds__(NTHREADS, 2) mega_fwd(Args a) {
    extern __shared__ __attribute__((aligned(16))) unsigned char lds_raw[];
    cg::grid_group grid = cg::this_grid();
    LAS unsigned char* lds = (LAS unsigned char*)lds_raw;
    const int G = gridDim.x, bid = blockIdx.x;
    const int ph_lo = a.ph_lo, ph_hi = a.ph_hi;
    if (ph_hi - ph_lo == 26) grid.sync();

#ifdef DBG_REP_P0
    for (int rep_ = 0; rep_ < 2; ++rep_)
#endif
    if (ph_lo <= 0) {
        int tid = threadIdx.x; asm volatile("" : "+v"(tid));
        const int lane = tid & 63, wave = __builtin_amdgcn_readfirstlane(tid >> 6);
        unsigned char* ws = a.ws;
        bf16_t* Wb = (bf16_t*)(ws + WS_W); bf16_t* wcT = (bf16_t*)(ws + WS_WCT); bf16_t* wsT = (bf16_t*)(ws + WS_WST); bf16_t* xb = (bf16_t*)(ws + WS_XB); float* rowss = rowss_arr(a.out, ws, 0);
        const int gw = bid * 8 + wave, NGW = G * 8;
        LAS float* scr = (LAS float*)(lds + wave * 16384);
        for (int it0 = gw; it0 < 2 * 13056 + 64; it0 += NGW) {
            const float* src; bf16_t* dst; const float* ksc = nullptr; float cs = 1.f; int K, N, map = 0, it;
            if (it0 < 2 * 13056) {
                const int l = it0 >= 13056 ? 1 : 0; const int r = it0 - l * 13056; bf16_t* Wl = Wb + (size_t)l * W_LAYER;
                if (r < 1408)       { it = r;         src = a.in[2] + (size_t)l * DM * FF; K = DM; N = FF; dst = Wl + WO_GU1; ksc = a.in[1] + l * DM; map = 1; }
                else if (r < 2816)  { it = r - 1408;  src = a.in[3] + (size_t)l * DM * FF; K = DM; N = FF; dst = Wl + WO_GU1; ksc = a.in[1] + l * DM; map = 2; }
                else if (r < 4224)  { it = r - 2816;  src = a.in[4] + (size_t)l * DM * FF; K = FF; N = DM; dst = Wl + WO_D1; cs = 0.5f; }
                else if (r < 7680)  { it = r - 4224;  src = a.in[6] + (size_t)l * DM * 6912; K = DM; N = 6912; dst = Wl + WO_IN; ksc = a.in[5] + l * DM; }
                else if (r < 7808)  { it = r - 7680;  src = a.in[14] + (size_t)l * 256 * DM; K = 256; N = DM; dst = Wl + WO_PA; }
                else if (r < 8064)  { it = r - 7808;  src = a.in[15] + (size_t)l * 512 * DM; K = 512; N = DM; dst = Wl + WO_PB; }
                else if (r < 8320)  { it = r - 8064;  src = a.in[16] + (size_t)l * 512 * DM; K = 512; N = DM; dst = Wl + WO_PC; }
                else if (r < 8832)  { it = r - 8320;  src = a.in[17] + (size_t)l * DM * DM; K = DM; N = DM; dst = Wl + WO_OUT; }
                else if (r < 10240) { it = r - 8832;  src = a.in[19] + (size_t)l * DM * FF; K = DM; N = FF; dst = Wl + WO_GU2; ksc = a.in[18] + l * DM; map = 1; }
                else if (r < 11648) { it = r - 10240; src = a.in[20] + (size_t)l * DM * FF; K = DM; N = FF; dst = Wl + WO_GU2; ksc = a.in[18] + l * DM; map = 2; }
                else                { it = r - 11648; src = a.in[21] + (size_t)l * DM * FF; K = FF; N = DM; dst = Wl + WO_D2; cs = 0.5f; }
            } else { const int q = (it0 - 2 * 13056) >> 3; it = (it0 - 2 * 13056) & 7; src = a.in[12] + (size_t)q * 16384; K = 128; N = 128; dst = wcT + (size_t)q * 16384; }
            const int nblk = N / 32;
            const int kb = it / nblk, nb = it % nblk, n0 = 32 * nb;
            const int drow0 = (map == 0) ? n0 : ((n0 >> 7) * 256 + (n0 & 127) + (map == 2 ? 128 : 0));
            transpose_item(src, K, N, dst, n0, drow0, 64 * kb, ksc, cs, scr, lane);
        }
        const int xcd = bid & 7, slot = bid >> 3, nslot = G >> 3;
        for (int i = bid * NTHREADS + tid; i < 2 * 4 * 128 * 128; i += G * NTHREADS) {
            const int t = (i >> 7) & 127, s = i & 127; const float v = (s <= t) ? a.in[10][i] : 0.f;
            wsT[i] = (bf16_t)(cvt_pk_bf16(v, 0.f) & 0xffffu);
        }
        const float* x = a.in[0];
        for (int m = xcd * SEQ + slot * 8 + wave; m < (xcd + 1) * SEQ; m += nslot * 8) {
            const f32x4* xr = (const f32x4*)(x + (size_t)m * DM) + lane; u32x2* o8 = (u32x2*)(xb + (size_t)m * DM) + lane; float ss = 0.f;
#pragma unroll
            for (int jj = 0; jj < 4; ++jj) { const f32x4 v = xr[64 * jj]; ss += (v[0] * v[0] + v[1] * v[1]) + (v[2] * v[2] + v[3] * v[3]); u32x2 o; o.x = cvt_pk_bf16(v[0], v[1]); o.y = cvt_pk_bf16(v[2], v[3]); o8[64 * jj] = o; }
            ss = wave_sum(ss); if (lane < 4) ((f32x4*)(rowss + (size_t)m * 16))[lane] = (f32x4){lane == 0 ? ss : 0.f, 0.f, 0.f, 0.f};
        }
    }
    unsigned nseam = 0;
    if (ph_lo <= 0 && ph_hi > 1) grid_seam((unsigned*)(a.ws + WS_BAR), (++nseam) * (unsigned)G);

    for (int lst = 0; lst < 24; ++lst) {
        if (lst + 1 < ph_lo || lst + 1 >= ph_hi) continue;
        int lq = __builtin_amdgcn_readfirstlane(lst / 12), st = __builtin_amdgcn_readfirstlane(lst % 12), zoff = __builtin_amdgcn_readfirstlane(0);
        asm volatile("" : "+s"(lq), "+s"(st), "+s"(zoff));
        unsigned char* ws = a.ws + zoff;
        const int l = lq;
        bf16_t* RA = (bf16_t*)(ws + WS_A);
        const bf16_t* Wl = (const bf16_t*)(ws + WS_W) + (size_t)l * W_LAYER;
        bool isg = true, sync = true;
        pg8::Gemm g{nullptr, nullptr, NT, 0, 0};
        pg8::EpiMix e{}; e.mode = 0; e.rs = nullptr; e.aux = nullptr; e.ob = nullptr; e.ldo = 0;
        switch (st) {
            case 0: g.A = (bf16_t*)(ws + WS_XB); g.Bt = Wl + WO_GU1; g.N = 2 * FF; g.K = DM; e.mode = pg8::EM_SWIGLU; e.rs = rowss_arr(a.out, ws, 3 * l); e.ob = RA; e.ldo = FF; break;
            case 1: g.A = RA; g.Bt = Wl + WO_D1; g.N = DM; g.K = FF; e.mode = pg8::EM_RESID; e.aux = (l == 0) ? (const void*)a.in[0] : nullptr; e.ob = (bf16_t*)(ws + WS_XB); e.ldo = DM; e.rs = rowss_arr(a.out, ws, 3 * l + 1); break;
            case 2: g.A = (bf16_t*)(ws + WS_XB); g.Bt = Wl + WO_IN; g.N = ZP; g.K = DM; e.mode = pg8::EM_Z1; e.rs = rowss_arr(a.out, ws, 3 * l + 1); e.ob = RA; e.ldo = ZP; break;
            case 3: isg = false; break;
            case 4: isg = false; break;
            case 5: g.A = (bf16_t*)(ws + WS_XB); g.Bt = Wl + WO_IN + (size_t)ZP * DM; g.N = 3072; g.K = DM; e.mode = pg8::EM_GATE; e.rs = rowss_arr(a.out, ws, 3 * l + 1); e.aux = a.in[7] + l * 3072; e.ob = RA; e.ldo = 3072; break;
            case 6: g.A = (bf16_t*)(ws + WS_YA); g.Bt = Wl + WO_PA; g.N = DM; g.K = 256; e.mode = pg8::EM_PROJ0; e.aux = RA; e.ob = (bf16_t*)(ws + WS_MERGED); e.ldo = DM; sync = (DBG_SEAM_ALL != 0); break;
            case 7: g.A = (bf16_t*)(ws + WS_YB); g.Bt = Wl + WO_PB; g.N = DM; g.K = 512; e.mode = pg8::EM_PROJ1; e.aux = RA + 1024; e.ob = (bf16_t*)(ws + WS_MERGED); e.ldo = DM; sync = (DBG_SEAM_ALL != 0); break;
            case 8: g.A = (bf16_t*)(ws + WS_YC); g.Bt = Wl + WO_PC; g.N = DM; g.K = 512; e.mode = pg8::EM_PROJ1; e.aux = RA + 2048; e.ob = (bf16_t*)(ws + WS_MERGED); e.ldo = DM; break;
            case 9: g.A = (bf16_t*)(ws + WS_MERGED); g.Bt = Wl + WO_OUT; g.N = DM; g.K = DM; e.mode = pg8::EM_RESID; e.aux = nullptr; e.ob = (bf16_t*)(ws + WS_XB); e.ldo = DM; e.rs = rowss_arr(a.out, ws, 3 * l + 2); break;
            case 10: g.A = (bf16_t*)(ws + WS_XB); g.Bt = Wl + WO_GU2; g.N = 2 * FF; g.K = DM; e.mode = pg8::EM_SWIGLU; e.rs = rowss_arr(a.out, ws, 3 * l + 2); e.ob = RA; e.ldo = FF; break;
            default: g.A = RA; g.Bt = Wl + WO_D2; g.N = DM; g.K = FF; e.mode = pg8::EM_RESID; e.aux = nullptr; e.ob = (bf16_t*)(ws + WS_XB); e.ldo = DM; e.rs = rowss_arr(a.out, ws, 3 * l + 3); break;
        }
        if (isg) {
            pg8::StaticOrder S; S.init(NT, g.N, G, bid);
#ifdef DBG_REP_GEMM0
            for (int rep_ = (st == 0 || st == 10) ? 0 : 1; rep_ < 2; ++rep_)
#endif
            pg8::gemm_phase<pg8::EpiMix, pg8::StaticOrder, true, true>(lds, g, S, e);
        } else if (st == 3) {
#ifndef DBG_NO_MIX
            const int tid = threadIdx.x;
            float* lse = (float*)(ws + WS_LSE);
            const int xcd = bid & 7, slot = bid >> 3, nslot = G >> 3;
#ifndef DBG_NO_ATTN
            attn_phase(lds, RA, lse, xcd, slot, nslot, tid);
#ifdef DBG_REP_ATTN
            { int ds_ = 0; asm volatile("" : "+s"(ds_)); attn_phase(lds, RA, lse, xcd, slot, nslot, tid, ds_ != 0); }
#endif
#endif
#ifdef DBG_REP_MIX
            for (int rep_ = 0; rep_ < 2; ++rep_) {
#endif
#ifndef DBG_NO_GATE
            for (int k = slot; k < 32; k += nslot) gate_unit(lds, RA, (bf16_t*)(ws + WS_YB), (const bf16_t*)(ws + WS_WST) + (size_t)l * 65536, a.in[8] + l * 512, a.in[9] + l * 512, a.in[11] + l * 512, xcd * 32 + k, tid);
#endif
#ifndef DBG_NO_POOL
            for (int k = slot; k < 128; k += nslot) pool_unit(lds, RA, (bf16_t*)(ws + WS_YC), (const bf16_t*)(ws + WS_WCT) + (size_t)l * 65536, a.in[13] + l * 512, xcd * 128 + k, tid);
#endif
#ifdef DBG_REP_MIX
            }
#endif
#endif
        } else {
#ifndef DBG_NO_COMB
            int tid = threadIdx.x; asm volatile("" : "+v"(tid));
            const float* lse = (const float*)(ws + WS_LSE); bf16_t* ya = (bf16_t*)(ws + WS_YA);
            const int xcd = bid & 7, slot = bid >> 3, nslot = G >> 3;
#ifdef DBG_REP_MIX
            for (int rep_ = 0; rep_ < 2; ++rep_)
#endif
            for (int i = xcd * (SEQ * 32) + slot * NTHREADS + tid; i < (xcd + 1) * (SEQ * 32); i += nslot * NTHREADS) {
                const int tok = i >> 5, j = (i >> 3) & 3, d8 = i & 7;
                const int bb = tok >> 12, tq = tok & (SEQ - 1);
                const float l0 = lse[(size_t)((0 * 4 + j) * 8 + bb) * SEQ + tq], l1 = lse[(size_t)((1 * 4 + j) * 8 + bb) * SEQ + (tq & 3) * (SEQ >> 2) + (tq >> 2)], l2 = lse[(size_t)((2 * 4 + j) * 8 + bb) * SEQ + (tq & 15) * (SEQ >> 4) + (tq >> 4)];
                const float mx = fmaxf(l0, fmaxf(l1, l2)); float e0 = __expf(l0 - mx), e1 = __expf(l1 - mx), e2 = __expf(l2 - mx); const float inv = 1.0f / (e0 + e1 + e2); e0 *= inv; e1 *= inv; e2 *= inv;
                const bf16_t* op = RA + (size_t)tok * ZP + j * 64 + d8 * 8;
                const u32x4 o0 = *(const u32x4*)op, o1 = *(const u32x4*)(op + 256), o2 = *(const u32x4*)(op + 512);
                u32x4 r;
#ifdef DBG_COPY_YA
                e0 = 0.f; e1 = 0.f; e2 = 1.f; (void)l0; (void)l1; (void)l2;
                { const u32x4 kk = *(const u32x4*)(op + 768); (void)o0; (void)o1; (void)o2; r = kk; *(u32x4*)(ya + (size_t)tok * 256 + j * 64 + d8 * 8) = r; continue; }
#endif
                r.x = cvt_pk_bf16(e0 * bf_lo(o0.x) + e1 * bf_lo(o1.x) + e2 * bf_lo(o2.x), e0 * bf_hi(o0.x) + e1 * bf_hi(o1.x) + e2 * bf_hi(o2.x));
                r.y = cvt_pk_bf16(e0 * bf_lo(o0.y) + e1 * bf_lo(o1.y) + e2 * bf_lo(o2.y), e0 * bf_hi(o0.y) + e1 * bf_hi(o1.y) + e2 * bf_hi(o2.y));
                r.z = cvt_pk_bf16(e0 * bf_lo(o0.z) + e1 * bf_lo(o1.z) + e2 * bf_lo(o2.z), e0 * bf_hi(o0.z) + e1 * bf_hi(o1.z) + e2 * bf_hi(o2.z));
                r.w = cvt_pk_bf16(e0 * bf_lo(o0.w) + e1 * bf_lo(o1.w) + e2 * bf_lo(o2.w), e0 * bf_hi(o0.w) + e1 * bf_hi(o1.w) + e2 * bf_hi(o2.w));
                *(u32x4*)(ya + (size_t)tok * 256 + j * 64 + d8 * 8) = r;
            }
#endif
        }
        if (sync && lst + 2 < ph_hi) grid_seam((unsigned*)(a.ws + WS_BAR), (++nseam) * (unsigned)G);
    }
    if (ph_hi > 25) {
        int tid = threadIdx.x; asm volatile("" : "+v"(tid));
        const int lane = tid & 63, wave = __builtin_amdgcn_readfirstlane(tid >> 6);
        const float* fn = a.in[22]; const float* rs6 = (const float*)(a.ws + WS_RS6); float* X = a.out; const bf16_t* xb = (const bf16_t*)(a.ws + WS_XB);
        const int xcd = bid & 7, slot = bid >> 3, nslot = G >> 3;
        for (int m = xcd * SEQ + slot * 8 + wave; m < (xcd + 1) * SEQ; m += nslot * 8) {
            const float rs = pg8::rstd_of(rs6, m);
            const u32x4* xr = (const u32x4*)(xb + (size_t)m * DM) + lane; f32x4* orow = (f32x4*)(X + (size_t)m * DM) + 2 * lane; const f32x4* gr = (const f32x4*)fn + 2 * lane;
#pragma unroll
            for (int jj = 0; jj < 2; ++jj) { const u32x4 v = xr[64 * jj]; const f32x4 g0 = gr[128 * jj], g1 = gr[128 * jj + 1];
                orow[128 * jj] = (f32x4){bf_lo(v.x), bf_hi(v.x), bf_lo(v.y), bf_hi(v.y)} * rs * g0; orow[128 * jj + 1] = (f32x4){bf_lo(v.z), bf_hi(v.z), bf_lo(v.w), bf_hi(v.w)} * rs * g1; }
        }
    }
}

extern "C" void kernel_launch(void* const* d_in, const int* in_sizes, int n_in, void* d_out, int out_size, void* d_ws, size_t ws_size, hipStream_t stream) {
    static int grid = 0;
    if (grid == 0) {
        if (n_in != 23 || in_sizes[0] != NT * DM || out_size != NT * DM || ws_size < WS_END) { fprintf(stderr, "kernel_launch: unexpected problem (n_in %d, in0 %d, out %d, ws %zu)\n", n_in, n_in > 0 ? in_sizes[0] : -1, out_size, ws_size); grid = -1; return; }
        int dev = 0, cus = 0, per_cu = 0;
        if (hipGetDevice(&dev) != hipSuccess || hipDeviceGetAttribute(&cus, hipDeviceAttributeMultiprocessorCount, dev) != hipSuccess) { grid = -1; return; }
        if (hipFuncSetAttribute((const void*)mega_fwd, hipFuncAttributeMaxDynamicSharedMemorySize, LDS_BYTES) != hipSuccess) { fprintf(stderr, "kernel_launch: hipFuncSetAttribute failed\n"); grid = -1; return; }
        if (hipOccupancyMaxActiveBlocksPerMultiprocessor(&per_cu, (const void*)mega_fwd, NTHREADS, LDS_BYTES) != hipSuccess || per_cu < 1) { fprintf(stderr, "kernel_launch: occupancy query says %d\n", per_cu); per_cu = 1; }
        (void)hipGetLastError();
        grid = cus & ~7;
    }
    if (grid < 0) return;
    (void)hipMemsetAsync((char*)d_ws + WS_BAR, 0, 256, stream);
    Args a{};
    for (int i = 0; i < 23; ++i) a.in[i] = (const float*)d_in[i];
    a.out = (float*)d_out; a.ws = (unsigned char*)d_ws;
#ifndef MK_N_LAUNCHES
#define MK_N_LAUNCHES 1
#endif
#if MK_N_LAUNCHES == 1
    a.ph_lo = 0; a.ph_hi = 26;
    void* args[] = {&a};
    hipError_t e = hipLaunchCooperativeKernel((const void*)mega_fwd, dim3(grid), dim3(NTHREADS), args, LDS_BYTES, stream);
    if (e != hipSuccess) fprintf(stderr, "cooperative launch failed: %s (grid %d)\n", hipGetErrorString(e), grid);
#else
    for (int ph = 0; ph < 26; ++ph) {
        int hi = ph + 1; const int stp = (ph >= 1 && ph <= 24) ? (ph - 1) % 12 : -1; if (stp == 6) hi = ph + 3;
        a.ph_lo = ph; a.ph_hi = hi;
        hipLaunchKernelGGL(mega_fwd, dim3(grid), dim3(NTHREADS), LDS_BYTES, stream, a);
        ph = hi - 1;
    }
#endif
}
```

```cpp
#include <hip/hip_runtime.h>
#include <hip/hip_cooperative_groups.h>
#include <cstdio>
#include <cstdint>
namespace pg8 {
#define PG8_LAS __attribute__((address_space(3)))
typedef unsigned short bf16_t;
typedef short bf16x8 __attribute__((ext_vector_type(8)));
typedef float f32x4 __attribute__((ext_vector_type(4)));
typedef unsigned u32x4 __attribute__((ext_vector_type(4)));
constexpr int BM = 256, BK = 64, HALF = 128, HTB = HALF * BK * 2  , STAGE_BYTES = 8 * HTB, NXCD = 8, WGM = 8;

__host__ __device__ __forceinline__ int lds_byte(int r, int c) { const int st = (r >> 4) * 2 + (c >> 5), rr = r & 15, cc = c & 31, ob = rr * 64 + cc * 2; return st * 1024 + (ob ^ (((ob >> 9) & 1) << 5)); }
__host__ __device__ __forceinline__ void stage_rc(int b, int& R, int& C) { const int st = b / 1024, sb = b % 1024, swz = sb ^ (((sb >> 9) & 1) << 5); R = (st >> 1) * 16 + swz / 64; C = (st & 1) * 32 + (swz % 64) / 2; }
__host__ __device__ __forceinline__ int perm32(int rho) { const int n = rho >> 4, i = rho & 15; return 8 * (i >> 2) + 4 * n + (i & 3); }

struct Unit { int pm, pn; };
struct Gemm { const bf16_t* A; const bf16_t* Bt; int M, N, K; };

struct StaticOrder {
    int nM, nN, nwg, G, c;
    __host__ __device__ void init(int M, int N, int G_, int c_) { nM = M / BM; nN = N / BM; nwg = nM * nN; G = G_; c = c_; }
    __host__ __device__ bool next(int i, Unit& u) const {
        const long L = (long)i * G + c; if (L >= nwg) return false;
        int wgid = (int)L; { const int q = nwg / NXCD, r = nwg % NXCD, xcd = wgid % NXCD, off = wgid / NXCD; wgid = (xcd < r ? xcd * (q + 1) : r * (q + 1) + (xcd - r) * q) + off; }
        const int nig = WGM * nN, gid = wgid / nig, fm = gid * WGM, gsz = (nM - fm) < WGM ? (nM - fm) : WGM;
        u.pm = fm + ((wgid % nig) % gsz); u.pn = (wgid % nig) / gsz; return true;
    }
    __device__ __forceinline__ void a_ready(const Unit&) const {}
    __device__ __forceinline__ void done(const Unit&) const {}
};

typedef float f32x2 __attribute__((ext_vector_type(2)));
typedef __bf16 bf16x2_c __attribute__((ext_vector_type(2)));
__device__ __forceinline__ unsigned cvt_pk_bf16(float lo, float hi) { const f32x2 v = {lo, hi}; const bf16x2_c b = __builtin_convertvector(v, bf16x2_c); return __builtin_bit_cast(unsigned, b); }
__device__ __forceinline__ f32x2 gelu_pk(f32x2 v) {
    const f32x2 av = __builtin_elementwise_abs(v), d = av * 0.2316418882f + 1.0f;
    f32x2 t; t.x = __builtin_amdgcn_rcpf(d.x); t.y = __builtin_amdgcn_rcpf(d.y);
    f32x2 q = t * 0.5307027145f + (-0.7265760135f); q = q * t + 0.7107068705f; q = q * t + (-0.142248368f); q = q * t + 0.127414796f; q = q * t;
    const f32x2 s = (v * v) * (-0.72134752044f);
    f32x2 e; e.x = __builtin_amdgcn_exp2f(s.x); e.y = __builtin_amdgcn_exp2f(s.y);
    const f32x2 m = v * (q * e), r = v - m;
    f32x2 o; o.x = v.x < 0.f ? m.x : r.x; o.y = v.y < 0.f ? m.y : r.y; return o;
}
typedef unsigned u32x2 __attribute__((ext_vector_type(2)));
__device__ __forceinline__ float bf_lo(unsigned u) { return __uint_as_float(u << 16); }
__device__ __forceinline__ float bf_hi(unsigned u) { return __uint_as_float(u & 0xffff0000u); }
__device__ __forceinline__ float sigmoidf_(float v) { return __builtin_amdgcn_rcpf(1.0f + __expf(-v)); }
constexpr float RMS_EPS = 1e-6f;
__device__ __forceinline__ float rstd_of(const float* part, int r) {
    const f32x4* p = (const f32x4*)(part + (size_t)r * 16); const f32x4 a = p[0], b = p[1], c = p[2], d = p[3];
    const float s = ((a[0] + a[1]) + (a[2] + a[3])) + ((b[0] + b[1]) + (b[2] + b[3])) + (((c[0] + c[1]) + (c[2] + c[3])) + ((d[0] + d[1]) + (d[2] + d[3])));
    return rsqrtf(s * (1.0f / 1024.0f) + RMS_EPS);
}
enum { EM_SWIGLU = 0, EM_RESID = 1, EM_Z1 = 2, EM_GATE = 3, EM_PROJ0 = 4, EM_PROJ1 = 5 };
struct EpiMix {
    static constexpr bool PERM = true, AFTER_DRAIN = false;
    int mode;
    float* rs;
    const void* aux;
    bf16_t* ob; int ldo;
    __device__ __forceinline__ void operator()(const f32x4 (&acc)[2][2][4][2], const Unit& u, int wr, int wc, int fr, int fq) const {
        const int row0 = u.pm * BM + wr * 64 + fr;
        const int cw = wc * 32 + 8 * fq;
        if (mode == EM_SWIGLU || mode == EM_Z1 || mode == EM_GATE) {
            f32x4 pp[8]; float rs8[8];
            const float* rsb = rs + (size_t)row0 * 16 + 4 * fq;
#pragma unroll
            for (int i = 0; i < 8; ++i) pp[i] = *(const f32x4*)(rsb + ((i >> 2) * HALF + (i & 3) * 16) * 16);
            f32x4 bv[2][2];
            if (mode == EM_GATE) {
#pragma unroll
                for (int bj = 0; bj < 2; ++bj) { const float* bp = (const float*)aux + u.pn * BM + cw + bj * HALF; bv[bj][0] = *(const f32x4*)bp; bv[bj][1] = *(const f32x4*)(bp + 4); }
            }
#pragma unroll
            for (int i = 0; i < 8; ++i) { float t = (pp[i][0] + pp[i][1]) + (pp[i][2] + pp[i][3]); t += __shfl_xor(t, 16); t += __shfl_xor(t, 32); rs8[i] = rsqrtf(t * (1.0f / 1024.0f) + RMS_EPS); }
            if (mode == EM_SWIGLU) {
                bf16_t* obase = ob + (size_t)row0 * 2816 + u.pn * HALF + cw;
#pragma unroll
                for (int ai = 0; ai < 2; ++ai)
#pragma unroll
                    for (int m = 0; m < 4; ++m) {
                        const float rsv = rs8[ai * 4 + m];
                        float h[8];
#pragma unroll
                        for (int n = 0; n < 2; ++n)
#pragma unroll
                            for (int e = 0; e < 4; ++e) { const float g = acc[ai][0][m][n][e] * rsv, up = acc[ai][1][m][n][e] * rsv; h[n * 4 + e] = g * sigmoidf_(g) * up; }
                        u32x4 w; w.x = cvt_pk_bf16(h[0], h[1]); w.y = cvt_pk_bf16(h[2], h[3]); w.z = cvt_pk_bf16(h[4], h[5]); w.w = cvt_pk_bf16(h[6], h[7]);
                        *(u32x4*)(obase + (ai * HALF + m * 16) * 2816) = w;
                    }
            } else if (mode == EM_Z1) {
                const float sc = (u.pn < 3) ? 0.125f : 1.0f; const bool act = (u.pn >= 9 && u.pn <= 12);
                bf16_t* obase = ob + (size_t)row0 * 3840 + u.pn * BM + cw;
#pragma unroll
                for (int ai = 0; ai < 2; ++ai)
#pragma unroll
                    for (int m = 0; m < 4; ++m) {
                        const float rsv = rs8[ai * 4 + m] * sc;
#pragma unroll
                        for (int bj = 0; bj < 2; ++bj) {
                            f32x4 v0 = acc[ai][bj][m][0] * rsv, v1 = acc[ai][bj][m][1] * rsv;
                            if (act) { const f32x2 a = gelu_pk((f32x2){v0[0], v0[1]}), b = gelu_pk((f32x2){v0[2], v0[3]}), c = gelu_pk((f32x2){v1[0], v1[1]}), d = gelu_pk((f32x2){v1[2], v1[3]});
                                v0 = (f32x4){a.x, a.y, b.x, b.y}; v1 = (f32x4){c.x, c.y, d.x, d.y}; }
                            u32x4 w; w.x = cvt_pk_bf16(v0[0], v0[1]); w.y = cvt_pk_bf16(v0[2], v0[3]); w.z = cvt_pk_bf16(v1[0], v1[1]); w.w = cvt_pk_bf16(v1[2], v1[3]);
                            *(u32x4*)(obase + (ai * HALF + m * 16) * 3840 + bj * HALF) = w;
                        }
                    }
            } else {
                bf16_t* obase = ob + (size_t)row0 * 3072 + u.pn * BM + cw;
#pragma unroll
                for (int ai = 0; ai < 2; ++ai)
#pragma unroll
                    for (int m = 0; m < 4; ++m) {
                        const float rsv = rs8[ai * 4 + m];
#pragma unroll
                        for (int bj = 0; bj < 2; ++bj) {
                            const f32x4 v0 = acc[ai][bj][m][0] * rsv + bv[bj][0], v1 = acc[ai][bj][m][1] * rsv + bv[bj][1];
                            u32x4 w; w.x = cvt_pk_bf16(sigmoidf_(v0[0]), sigmoidf_(v0[1])); w.y = cvt_pk_bf16(sigmoidf_(v0[2]), sigmoidf_(v0[3]));
                            w.z = cvt_pk_bf16(sigmoidf_(v1[0]), sigmoidf_(v1[1])); w.w = cvt_pk_bf16(sigmoidf_(v1[2]), sigmoidf_(v1[3]));
                            *(u32x4*)(obase + (ai * HALF + m * 16) * 3072 + bj * HALF) = w;
                        }
                    }
            }
        } else if (mode == EM_RESID) {
            const float* xin = (const float*)aux; const size_t boff = (size_t)row0 * 1024 + u.pn * BM + cw; bf16_t* obase = ob + boff; const float* xbase = xin + boff; float* rsb = rs + (size_t)row0 * 16 + u.pn * 4 + wc;
#pragma unroll
            for (int ai = 0; ai < 2; ++ai) {
                u32x4 xo[4][2];
                if (!xin) {
#pragma unroll
                    for (int m = 0; m < 4; ++m)
#pragma unroll
                        for (int bj = 0; bj < 2; ++bj) xo[m][bj] = *(const u32x4*)(obase + (ai * HALF + m * 16) * 1024 + bj * HALF);
                }
#pragma unroll
                for (int m = 0; m < 4; ++m) {
                    float ss = 0.f;
#pragma unroll
                    for (int bj = 0; bj < 2; ++bj) {
                        const int off = (ai * HALF + m * 16) * 1024 + bj * HALF;
                        f32x4 x0, x1;
                        if (xin) { x0 = *(const f32x4*)(xbase + off); x1 = *(const f32x4*)(xbase + off + 4); }
                        else { const u32x4 q = xo[m][bj]; x0 = (f32x4){bf_lo(q.x), bf_hi(q.x), bf_lo(q.y), bf_hi(q.y)}; x1 = (f32x4){bf_lo(q.z), bf_hi(q.z), bf_lo(q.w), bf_hi(q.w)}; }
                        const f32x4 v0 = x0 + acc[ai][bj][m][0], v1 = x1 + acc[ai][bj][m][1];
                        u32x4 w; w.x = cvt_pk_bf16(v0[0], v0[1]); w.y = cvt_pk_bf16(v0[2], v0[3]); w.z = cvt_pk_bf16(v1[0], v1[1]); w.w = cvt_pk_bf16(v1[2], v1[3]);
                        *(u32x4*)(obase + off) = w;
                        ss += (v0[0] * v0[0] + v0[1] * v0[1]) + (v0[2] * v0[2] + v0[3] * v0[3]) + (v1[0] * v1[0] + v1[1] * v1[1]) + (v1[2] * v1[2] + v1[3] * v1[3]);
                    }
                    ss += __shfl_xor(ss, 16); ss += __shfl_xor(ss, 32);
                    if (fq == 0) rsb[(ai * HALF + m * 16) * 16] = ss;
                }
            }
        } else {
            const bool accum = (mode == EM_PROJ1); const bf16_t* gbase = (const bf16_t*)aux + (size_t)row0 * 3072 + u.pn * BM + cw; bf16_t* obase = ob + (size_t)row0 * 1024 + u.pn * BM + cw;
#pragma unroll
            for (int ai = 0; ai < 2; ++ai) {
                u32x4 gv[4][2], old[4][2];
#pragma unroll
                for (int m = 0; m < 4; ++m)
#pragma unroll
                    for (int bj = 0; bj < 2; ++bj) gv[m][bj] = *(const u32x4*)(gbase + (ai * HALF + m * 16) * 3072 + bj * HALF);
                if (accum) {
#pragma unroll
                    for (int m = 0; m < 4; ++m)
#pragma unroll
                        for (int bj = 0; bj < 2; ++bj) old[m][bj] = *(const u32x4*)(obase + (ai * HALF + m * 16) * 1024 + bj * HALF);
                } else {
#pragma unroll
                    for (int m = 0; m < 4; ++m)
#pragma unroll
                        for (int bj = 0; bj < 2; ++bj) old[m][bj] = (u32x4){0u, 0u, 0u, 0u};
                }
#pragma unroll
                for (int m = 0; m < 4; ++m)
#pragma unroll
                    for (int bj = 0; bj < 2; ++bj) {
                        const u32x4 g4 = gv[m][bj], o4 = old[m][bj]; const f32x4 a0 = acc[ai][bj][m][0], a1 = acc[ai][bj][m][1];
                        u32x4 w;
                        w.x = cvt_pk_bf16(bf_lo(o4.x) + bf_lo(g4.x) * a0[0], bf_hi(o4.x) + bf_hi(g4.x) * a0[1]);
                        w.y = cvt_pk_bf16(bf_lo(o4.y) + bf_lo(g4.y) * a0[2], bf_hi(o4.y) + bf_hi(g4.y) * a0[3]);
                        w.z = cvt_pk_bf16(bf_lo(o4.z) + bf_lo(g4.z) * a1[0], bf_hi(o4.z) + bf_hi(g4.z) * a1[1]);
                        w.w = cvt_pk_bf16(bf_lo(o4.w) + bf_lo(g4.w) * a1[2], bf_hi(o4.w) + bf_hi(g4.w) * a1[3]);
                        *(u32x4*)(obase + (ai * HALF + m * 16) * 1024 + bj * HALF) = w;
                    }
            }
        }
    }
};

template <class Epi, class Sched, bool ALIGN_EPI = false, bool SP2 = false>
__device__ __forceinline__ void gemm_phase(PG8_LAS unsigned char* lds, const Gemm g, const Sched& S, const Epi& E) {
    const int tid = threadIdx.x, wid = __builtin_amdgcn_readfirstlane(tid >> 6), lane = tid & 63, wr = wid >> 2, wc = wid & 3, fr = lane & 15, fq = lane >> 4;
    const int K = g.K, nt = K / BK;
    unsigned voffA[2], voffB[2];
#pragma unroll
    for (int i = 0; i < 2; ++i) { int R, C; stage_rc(tid * 16 + i * 8192, R, C); const int Rb = Epi::PERM ? ((R & ~31) + perm32(R & 31)) : R;
        voffA[i] = (unsigned)(R * K + C) * 2u; voffB[i] = (unsigned)(Rb * K + C) * 2u; }
    const size_t kstep = (size_t)(BK * 2);
    const size_t hstep = (size_t)HALF * K * 2;
    const size_t tstep = 2 * hstep;
    const unsigned ldsw = (unsigned)wid * 1024u;
    const int aoff = lds_byte(wr * 64 + fr, fq * 8), boff = lds_byte(wc * 32 + fr, fq * 8);
#define PG8_SA(b, h) (((b) * 2 + (h)) * HTB)
#define PG8_SB(b, h) ((4 + (b) * 2 + (h)) * HTB)
#define PG8_STAGE(bufoff, gbase, voff) do { _Pragma("unroll") for (int _i = 0; _i < 2; ++_i) \
        __builtin_amdgcn_global_load_lds((const unsigned*)((const char*)(gbase) + (voff)[_i]), (PG8_LAS unsigned*)(lds + (bufoff) + ldsw + _i * 8192), 16, 0, 0); } while (0)
#define PG8_LDA(dst, b, h) do { _Pragma("unroll") for (int m = 0; m < 4; ++m) _Pragma("unroll") for (int k = 0; k < 2; ++k) dst[m][k] = *(const PG8_LAS bf16x8*)(lds + PG8_SA(b, h) + aoff + m * 2048 + k * 1024); } while (0)
#define PG8_LDB(dst, b, h) do { _Pragma("unroll") for (int n = 0; n < 2; ++n) _Pragma("unroll") for (int k = 0; k < 2; ++k) dst[n][k] = *(const PG8_LAS bf16x8*)(lds + PG8_SB(b, h) + boff + n * 2048 + k * 1024); } while (0)
#define PG8_MMA(ai, bj, At, Bt) do { __builtin_amdgcn_s_setprio(1); _Pragma("unroll") for (int m = 0; m < 4; ++m) _Pragma("unroll") for (int n = 0; n < 2; ++n) _Pragma("unroll") for (int k = 0; k < 2; ++k) \
        acc[ai][bj][m][n] = __builtin_amdgcn_mfma_f32_16x16x32_bf16(Bt[n][k], At[m][k], acc[ai][bj][m][n], 0, 0, 0); __builtin_amdgcn_s_setprio(0); } while (0)
#define PG8_WAIT_V(n) asm volatile("s_waitcnt vmcnt(" #n ")" ::: "memory")
#define PG8_WAIT_L(n) asm volatile("s_waitcnt lgkmcnt(" #n ")" ::: "memory")
#define PG8_BAR __builtin_amdgcn_s_barrier()
#define PG8_SCHED __builtin_amdgcn_sched_barrier(0)
    Unit cur, nxt; int ui = 0;
    if (!S.next(0, cur)) return;
    f32x4 acc[2][2][4][2];
#pragma unroll
    for (int a = 0; a < 2; ++a)
#pragma unroll
        for (int b = 0; b < 2; ++b)
#pragma unroll
            for (int m = 0; m < 4; ++m)
#pragma unroll
                for (int n = 0; n < 2; ++n) acc[a][b][m][n] = (f32x4){0.f, 0.f, 0.f, 0.f};
    bf16x8 At[4][2], B0[2][2], B1[2][2];
    const char* cA = (const char*)g.A + (size_t)cur.pm * tstep; const char* cB = (const char*)g.Bt + (size_t)cur.pn * tstep;
    S.a_ready(cur);
    if constexpr (SP2) {
        PG8_STAGE(PG8_SB(0, 0), cB, voffB); PG8_STAGE(PG8_SB(0, 1), cB + hstep, voffB); PG8_STAGE(PG8_SA(0, 0), cA, voffA); PG8_STAGE(PG8_SA(0, 1), cA + hstep, voffA);
        if (wr == 1) PG8_BAR;
        PG8_WAIT_V(2); PG8_BAR;
        PG8_STAGE(PG8_SB(1, 0), cB + kstep, voffB); PG8_STAGE(PG8_SA(1, 0), cA + kstep, voffA); PG8_STAGE(PG8_SB(1, 1), cB + hstep + kstep, voffB);
        PG8_WAIT_V(6); PG8_BAR;
    } else {
        PG8_STAGE(PG8_SB(0, 0), cB, voffB); PG8_STAGE(PG8_SA(0, 0), cA, voffA); PG8_STAGE(PG8_SB(0, 1), cB + hstep, voffB); PG8_STAGE(PG8_SA(0, 1), cA + hstep, voffA);
        if (wr == 1) PG8_BAR;
        PG8_WAIT_V(4); PG8_BAR;
        PG8_STAGE(PG8_SB(1, 0), cB + kstep, voffB); PG8_STAGE(PG8_SA(1, 0), cA + kstep, voffA); PG8_STAGE(PG8_SB(1, 1), cB + hstep + kstep, voffB);
        PG8_WAIT_V(6); PG8_BAR;
    }
    for (;;) {
        const bool has_next = S.next(ui + 1, nxt);
        const char* nA = has_next ? (const char*)g.A + (size_t)nxt.pm * tstep : cA; const char* nB = has_next ? (const char*)g.Bt + (size_t)nxt.pn * tstep : cB;
        for (int t = 0; t < nt; t += 2) {
            const bool last = (t == nt - 2);
            const char* a1 = cA + (size_t)(t + 1) * kstep;
            const char* a2 = last ? nA : cA + (size_t)(t + 2) * kstep; const char* b2 = last ? nB : cB + (size_t)(t + 2) * kstep;
            const char* a3 = a2 + kstep; const char* b3 = b2 + kstep;
            if (last && has_next) S.a_ready(nxt);
            if constexpr (SP2) {
            PG8_LDB(B0, 0, 0); PG8_LDB(B1, 0, 1); PG8_SCHED; PG8_LDA(At, 0, 0); PG8_STAGE(PG8_SA(1, 1), a1 + hstep, voffA);
            PG8_WAIT_V(8); PG8_WAIT_L(0); PG8_BAR; PG8_MMA(0, 0, At, B0); PG8_MMA(0, 1, At, B1); PG8_BAR; PG8_SCHED;
            PG8_LDA(At, 0, 1); PG8_STAGE(PG8_SB(0, 0), b2, voffB); PG8_STAGE(PG8_SB(0, 1), b2 + hstep, voffB); PG8_STAGE(PG8_SA(0, 0), a2, voffA);
            PG8_WAIT_V(8); PG8_WAIT_L(0); PG8_BAR; PG8_MMA(1, 0, At, B0); PG8_MMA(1, 1, At, B1); PG8_BAR; PG8_SCHED;
            PG8_LDB(B0, 1, 0); PG8_LDB(B1, 1, 1); PG8_SCHED; PG8_LDA(At, 1, 0); PG8_STAGE(PG8_SA(0, 1), a2 + hstep, voffA);
            PG8_WAIT_V(8); PG8_WAIT_L(0); PG8_BAR; PG8_MMA(0, 0, At, B0); PG8_MMA(0, 1, At, B1); PG8_BAR; PG8_SCHED;
            PG8_LDA(At, 1, 1); PG8_STAGE(PG8_SB(1, 0), b3, voffB); PG8_STAGE(PG8_SB(1, 1), b3 + hstep, voffB); PG8_STAGE(PG8_SA(1, 0), a3, voffA);
            PG8_WAIT_V(8); PG8_WAIT_L(0); PG8_BAR; PG8_MMA(1, 0, At, B0); PG8_MMA(1, 1, At, B1); PG8_BAR; PG8_SCHED;
            } else {
            PG8_LDB(B0, 0, 0); PG8_SCHED; PG8_LDA(At, 0, 0); PG8_STAGE(PG8_SA(1, 1), a1 + hstep, voffA);
            PG8_WAIT_L(8); PG8_BAR; PG8_WAIT_L(0); PG8_MMA(0, 0, At, B0); PG8_BAR; PG8_SCHED;
            PG8_LDB(B1, 0, 1); PG8_STAGE(PG8_SB(0, 0), b2, voffB);
            PG8_BAR; PG8_WAIT_L(0); PG8_MMA(0, 1, At, B1); PG8_BAR;
            PG8_LDA(At, 0, 1); PG8_STAGE(PG8_SA(0, 0), a2, voffA);
            PG8_BAR; PG8_WAIT_L(0); PG8_MMA(1, 0, At, B0); PG8_BAR; PG8_SCHED;
            PG8_STAGE(PG8_SB(0, 1), b2 + hstep, voffB);
            PG8_WAIT_V(6); PG8_BAR; PG8_MMA(1, 1, At, B1); PG8_BAR;
            PG8_LDB(B0, 1, 0); PG8_SCHED; PG8_LDA(At, 1, 0); PG8_STAGE(PG8_SA(0, 1), a2 + hstep, voffA);
            PG8_WAIT_L(8); PG8_BAR; PG8_WAIT_L(0); PG8_MMA(0, 0, At, B0); PG8_BAR; PG8_SCHED;
            PG8_LDB(B1, 1, 1); PG8_STAGE(PG8_SB(1, 0), b3, voffB);
            PG8_BAR; PG8_WAIT_L(0); PG8_MMA(0, 1, At, B1); PG8_BAR;
            PG8_LDA(At, 1, 1); PG8_STAGE(PG8_SA(1, 0), a3, voffA);
            PG8_BAR; PG8_WAIT_L(0); PG8_MMA(1, 0, At, B0); PG8_BAR; PG8_SCHED;
            PG8_STAGE(PG8_SB(1, 1), b3 + hstep, voffB);
            PG8_WAIT_V(6); PG8_BAR; PG8_MMA(1, 1, At, B1); PG8_BAR;
            }
        }
        if constexpr (ALIGN_EPI) { if (wr == 0) PG8_BAR; }
        if constexpr (!Epi::AFTER_DRAIN) { E(acc, cur, wr, wc, fr, fq); S.done(cur); }
        if (!has_next) break;
#pragma unroll
        for (int a = 0; a < 2; ++a)
#pragma unroll
            for (int b = 0; b < 2; ++b)
#pragma unroll
                for (int m = 0; m < 4; ++m)
#pragma unroll
                    for (int n = 0; n < 2; ++n) acc[a][b][m][n] = (f32x4){0.f, 0.f, 0.f, 0.f};
        cur = nxt; cA = nA; cB = nB; ++ui;
        if constexpr (ALIGN_EPI) { if (wr == 1) PG8_BAR; }
    }
    PG8_WAIT_V(0);
    if constexpr (!ALIGN_EPI) { if (wr == 0) PG8_BAR; }
    PG8_BAR;
    if constexpr (Epi::AFTER_DRAIN) { E.fused(acc, cur, wr, wc, fr, fq, lds, wid, lane); S.done(cur); }
#undef PG8_SA
#undef PG8_SB
#undef PG8_STAGE
#undef PG8_LDA
#undef PG8_LDB
#undef PG8_MMA
#undef PG8_WAIT_V
#undef PG8_WAIT_L
#undef PG8_BAR
#undef PG8_SCHED
}
}
namespace cg = cooperative_groups;
#define LAS __attribute__((address_space(3)))
using pg8::bf16_t; using pg8::bf16x8; using pg8::f32x4; using pg8::u32x4; using pg8::u32x2; using pg8::f32x2;
using pg8::bf_lo; using pg8::bf_hi;
using pg8::cvt_pk_bf16;

constexpr int NT = 32768, DM = 1024, FF = 2816, SEQ = 4096;
constexpr int ZP = 3840;
constexpr int NTHREADS = 512, LDS_STAGE = 131072, LDS_BYTES = LDS_STAGE + 256;
constexpr size_t MiB = 1u << 20;
constexpr size_t WS_ROWSS = 0;
constexpr size_t WS_BAR = 960 * 1024;
constexpr size_t WS_LSE = 1 * MiB;
constexpr size_t WS_WST = 3 * MiB;
constexpr size_t WS_WCT = 3 * MiB + 256 * 1024;
constexpr size_t WS_W = 4 * MiB;
constexpr size_t W_LAYER = 26738688;
constexpr size_t WO_GU1 = 0, WO_D1 = 5767168, WO_IN = 8650752, WO_PA = 15728640, WO_PB = 15990784, WO_PC = 16515072, WO_OUT = 17039360, WO_GU2 = 18087936, WO_D2 = 23855104;
constexpr size_t WS_XB = 106 * MiB;
constexpr size_t WS_YA = 170 * MiB, WS_YB = 186 * MiB, WS_YC = 218 * MiB;
constexpr size_t WS_A = 250 * MiB;
constexpr size_t WS_MERGED = WS_A + 192 * MiB;
constexpr size_t WS_RS6 = 506 * MiB;
constexpr size_t WS_END = 508 * MiB;

__device__ __forceinline__ float wave_sum(float v) {
#pragma unroll
    for (int o = 1; o < 64; o <<= 1) v += __shfl_xor(v, o);
    return v;
}
__device__ __forceinline__ f32x4 mfma16(bf16x8 a, bf16x8 b, f32x4 c) { return __builtin_amdgcn_mfma_f32_16x16x32_bf16(a, b, c, 0, 0, 0); }

__device__ __forceinline__ void transpose_item(const float* W, int K, int N, bf16_t* WT, int n0, int drow0, int k0, const float* kscale, float cs, LAS float* scr, int lane) {
    const int kr = lane >> 3, n4 = (lane & 7) * 4;
    f32x4 v[8]; float sc[8];
#pragma unroll
    for (int i = 0; i < 8; ++i) { v[i] = *(const f32x4*)(W + (size_t)(k0 + 8 * i + kr) * N + n0 + n4); sc[i] = kscale ? kscale[k0 + 8 * i + kr] * cs : cs; }
#pragma unroll
    for (int i = 0; i < 8; ++i) { LAS float* d = scr + (8 * i + kr) * 33 + n4; d[0] = v[i][0] * sc[i]; d[1] = v[i][1] * sc[i]; d[2] = v[i][2] * sc[i]; d[3] = v[i][3] * sc[i]; }
    asm volatile("s_waitcnt lgkmcnt(0)" ::: "memory");
    const int c = lane & 7;
#pragma unroll
    for (int j = 0; j < 4; ++j) { const int n = (lane >> 3) + 8 * j; const LAS float* s = scr + (8 * c) * 33 + n;
        u32x4 o; o.x = cvt_pk_bf16(s[0 * 33], s[1 * 33]); o.y = cvt_pk_bf16(s[2 * 33], s[3 * 33]); o.z = cvt_pk_bf16(s[4 * 33], s[5 * 33]); o.w = cvt_pk_bf16(s[6 * 33], s[7 * 33]);
        *(u32x4*)(WT + (size_t)(drow0 + n) * K + k0 + 8 * c) = o; }
    asm volatile("s_waitcnt lgkmcnt(0)" ::: "memory");
}

__device__ __forceinline__ void mm128(const LAS unsigned char* A, const LAS unsigned char* B, int w, int fr, int fq, f32x4 (&acc)[8]) {
    bf16x8 bw[4];
#pragma unroll
    for (int ks = 0; ks < 4; ++ks) bw[ks] = *(const LAS bf16x8*)(B + (16 * w + fr) * 272 + ks * 64 + fq * 16);
#pragma unroll
    for (int ct = 0; ct < 8; ++ct) {
        f32x4 c = (f32x4){0.f, 0.f, 0.f, 0.f};
#pragma unroll
        for (int ks = 0; ks < 4; ++ks) { const bf16x8 a = *(const LAS bf16x8*)(A + (16 * ct + fr) * 272 + ks * 64 + fq * 16); c = mfma16(a, bw[ks], c); }
        acc[ct] = c;
    }
}

struct AttnRegs { u32x4 kv[4], vv[4]; bf16x8 q0, q1; };
__device__ __forceinline__ void attn_decode(int k, int xcd, int& g, int& j, int& sh, int& r, int& n) {
    g = k >> 7; j = (k >> 5) & 3; const int rn = k & 31; sh = 2 * g; r = rn >> (5 - sh); n = rn & ((32 >> sh) - 1); (void)xcd;
}
__device__ __forceinline__ void attn_load(AttnRegs& R, const bf16_t* Z1, int k, int xcd, int tid, int w, int fr, int fq) {
    int g, j, sh, r, n; attn_decode(k, xcd, g, j, sh, r, n);
    const int colq = g * 256 + j * 64; const size_t tok_b = (size_t)xcd * SEQ + r;
#pragma unroll
    for (int it = 0; it < 4; ++it) {
        const int c = tid + NTHREADS * it; const int key = c & 255, dc = c >> 8;
        const int p = (n - 1) * 128 + key; const int pc = p < 0 ? 0 : p;
        const bf16_t* src = Z1 + (tok_b + ((size_t)pc << sh)) * ZP + colq + dc * 8;
        R.kv[it] = *(const u32x4*)(src + 768); R.vv[it] = *(const u32x4*)(src + 1536);
    }
    const bf16_t* qp = Z1 + (tok_b + ((size_t)(n * 128 + 16 * w + fr) << sh)) * ZP + colq;
    R.q0 = *(const bf16x8*)(qp + fq * 8); R.q1 = *(const bf16x8*)(qp + 32 + fq * 8);
}
__device__ __forceinline__ void attn_stage(const AttnRegs& R, LAS unsigned char* lds, int k, int xcd, int tid) {
    int g, j, sh, r, n; attn_decode(k, xcd, g, j, sh, r, n);
#pragma unroll
    for (int it = 0; it < 4; ++it) {
        const int c = tid + NTHREADS * it; const int key = c & 255, dc = c >> 8;
        const bool ok = ((n - 1) * 128 + key) >= 0; const u32x4 z = (u32x4){0u, 0u, 0u, 0u};
        const u32x4 kv = ok ? R.kv[it] : z, vv = ok ? R.vv[it] : z;
        *(LAS u32x4*)(lds + key * 144 + dc * 16) = kv;
        const int k32 = key & 31; const int pos = (key & ~31) + 8 * ((k32 & 15) >> 2) + 4 * (k32 >> 4) + (k32 & 3);
        LAS bf16_t* vt = (LAS bf16_t*)(lds + 36864) + (dc * 8) * 264 + pos;
        vt[0 * 264] = (bf16_t)(vv.x & 0xffffu); vt[1 * 264] = (bf16_t)(vv.x >> 16); vt[2 * 264] = (bf16_t)(vv.y & 0xffffu); vt[3 * 264] = (bf16_t)(vv.y >> 16);
        vt[4 * 264] = (bf16_t)(vv.z & 0xffffu); vt[5 * 264] = (bf16_t)(vv.z >> 16); vt[6 * 264] = (bf16_t)(vv.w & 0xffffu); vt[7 * 264] = (bf16_t)(vv.w >> 16);
    }
}
__device__ __forceinline__ void attn_compute(LAS unsigned char* lds, bf16_t* Z1, float* lse, int k, int xcd, bf16x8 q0, bf16x8 q1, int w, int fr, int fq, bool dostore = true) {
    int g, j, sh, r, n; attn_decode(k, xcd, g, j, sh, r, n);
    const int colq = g * 256 + j * 64; const size_t tok_b = (size_t)xcd * SEQ + r; const int qi = 16 * w + fr;
    bf16_t* qp = Z1 + (tok_b + ((size_t)(n * 128 + qi) << sh)) * ZP + colq;
    const int kt0 = (w < 6 ? w : 6) & ~1;
    f32x4 s[10];
#pragma unroll
    for (int t = 0; t < 10; ++t) {
        const LAS unsigned char* kp = lds + (16 * (kt0 + t) + fr) * 144 + fq * 16;
        const bf16x8 a0 = *(const LAS bf16x8*)kp, a1 = *(const LAS bf16x8*)(kp + 64);
        s[t] = mfma16(a0, q0, (f32x4){0.f, 0.f, 0.f, 0.f}); s[t] = mfma16(a1, q1, s[t]);
    }
    constexpr float L2E = 1.4426950408889634f;
    float mx = -1e30f;
#pragma unroll
    for (int t = 0; t < 10; ++t)
#pragma unroll
        for (int i = 0; i < 4; ++i) {
            const int kj = 16 * (kt0 + t) + 4 * fq + i; const int dist = qi + 128 - kj;
            const bool valid = (dist >= 0) && (dist <= 128) && !(n == 0 && kj < 128);
            const float v = valid ? s[t][i] * L2E : -1e30f; s[t][i] = v; mx = fmaxf(mx, v);
        }
    mx = fmaxf(mx, __shfl_xor(mx, 16)); mx = fmaxf(mx, __shfl_xor(mx, 32));
    float l = 0.f;
#pragma unroll
    for (int t = 0; t < 10; ++t)
#pragma unroll
        for (int i = 0; i < 4; ++i) { const float p = __builtin_amdgcn_exp2f(s[t][i] - mx); s[t][i] = p; l += p; }
    l += __shfl_xor(l, 16); l += __shfl_xor(l, 32);
    f32x4 o[4];
#pragma unroll
    for (int dt = 0; dt < 4; ++dt) o[dt] = (f32x4){0.f, 0.f, 0.f, 0.f};
#pragma unroll
    for (int G = 0; G < 5; ++G) {
        u32x4 pw; pw.x = cvt_pk_bf16(s[2 * G][0], s[2 * G][1]); pw.y = cvt_pk_bf16(s[2 * G][2], s[2 * G][3]); pw.z = cvt_pk_bf16(s[2 * G + 1][0], s[2 * G + 1][1]); pw.w = cvt_pk_bf16(s[2 * G + 1][2], s[2 * G + 1][3]);
        const bf16x8 pb = __builtin_bit_cast(bf16x8, pw);
#pragma unroll
        for (int dt = 0; dt < 4; ++dt) {
            const bf16x8 va = *(const LAS bf16x8*)(lds + 36864 + (16 * dt + fr) * 528 + (32 * (kt0 / 2 + G) + 8 * fq) * 2);
            o[dt] = mfma16(va, pb, o[dt]);
        }
    }
    const float rl = 1.0f / l;
    if (!dostore) { if (rl == 123.456f) lse[0] = o[0][0] + o[1][1] + o[2][2] + o[3][3]; return; }
#pragma unroll
    for (int dt = 0; dt < 4; ++dt) { u32x2 wv; wv.x = cvt_pk_bf16(o[dt][0] * rl, o[dt][1] * rl); wv.y = cvt_pk_bf16(o[dt][2] * rl, o[dt][3] * rl); *(u32x2*)(qp + 16 * dt + 4 * fq) = wv; }
    if (fq == 0) lse[(size_t)((g * 4 + j) * 8 + xcd) * SEQ + r * (SEQ >> sh) + n * 128 + qi] = (mx + __log2f(l)) * 0.6931471805599453f;
}
__device__ __forceinline__ void attn_phase(LAS unsigned char* lds, bf16_t* Z1, float* lse, int xcd, int slot, int nslot, int tid, bool dostore = true) {
    asm volatile("" : "+v"(tid));
    const int lane = tid & 63, w = __builtin_amdgcn_readfirstlane(tid >> 6), fr = lane & 15, fq = lane >> 4;
    int k = slot; if (k >= 384) return;
    AttnRegs R; attn_load(R, Z1, k, xcd, tid, w, fr, fq);
    for (;;) {
        attn_stage(R, lds, k, xcd, tid);
        const bf16x8 q0 = R.q0, q1 = R.q1;
        __syncthreads();
        const int kn = k + nslot;
        if (kn < 384) attn_load(R, Z1, kn, xcd, tid, w, fr, fq);
        attn_compute(lds, Z1, lse, k, xcd, q0, q1, w, fr, fq, dostore);
        __syncthreads();
        if (kn >= 384) break;
        k = kn;
    }
}

__device__ __forceinline__ void gate_unit(LAS unsigned char* lds, const bf16_t* Z1, bf16_t* yb, const bf16_t* wsT, const float* lng, const float* lnb, const float* bbs, int ch, int tid) {
    asm volatile("" : "+v"(tid));
    const int lane = tid & 63, w = __builtin_amdgcn_readfirstlane(tid >> 6), fr = lane & 15, fq = lane >> 4;
    const size_t t0 = (size_t)ch * 128;
    LAS float* st = (LAS float*)lds;
    for (int i = 0; i < 16; ++i) {
        const int t = 16 * w + i;
        const u32x4 raw = *(const u32x4*)(Z1 + (t0 + t) * ZP + 2816 + lane * 8);
        float x[8] = {bf_lo(raw.x), bf_hi(raw.x), bf_lo(raw.y), bf_hi(raw.y), bf_lo(raw.z), bf_hi(raw.z), bf_lo(raw.w), bf_hi(raw.w)};
        float sm = 0.f;
#pragma unroll
        for (int e = 0; e < 8; ++e) sm += x[e];
        const float mean = wave_sum(sm) * (1.0f / 512.0f); float q = 0.f;
#pragma unroll
        for (int e = 0; e < 8; ++e) { const float d = x[e] - mean; q += d * d; }
        const float rstd = rsqrtf(wave_sum(q) * (1.0f / 512.0f) + 1e-6f);
        if (lane == 0) { st[2 * t] = mean; st[2 * t + 1] = rstd; }
    }
    __syncthreads();
    for (int g = 0; g < 4; ++g) {
#pragma unroll
        for (int it = 0; it < 4; ++it) {
            const int c = tid + NTHREADS * it; const int row = c >> 4, c8 = c & 15;
            *(LAS u32x4*)(lds + 1024 + row * 272 + c8 * 16) = *(const u32x4*)(wsT + (size_t)(g * 128 + row) * 128 + c8 * 8);
        }
#pragma unroll
        for (int it = 0; it < 4; ++it) {
            const int c = tid + NTHREADS * it; const int sidx = c & 127, c8 = c >> 7;
            const u32x4 raw = *(const u32x4*)(Z1 + (t0 + sidx) * ZP + 2816 + g * 128 + c8 * 8);
            const float mean = st[2 * sidx], rstd = st[2 * sidx + 1];
            const int chn = g * 128 + c8 * 8;
            const f32x4 g0 = *(const f32x4*)(lng + chn), g1 = *(const f32x4*)(lng + chn + 4), b0 = *(const f32x4*)(lnb + chn), b1 = *(const f32x4*)(lnb + chn + 4);
            const float x[8] = {bf_lo(raw.x), bf_hi(raw.x), bf_lo(raw.y), bf_hi(raw.y), bf_lo(raw.z), bf_hi(raw.z), bf_lo(raw.w), bf_hi(raw.w)};
            const float gg[8] = {g0[0], g0[1], g0[2], g0[3], g1[0], g1[1], g1[2], g1[3]}; const float bb[8] = {b0[0], b0[1], b0[2], b0[3], b1[0], b1[1], b1[2], b1[3]};
            LAS bf16_t* vt = (LAS bf16_t*)(lds + 35840) + (c8 * 8) * 136 + sidx;
#pragma unroll
            for (int e = 0; e < 8; e += 2) { const unsigned pk = cvt_pk_bf16((x[e] - mean) * rstd * gg[e] + bb[e], (x[e + 1] - mean) * rstd * gg[e + 1] + bb[e + 1]); vt[e * 136] = (bf16_t)(pk & 0xffffu); vt[(e + 1) * 136] = (bf16_t)(pk >> 16); }
        }
        __syncthreads();
        f32x4 acc[8];
        mm128(lds + 35840, lds + 1024, w, fr, fq, acc);
        const int t = 16 * w + fr; const float bias = bbs[g * 128 + t];
#pragma unroll
        for (int ct = 0; ct < 8; ++ct) {
            const int chn = g * 128 + 16 * ct + 4 * fq;
            const u32x2 uu = *(const u32x2*)(Z1 + (t0 + t) * ZP + 2304 + chn);
            u32x2 o; o.x = cvt_pk_bf16(bf_lo(uu.x) * (acc[ct][0] + bias), bf_hi(uu.x) * (acc[ct][1] + bias)); o.y = cvt_pk_bf16(bf_lo(uu.y) * (acc[ct][2] + bias), bf_hi(uu.y) * (acc[ct][3] + bias));
            *(u32x2*)(yb + (t0 + t) * 512 + chn) = o;
        }
        __syncthreads();
    }
}

__device__ __forceinline__ void pool_unit(LAS unsigned char* lds, const bf16_t* Z1, bf16_t* yc, const bf16_t* wcT, const float* cscale, int unit, int tid) {
    asm volatile("" : "+v"(tid));
    const int lane = tid & 63, w = __builtin_amdgcn_readfirstlane(tid >> 6), fr = lane & 15, fq = lane >> 4;
    const int tile = unit >> 2, gi = unit & 3; const size_t t0 = (size_t)tile * 128; const int tpos0 = (int)(t0 & (SEQ - 1)); const int win = 2 << gi;
    for (int c = tid; c < 143 * 16; c += NTHREADS) {
        const int row = c >> 4, c8 = c & 15; const int tt = row - 15;
        u32x4 v = (u32x4){0u, 0u, 0u, 0u};
        if (tpos0 + tt >= 0) v = *(const u32x4*)(Z1 + (size_t)((long)t0 + tt) * ZP + 3328 + gi * 128 + c8 * 8);
        *(LAS u32x4*)(lds + row * 272 + c8 * 16) = v;
    }
#pragma unroll
    for (int it = 0; it < 4; ++it) {
        const int c = tid + NTHREADS * it; const int row = c >> 4, c8 = c & 15;
        *(LAS u32x4*)(lds + 73728 + row * 272 + c8 * 16) = *(const u32x4*)(wcT + (size_t)(gi * 128 + row) * 128 + c8 * 8);
    }
    __syncthreads();
#pragma unroll
    for (int it = 0; it < 4; ++it) {
        const int c = tid + NTHREADS * it; const int t = c >> 4, c8 = c & 15;
        const int cnt = (tpos0 + t + 1 < win) ? (tpos0 + t + 1) : win;
        float sm[8] = {0.f, 0.f, 0.f, 0.f, 0.f, 0.f, 0.f, 0.f};
        for (int i = 0; i < cnt; ++i) { const u32x4 raw = *(const LAS u32x4*)(lds + (t + 15 - i) * 272 + c8 * 16);
            sm[0] += bf_lo(raw.x); sm[1] += bf_hi(raw.x); sm[2] += bf_lo(raw.y); sm[3] += bf_hi(raw.y); sm[4] += bf_lo(raw.z); sm[5] += bf_hi(raw.z); sm[6] += bf_lo(raw.w); sm[7] += bf_hi(raw.w); }
        const u32x4 xt = *(const LAS u32x4*)(lds + (t + 15) * 272 + c8 * 16); const float ic = 1.0f / (float)cnt;
        u32x4 o; o.x = cvt_pk_bf16(sm[0] * ic - bf_lo(xt.x), sm[1] * ic - bf_hi(xt.x)); o.y = cvt_pk_bf16(sm[2] * ic - bf_lo(xt.y), sm[3] * ic - bf_hi(xt.y));
        o.z = cvt_pk_bf16(sm[4] * ic - bf_lo(xt.z), sm[5] * ic - bf_hi(xt.z)); o.w = cvt_pk_bf16(sm[6] * ic - bf_lo(xt.w), sm[7] * ic - bf_hi(xt.w));
        *(LAS u32x4*)(lds + 38912 + t * 272 + c8 * 16) = o;
    }
    __syncthreads();
    f32x4 acc[8];
    mm128(lds + 73728, lds + 38912, w, fr, fq, acc);
    const int t = 16 * w + fr;
#pragma unroll
    for (int dt = 0; dt < 8; ++dt) {
        const int d = gi * 128 + 16 * dt + 4 * fq; const f32x4 sc = *(const f32x4*)(cscale + d);
        u32x2 o; o.x = cvt_pk_bf16(acc[dt][0] * sc[0], acc[dt][1] * sc[1]); o.y = cvt_pk_bf16(acc[dt][2] * sc[2], acc[dt][3] * sc[3]);
        *(u32x2*)(yc + (t0 + t) * 512 + d) = o;
    }
    __syncthreads();
}

typedef unsigned v4u __attribute__((ext_vector_type(4)));
#define XB_TMO      128
#define XB_XCNT(j)  (256  + 64 * (j))
#define XB_XSUB(j)  (1280 + 64 * (j))
#define XB_XGEN(j)  (2304 + 64 * (j))
#define XB_TOP      3328
#define XB_TOPGEN   3392
#define XCD_BAR_WORDS 3456
#define XB_SPIN_CAP (1u << 18)

__device__ __forceinline__ unsigned xb_ld(unsigned* p)              { return __hip_atomic_load(p, __ATOMIC_RELAXED, __HIP_MEMORY_SCOPE_AGENT); }
__device__ __forceinline__ unsigned xb_add(unsigned* p, unsigned v) { return __hip_atomic_fetch_add(p, v, __ATOMIC_RELAXED, __HIP_MEMORY_SCOPE_AGENT); }
__device__ __forceinline__ unsigned xb_xcc_id() { return (unsigned)__builtin_amdgcn_s_getreg((3 << 11) | 20) & 0xFu; }
#define XB_SPIN(cond, bar) do { unsigned _sp = 0; while (cond) { __builtin_amdgcn_s_sleep(1); \
    if ((++_sp & 255u) == 0u) { if (xb_ld(&(bar)[XB_TMO])) break; if (_sp > XB_SPIN_CAP) { atomicAdd(&(bar)[XB_TMO], 1u); break; } } } } while (0)

struct XcdBarrier {
    unsigned* bar; unsigned x;
    volatile LAS unsigned* st;
};

__device__ __forceinline__ XcdBarrier xcd_barrier_post(unsigned* bar, volatile LAS unsigned* st) {
    XcdBarrier b; b.bar = bar; b.x = xb_xcc_id(); b.st = st;
    if (threadIdx.x == 0) (void)xb_add(&bar[XB_XCNT(b.x)], 1u);
    return b;
}
__device__ __forceinline__ void xcd_barrier_complete(unsigned* bar, unsigned x, unsigned& nloc, unsigned& nx) {
    const unsigned G = gridDim.x * gridDim.y * gridDim.z;
    unsigned sum, cnt, mine, sp = 0u;
    for (;;) {
        sum = 0u; cnt = 0u; mine = 0u;
#pragma unroll
        for (unsigned j = 0; j < 16; ++j) { const unsigned c = xb_ld(&bar[XB_XCNT(j)]); sum += c; cnt += (c > 0u) ? 1u : 0u; mine = (j == x) ? c : mine; }
        if (sum == G) break;
        __builtin_amdgcn_s_sleep(1);
        if ((++sp & 255u) == 0u) { if (xb_ld(&bar[XB_TMO])) break; if (sp > XB_SPIN_CAP) { atomicAdd(&bar[XB_TMO], 1u); break; } }
    }
    nloc = mine > 0u ? mine : 1u; nx = cnt > 0u ? cnt : 1u;
}

__device__ __forceinline__ void xcd_barrier(const XcdBarrier& b) {
    asm volatile("s_waitcnt vmcnt(0)" ::: "memory");
    __syncthreads();
    if (threadIdx.x == 0) {
        unsigned* bar = b.bar;
        __builtin_amdgcn_s_waitcnt(0);
        unsigned nloc = b.st[0], nx = b.st[1];
        if (nloc == 0u) { xcd_barrier_complete(bar, b.x, nloc, nx); b.st[0] = nloc; b.st[1] = nx; }
        const unsigned old = xb_add(&bar[XB_XSUB(b.x)], 1u);
        const unsigned gen = old / nloc;
        if (old + 1u == (gen + 1u) * nloc) {
            __builtin_amdgcn_fence(__ATOMIC_RELEASE, "agent");
            asm volatile("s_waitcnt vmcnt(0)" ::: "memory");
            const unsigned og = xb_add(&bar[XB_TOP], 1u);
            const unsigned tg = og / nx;
            if (og + 1u == (tg + 1u) * nx) xb_add(&bar[XB_TOPGEN], 1u);
            else XB_SPIN(xb_ld(&bar[XB_TOPGEN]) == tg, bar);
            __builtin_amdgcn_fence(__ATOMIC_ACQUIRE, "agent");
            xb_add(&bar[XB_XGEN(b.x)], 1u);
            asm volatile("s_waitcnt vmcnt(0)" ::: "memory");
        } else {
            XB_SPIN(xb_ld(&bar[XB_XGEN(b.x)]) == gen, bar);
            __builtin_amdgcn_fence(__ATOMIC_ACQUIRE, "agent");
            asm volatile("s_waitcnt vmcnt(0)" ::: "memory");
        }
    }
    __syncthreads();
}


__device__ __forceinline__ void grid_seam(unsigned* bar, unsigned target) {
#ifdef DBG_REP_SEAM
  for (int rep_ = 0; rep_ < 2; ++rep_) {
    target = 2 * target - (1 - rep_) * gridDim.x;
#endif
    asm volatile("s_waitcnt vmcnt(0) lgkmcnt(0)" ::: "memory");
    __syncthreads();
    if (threadIdx.x == 0) {
        __builtin_amdgcn_fence(__ATOMIC_RELEASE, "agent"); asm volatile("s_waitcnt vmcnt(0)" ::: "memory");
        __hip_atomic_fetch_add(bar, 1u, __ATOMIC_RELAXED, __HIP_MEMORY_SCOPE_AGENT);
        unsigned spins = 0;
        while (__hip_atomic_load(bar, __ATOMIC_RELAXED, __HIP_MEMORY_SCOPE_AGENT) < target) { __builtin_amdgcn_s_sleep(2); if (++spins > (1u << 24)) break; }
        __builtin_amdgcn_fence(__ATOMIC_ACQUIRE, "agent"); asm volatile("s_waitcnt vmcnt(0)" ::: "memory");
    }
    __syncthreads();
#ifdef DBG_REP_SEAM
    target = (target + (1 - rep_) * gridDim.x) / 2;
  }
#endif
}

#ifndef DBG_SEAM_ALL
#define DBG_SEAM_ALL 0
#endif
__device__ __forceinline__ float* rowss_arr(float* dout, unsigned char* ws, int k) { return k < 6 ? dout + (size_t)k * NT * 16 : (float*)(ws + WS_RS6); }
#ifdef MK_FLAT_BAR
#define SEAM() grid_seam((unsigned*)(a.ws + WS_BAR) + 4096, nseam * (unsigned)G)
#else
#define SEAM() xcd_barrier(xbar)
#endif
struct Args { const float* in[23]; float* out; unsigned char* ws; int ph_lo, ph_hi; };

__global__ void __launch_bounds__(NTHREADS, 2) mega_fwd(Args a) {
    extern __shared__ __attribute__((aligned(16))) unsigned char lds_raw[];
    cg::grid_group grid = cg::this_grid();
    LAS unsigned char* lds = (LAS unsigned char*)lds_raw;
    const int G = gridDim.x, bid = blockIdx.x;
    const int ph_lo = a.ph_lo, ph_hi = a.ph_hi;
    volatile LAS unsigned* bst = (volatile LAS unsigned*)(lds + LDS_STAGE);
    if (threadIdx.x < 2) bst[threadIdx.x] = 0u;
    __syncthreads();
    const XcdBarrier xbar = xcd_barrier_post((unsigned*)(a.ws + WS_BAR), bst);
    if (ph_hi - ph_lo == 26) grid.sync();

#ifdef DBG_REP_P0
    for (int rep_ = 0; rep_ < 2; ++rep_)
#endif
    if (ph_lo <= 0) {
        int tid = threadIdx.x; asm volatile("" : "+v"(tid));
        const int lane = tid & 63, wave = __builtin_amdgcn_readfirstlane(tid >> 6);
        unsigned char* ws = a.ws;
        bf16_t* Wb = (bf16_t*)(ws + WS_W); bf16_t* wcT = (bf16_t*)(ws + WS_WCT); bf16_t* wsT = (bf16_t*)(ws + WS_WST); bf16_t* xb = (bf16_t*)(ws + WS_XB); float* rowss = rowss_arr(a.out, ws, 0);
        const int gw = bid * 8 + wave, NGW = G * 8;
        LAS float* scr = (LAS float*)(lds + wave * 16384);
        for (int it0 = gw; it0 < 2 * 13056 + 64; it0 += NGW) {
            const float* src; bf16_t* dst; const float* ksc = nullptr; float cs = 1.f; int K, N, map = 0, it;
            if (it0 < 2 * 13056) {
                const int l = it0 >= 13056 ? 1 : 0; const int r = it0 - l * 13056; bf16_t* Wl = Wb + (size_t)l * W_LAYER;
                if (r < 1408)       { it = r;         src = a.in[2] + (size_t)l * DM * FF; K = DM; N = FF; dst = Wl + WO_GU1; ksc = a.in[1] + l * DM; map = 1; }
                else if (r < 2816)  { it = r - 1408;  src = a.in[3] + (size_t)l * DM * FF; K = DM; N = FF; dst = Wl + WO_GU1; ksc = a.in[1] + l * DM; map = 2; }
                else if (r < 4224)  { it = r - 2816;  src = a.in[4] + (size_t)l * DM * FF; K = FF; N = DM; dst = Wl + WO_D1; cs = 0.5f; }
                else if (r < 7680)  { it = r - 4224;  src = a.in[6] + (size_t)l * DM * 6912; K = DM; N = 6912; dst = Wl + WO_IN; ksc = a.in[5] + l * DM; }
                else if (r < 7808)  { it = r - 7680;  src = a.in[14] + (size_t)l * 256 * DM; K = 256; N = DM; dst = Wl + WO_PA; }
                else if (r < 8064)  { it = r - 7808;  src = a.in[15] + (size_t)l * 512 * DM; K = 512; N = DM; dst = Wl + WO_PB; }
                else if (r < 8320)  { it = r - 8064;  src = a.in[16] + (size_t)l * 512 * DM; K = 512; N = DM; dst = Wl + WO_PC; }
                else if (r < 8832)  { it = r - 8320;  src = a.in[17] + (size_t)l * DM * DM; K = DM; N = DM; dst = Wl + WO_OUT; }
                else if (r < 10240) { it = r - 8832;  src = a.in[19] + (size_t)l * DM * FF; K = DM; N = FF; dst = Wl + WO_GU2; ksc = a.in[18] + l * DM; map = 1; }
                else if (r < 11648) { it = r - 10240; src = a.in[20] + (size_t)l * DM * FF; K = DM; N = FF; dst = Wl + WO_GU2; ksc = a.in[18] + l * DM; map = 2; }
                else                { it = r - 11648; src = a.in[21] + (size_t)l * DM * FF; K = FF; N = DM; dst = Wl + WO_D2; cs = 0.5f; }
            } else { const int q = (it0 - 2 * 13056) >> 3; it = (it0 - 2 * 13056) & 7; src = a.in[12] + (size_t)q * 16384; K = 128; N = 128; dst = wcT + (size_t)q * 16384; }
            const int nblk = N / 32;
            const int kb = it / nblk, nb = it % nblk, n0 = 32 * nb;
            const int drow0 = (map == 0) ? n0 : ((n0 >> 7) * 256 + (n0 & 127) + (map == 2 ? 128 : 0));
            transpose_item(src, K, N, dst, n0, drow0, 64 * kb, ksc, cs, scr, lane);
        }
        const int xcd = bid & 7, slot = bid >> 3, nslot = G >> 3;
        for (int i = bid * NTHREADS + tid; i < 2 * 4 * 128 * 128; i += G * NTHREADS) {
            const int t = (i >> 7) & 127, s = i & 127; const float v = (s <= t) ? a.in[10][i] : 0.f;
            wsT[i] = (bf16_t)(cvt_pk_bf16(v, 0.f) & 0xffffu);
        }
        const float* x = a.in[0];
        for (int m = xcd * SEQ + slot * 8 + wave; m < (xcd + 1) * SEQ; m += nslot * 8) {
            const f32x4* xr = (const f32x4*)(x + (size_t)m * DM) + lane; u32x2* o8 = (u32x2*)(xb + (size_t)m * DM) + lane; float ss = 0.f;
#pragma unroll
            for (int jj = 0; jj < 4; ++jj) { const f32x4 v = xr[64 * jj]; ss += (v[0] * v[0] + v[1] * v[1]) + (v[2] * v[2] + v[3] * v[3]); u32x2 o; o.x = cvt_pk_bf16(v[0], v[1]); o.y = cvt_pk_bf16(v[2], v[3]); o8[64 * jj] = o; }
            ss = wave_sum(ss); if (lane < 4) ((f32x4*)(rowss + (size_t)m * 16))[lane] = (f32x4){lane == 0 ? ss : 0.f, 0.f, 0.f, 0.f};
        }
    }
    unsigned nseam = 0;
    if (ph_lo <= 0 && ph_hi > 1) { ++nseam; SEAM(); }

    for (int lst = 0; lst < 24; ++lst) {
        if (lst + 1 < ph_lo || lst + 1 >= ph_hi) continue;
        int lq = __builtin_amdgcn_readfirstlane(lst / 12), st = __builtin_amdgcn_readfirstlane(lst % 12), zoff = __builtin_amdgcn_readfirstlane(0);
        asm volatile("" : "+s"(lq), "+s"(st), "+s"(zoff));
        unsigned char* ws = a.ws + zoff;
        const int l = lq;
        bf16_t* RA = (bf16_t*)(ws + WS_A);
        const bf16_t* Wl = (const bf16_t*)(ws + WS_W) + (size_t)l * W_LAYER;
        bool isg = true, sync = true;
        pg8::Gemm g{nullptr, nullptr, NT, 0, 0};
        pg8::EpiMix e{}; e.mode = 0; e.rs = nullptr; e.aux = nullptr; e.ob = nullptr; e.ldo = 0;
        switch (st) {
            case 0: g.A = (bf16_t*)(ws + WS_XB); g.Bt = Wl + WO_GU1; g.N = 2 * FF; g.K = DM; e.mode = pg8::EM_SWIGLU; e.rs = rowss_arr(a.out, ws, 3 * l); e.ob = RA; e.ldo = FF; break;
            case 1: g.A = RA; g.Bt = Wl + WO_D1; g.N = DM; g.K = FF; e.mode = pg8::EM_RESID; e.aux = (l == 0) ? (const void*)a.in[0] : nullptr; e.ob = (bf16_t*)(ws + WS_XB); e.ldo = DM; e.rs = rowss_arr(a.out, ws, 3 * l + 1); break;
            case 2: g.A = (bf16_t*)(ws + WS_XB); g.Bt = Wl + WO_IN; g.N = ZP; g.K = DM; e.mode = pg8::EM_Z1; e.rs = rowss_arr(a.out, ws, 3 * l + 1); e.ob = RA; e.ldo = ZP; break;
            case 3: isg = false; break;
            case 4: isg = false; break;
            case 5: g.A = (bf16_t*)(ws + WS_XB); g.Bt = Wl + WO_IN + (size_t)ZP * DM; g.N = 3072; g.K = DM; e.mode = pg8::EM_GATE; e.rs = rowss_arr(a.out, ws, 3 * l + 1); e.aux = a.in[7] + l * 3072; e.ob = RA; e.ldo = 3072; break;
            case 6: g.A = (bf16_t*)(ws + WS_YA); g.Bt = Wl + WO_PA; g.N = DM; g.K = 256; e.mode = pg8::EM_PROJ0; e.aux = RA; e.ob = (bf16_t*)(ws + WS_MERGED); e.ldo = DM; sync = (DBG_SEAM_ALL != 0); break;
            case 7: g.A = (bf16_t*)(ws + WS_YB); g.Bt = Wl + WO_PB; g.N = DM; g.K = 512; e.mode = pg8::EM_PROJ1; e.aux = RA + 1024; e.ob = (bf16_t*)(ws + WS_MERGED); e.ldo = DM; sync = (DBG_SEAM_ALL != 0); break;
            case 8: g.A = (bf16_t*)(ws + WS_YC); g.Bt = Wl + WO_PC; g.N = DM; g.K = 512; e.mode = pg8::EM_PROJ1; e.aux = RA + 2048; e.ob = (bf16_t*)(ws + WS_MERGED); e.ldo = DM; break;
            case 9: g.A = (bf16_t*)(ws + WS_MERGED); g.Bt = Wl + WO_OUT; g.N = DM; g.K = DM; e.mode = pg8::EM_RESID; e.aux = nullptr; e.ob = (bf16_t*)(ws + WS_XB); e.ldo = DM; e.rs = rowss_arr(a.out, ws, 3 * l + 2); break;
            case 10: g.A = (bf16_t*)(ws + WS_XB); g.Bt = Wl + WO_GU2; g.N = 2 * FF; g.K = DM; e.mode = pg8::EM_SWIGLU; e.rs = rowss_arr(a.out, ws, 3 * l + 2); e.ob = RA; e.ldo = FF; break;
            default: g.A = RA; g.Bt = Wl + WO_D2; g.N = DM; g.K = FF; e.mode = pg8::EM_RESID; e.aux = nullptr; e.ob = (bf16_t*)(ws + WS_XB); e.ldo = DM; e.rs = rowss_arr(a.out, ws, 3 * l + 3); break;
        }
        if (isg) {
            pg8::StaticOrder S; S.init(NT, g.N, G, bid);
#ifdef DBG_REP_GEMM0
            for (int rep_ = (st == 0 || st == 10) ? 0 : 1; rep_ < 2; ++rep_)
#endif
            pg8::gemm_phase<pg8::EpiMix, pg8::StaticOrder, true, true>(lds, g, S, e);
        } else if (st == 3) {
#ifndef DBG_NO_MIX
            const int tid = threadIdx.x;
            float* lse = (float*)(ws + WS_LSE);
            const int xcd = bid & 7, slot = bid >> 3, nslot = G >> 3;
#ifndef DBG_NO_ATTN
            attn_phase(lds, RA, lse, xcd, slot, nslot, tid);
#ifdef DBG_REP_ATTN
            { int ds_ = 0; asm volatile("" : "+s"(ds_)); attn_phase(lds, RA, lse, xcd, slot, nslot, tid, ds_ != 0); }
#endif
#endif
#ifdef DBG_REP_MIX
            for (int rep_ = 0; rep_ < 2; ++rep_) {
#endif
#ifndef DBG_NO_GATE
            for (int k = slot; k < 32; k += nslot) gate_unit(lds, RA, (bf16_t*)(ws + WS_YB), (const bf16_t*)(ws + WS_WST) + (size_t)l * 65536, a.in[8] + l * 512, a.in[9] + l * 512, a.in[11] + l * 512, xcd * 32 + k, tid);
#endif
#ifndef DBG_NO_POOL
            for (int k = slot; k < 128; k += nslot) pool_unit(lds, RA, (bf16_t*)(ws + WS_YC), (const bf16_t*)(ws + WS_WCT) + (size_t)l * 65536, a.in[13] + l * 512, xcd * 128 + k, tid);
#endif
#ifdef DBG_REP_MIX
            }
#endif
#endif
        } else {
#ifndef DBG_NO_COMB
            int tid = threadIdx.x; asm volatile("" : "+v"(tid));
            const float* lse = (const float*)(ws + WS_LSE); bf16_t* ya = (bf16_t*)(ws + WS_YA);
            const int xcd = bid & 7, slot = bid >> 3, nslot = G >> 3;
#ifdef DBG_REP_MIX
            for (int rep_ = 0; rep_ < 2; ++rep_)
#endif
            for (int i = xcd * (SEQ * 32) + slot * NTHREADS + tid; i < (xcd + 1) * (SEQ * 32); i += nslot * NTHREADS) {
                const int tok = i >> 5, j = (i >> 3) & 3, d8 = i & 7;
                const int bb = tok >> 12, tq = tok & (SEQ - 1);
                const float l0 = lse[(size_t)((0 * 4 + j) * 8 + bb) * SEQ + tq], l1 = lse[(size_t)((1 * 4 + j) * 8 + bb) * SEQ + (tq & 3) * (SEQ >> 2) + (tq >> 2)], l2 = lse[(size_t)((2 * 4 + j) * 8 + bb) * SEQ + (tq & 15) * (SEQ >> 4) + (tq >> 4)];
                const float mx = fmaxf(l0, fmaxf(l1, l2)); float e0 = __expf(l0 - mx), e1 = __expf(l1 - mx), e2 = __expf(l2 - mx); const float inv = 1.0f / (e0 + e1 + e2); e0 *= inv; e1 *= inv; e2 *= inv;
                const bf16_t* op = RA + (size_t)tok * ZP + j * 64 + d8 * 8;
                const u32x4 o0 = *(const u32x4*)op, o1 = *(const u32x4*)(op + 256), o2 = *(const u32x4*)(op + 512);
                u32x4 r;
#ifdef DBG_COPY_YA
                e0 = 0.f; e1 = 0.f; e2 = 1.f; (void)l0; (void)l1; (void)l2;
                { const u32x4 kk = *(const u32x4*)(op + 768); (void)o0; (void)o1; (void)o2; r = kk; *(u32x4*)(ya + (size_t)tok * 256 + j * 64 + d8 * 8) = r; continue; }
#endif
                r.x = cvt_pk_bf16(e0 * bf_lo(o0.x) + e1 * bf_lo(o1.x) + e2 * bf_lo(o2.x), e0 * bf_hi(o0.x) + e1 * bf_hi(o1.x) + e2 * bf_hi(o2.x));
                r.y = cvt_pk_bf16(e0 * bf_lo(o0.y) + e1 * bf_lo(o1.y) + e2 * bf_lo(o2.y), e0 * bf_hi(o0.y) + e1 * bf_hi(o1.y) + e2 * bf_hi(o2.y));
                r.z = cvt_pk_bf16(e0 * bf_lo(o0.z) + e1 * bf_lo(o1.z) + e2 * bf_lo(o2.z), e0 * bf_hi(o0.z) + e1 * bf_hi(o1.z) + e2 * bf_hi(o2.z));
                r.w = cvt_pk_bf16(e0 * bf_lo(o0.w) + e1 * bf_lo(o1.w) + e2 * bf_lo(o2.w), e0 * bf_hi(o0.w) + e1 * bf_hi(o1.w) + e2 * bf_hi(o2.w));
                *(u32x4*)(ya + (size_t)tok * 256 + j * 64 + d8 * 8) = r;
            }
#endif
        }
        if (sync && lst + 2 < ph_hi) { ++nseam; SEAM(); }
    }
    if (ph_hi > 25) {
        int tid = threadIdx.x; asm volatile("" : "+v"(tid));
        const int lane = tid & 63, wave = __builtin_amdgcn_readfirstlane(tid >> 6);
        const float* fn = a.in[22]; const float* rs6 = (const float*)(a.ws + WS_RS6); float* X = a.out; const bf16_t* xb = (const bf16_t*)(a.ws + WS_XB);
        const int xcd = bid & 7, slot = bid >> 3, nslot = G >> 3;
        for (int m = xcd * SEQ + slot * 8 + wave; m < (xcd + 1) * SEQ; m += nslot * 8) {
            const float rs = pg8::rstd_of(rs6, m);
            const u32x4* xr = (const u32x4*)(xb + (size_t)m * DM) + lane; f32x4* orow = (f32x4*)(X + (size_t)m * DM) + 2 * lane; const f32x4* gr = (const f32x4*)fn + 2 * lane;
#pragma unroll
            for (int jj = 0; jj < 2; ++jj) { const u32x4 v = xr[64 * jj]; const f32x4 g0 = gr[128 * jj], g1 = gr[128 * jj + 1];
                orow[128 * jj] = (f32x4){bf_lo(v.x), bf_hi(v.x), bf_lo(v.y), bf_hi(v.y)} * rs * g0; orow[128 * jj + 1] = (f32x4){bf_lo(v.z), bf_hi(v.z), bf_lo(v.w), bf_hi(v.w)} * rs * g1; }
        }
    }
}

extern "C" void kernel_launch(void* const* d_in, const int* in_sizes, int n_in, void* d_out, int out_size, void* d_ws, size_t ws_size, hipStream_t stream) {
    static int grid = 0;
    if (grid == 0) {
        if (n_in != 23 || in_sizes[0] != NT * DM || out_size != NT * DM || ws_size < WS_END) { fprintf(stderr, "kernel_launch: unexpected problem (n_in %d, in0 %d, out %d, ws %zu)\n", n_in, n_in > 0 ? in_sizes[0] : -1, out_size, ws_size); grid = -1; return; }
        int dev = 0, cus = 0, per_cu = 0;
        if (hipGetDevice(&dev) != hipSuccess || hipDeviceGetAttribute(&cus, hipDeviceAttributeMultiprocessorCount, dev) != hipSuccess) { grid = -1; return; }
        if (hipFuncSetAttribute((const void*)mega_fwd, hipFuncAttributeMaxDynamicSharedMemorySize, LDS_BYTES) != hipSuccess) { fprintf(stderr, "kernel_launch: hipFuncSetAttribute failed\n"); grid = -1; return; }
        if (hipOccupancyMaxActiveBlocksPerMultiprocessor(&per_cu, (const void*)mega_fwd, NTHREADS, LDS_BYTES) != hipSuccess || per_cu < 1) { fprintf(stderr, "kernel_launch: occupancy query says %d\n", per_cu); per_cu = 1; }
        (void)hipGetLastError();
        grid = cus & ~7;
    }
    if (grid < 0) return;
    (void)hipMemsetAsync((char*)d_ws + WS_BAR, 0, 32768, stream);
    Args a{};
    for (int i = 0; i < 23; ++i) a.in[i] = (const float*)d_in[i];
    a.out = (float*)d_out; a.ws = (unsigned char*)d_ws;
#ifndef MK_N_LAUNCHES
#define MK_N_LAUNCHES 1
#endif
#if MK_N_LAUNCHES == 1
    a.ph_lo = 0; a.ph_hi = 26;
    void* args[] = {&a};
    hipError_t e = hipLaunchCooperativeKernel((const void*)mega_fwd, dim3(grid), dim3(NTHREADS), args, LDS_BYTES, stream);
    if (e != hipSuccess) fprintf(stderr, "cooperative launch failed: %s (grid %d)\n", hipGetErrorString(e), grid);
#else
    for (int ph = 0; ph < 26; ++ph) {
        int hi = ph + 1; const int stp = (ph >= 1 && ph <= 24) ? (ph - 1) % 12 : -1; if (stp == 6) hi = ph + 3;
        a.ph_lo = ph; a.ph_hi = hi;
        hipLaunchKernelGGL(mega_fwd, dim3(grid), dim3(NTHREADS), LDS_BYTES, stream, a);
        ph = hi - 1;
    }
#endif
}
```

```cpp
#include <hip/hip_runtime.h>
#include <hip/hip_cooperative_groups.h>
#include <cstdio>
#include <cstdint>
namespace pg8 {
#define PG8_LAS __attribute__((address_space(3)))
typedef unsigned short bf16_t;
typedef short bf16x8 __attribute__((ext_vector_type(8)));
typedef float f32x4 __attribute__((ext_vector_type(4)));
typedef unsigned u32x4 __attribute__((ext_vector_type(4)));
constexpr int BM = 256, BK = 64, HALF = 128, HTB = HALF * BK * 2  , STAGE_BYTES = 8 * HTB, NXCD = 8, WGM = 8;

__host__ __device__ __forceinline__ int lds_byte(int r, int c) { const int st = (r >> 4) * 2 + (c >> 5), rr = r & 15, cc = c & 31, ob = rr * 64 + cc * 2; return st * 1024 + (ob ^ (((ob >> 9) & 1) << 5)); }
__host__ __device__ __forceinline__ void stage_rc(int b, int& R, int& C) { const int st = b / 1024, sb = b % 1024, swz = sb ^ (((sb >> 9) & 1) << 5); R = (st >> 1) * 16 + swz / 64; C = (st & 1) * 32 + (swz % 64) / 2; }
__host__ __device__ __forceinline__ int perm32(int rho) { const int n = rho >> 4, i = rho & 15; return 8 * (i >> 2) + 4 * n + (i & 3); }

struct Unit { int pm, pn; };
struct Gemm { const bf16_t* A; const bf16_t* Bt; int M, N, K; };

struct StaticOrder {
    int nM, nN, nwg, G, c;
    __host__ __device__ void init(int M, int N, int G_, int c_) { nM = M / BM; nN = N / BM; nwg = nM * nN; G = G_; c = c_; }
    __host__ __device__ bool next(int i, Unit& u) const {
        const long L = (long)i * G + c; if (L >= nwg) return false;
        int wgid = (int)L; { const int q = nwg / NXCD, r = nwg % NXCD, xcd = wgid % NXCD, off = wgid / NXCD; wgid = (xcd < r ? xcd * (q + 1) : r * (q + 1) + (xcd - r) * q) + off; }
        const int nig = WGM * nN, gid = wgid / nig, fm = gid * WGM, gsz = (nM - fm) < WGM ? (nM - fm) : WGM;
        u.pm = fm + ((wgid % nig) % gsz); u.pn = (wgid % nig) / gsz; return true;
    }
    __device__ __forceinline__ void a_ready(const Unit&) const {}
    __device__ __forceinline__ void done(const Unit&) const {}
};

typedef float f32x2 __attribute__((ext_vector_type(2)));
typedef __bf16 bf16x2_c __attribute__((ext_vector_type(2)));
__device__ __forceinline__ unsigned cvt_pk_bf16(float lo, float hi) { const f32x2 v = {lo, hi}; const bf16x2_c b = __builtin_convertvector(v, bf16x2_c); return __builtin_bit_cast(unsigned, b); }
__device__ __forceinline__ f32x2 gelu_pk(f32x2 v) {
    const f32x2 av = __builtin_elementwise_abs(v), d = av * 0.2316418882f + 1.0f;
    f32x2 t; t.x = __builtin_amdgcn_rcpf(d.x); t.y = __builtin_amdgcn_rcpf(d.y);
    f32x2 q = t * 0.5307027145f + (-0.7265760135f); q = q * t + 0.7107068705f; q = q * t + (-0.142248368f); q = q * t + 0.127414796f; q = q * t;
    const f32x2 s = (v * v) * (-0.72134752044f);
    f32x2 e; e.x = __builtin_amdgcn_exp2f(s.x); e.y = __builtin_amdgcn_exp2f(s.y);
    const f32x2 m = v * (q * e), r = v - m;
    f32x2 o; o.x = v.x < 0.f ? m.x : r.x; o.y = v.y < 0.f ? m.y : r.y; return o;
}
typedef unsigned u32x2 __attribute__((ext_vector_type(2)));
__device__ __forceinline__ float bf_lo(unsigned u) { return __uint_as_float(u << 16); }
__device__ __forceinline__ float bf_hi(unsigned u) { return __uint_as_float(u & 0xffff0000u); }
__device__ __forceinline__ float sigmoidf_(float v) { return __builtin_amdgcn_rcpf(1.0f + __expf(-v)); }
constexpr float RMS_EPS = 1e-6f;
__device__ __forceinline__ float rstd_of(const float* part, int r) {
    const f32x4* p = (const f32x4*)(part + (size_t)r * 16); const f32x4 a = p[0], b = p[1], c = p[2], d = p[3];
    const float s = ((a[0] + a[1]) + (a[2] + a[3])) + ((b[0] + b[1]) + (b[2] + b[3])) + (((c[0] + c[1]) + (c[2] + c[3])) + ((d[0] + d[1]) + (d[2] + d[3])));
    return rsqrtf(s * (1.0f / 1024.0f) + RMS_EPS);
}
enum { EM_SWIGLU = 0, EM_RESID = 1, EM_Z1 = 2, EM_GATE = 3, EM_PROJ0 = 4, EM_PROJ1 = 5, EM_DRY = 6 };
struct EpiMix {
    static constexpr bool PERM = true, AFTER_DRAIN = false;
    int mode;
    float* rs;
    const void* aux;
    bf16_t* ob; int ldo;
    __device__ __forceinline__ void operator()(const f32x4 (&acc)[2][2][4][2], const Unit& u, int wr, int wc, int fr, int fq) const {
        const int row0 = u.pm * BM + wr * 64 + fr;
        const int cw = wc * 32 + 8 * fq;
        if (mode == EM_SWIGLU || mode == EM_Z1 || mode == EM_GATE) {
            f32x4 pp[8]; float rs8[8];
            const float* rsb = rs + (size_t)row0 * 16 + 4 * fq;
#pragma unroll
            for (int i = 0; i < 8; ++i) pp[i] = *(const f32x4*)(rsb + ((i >> 2) * HALF + (i & 3) * 16) * 16);
            f32x4 bv[2][2];
            if (mode == EM_GATE) {
#pragma unroll
                for (int bj = 0; bj < 2; ++bj) { const float* bp = (const float*)aux + u.pn * BM + cw + bj * HALF; bv[bj][0] = *(const f32x4*)bp; bv[bj][1] = *(const f32x4*)(bp + 4); }
            }
#pragma unroll
            for (int i = 0; i < 8; ++i) { float t = (pp[i][0] + pp[i][1]) + (pp[i][2] + pp[i][3]); t += __shfl_xor(t, 16); t += __shfl_xor(t, 32); rs8[i] = rsqrtf(t * (1.0f / 1024.0f) + RMS_EPS); }
            if (mode == EM_SWIGLU) {
                bf16_t* obase = ob + (size_t)row0 * 2816 + u.pn * HALF + cw;
#pragma unroll
                for (int ai = 0; ai < 2; ++ai)
#pragma unroll
                    for (int m = 0; m < 4; ++m) {
                        const float rsv = rs8[ai * 4 + m];
                        float h[8];
#pragma unroll
                        for (int n = 0; n < 2; ++n)
#pragma unroll
                            for (int e = 0; e < 4; ++e) { const float g = acc[ai][0][m][n][e] * rsv, up = acc[ai][1][m][n][e] * rsv; h[n * 4 + e] = g * sigmoidf_(g) * up; }
                        u32x4 w; w.x = cvt_pk_bf16(h[0], h[1]); w.y = cvt_pk_bf16(h[2], h[3]); w.z = cvt_pk_bf16(h[4], h[5]); w.w = cvt_pk_bf16(h[6], h[7]);
                        *(u32x4*)(obase + (ai * HALF + m * 16) * 2816) = w;
                    }
            } else if (mode == EM_Z1) {
                const float sc = (u.pn < 3) ? 0.125f : 1.0f; const bool act = (u.pn >= 9 && u.pn <= 12);
                bf16_t* obase = ob + (size_t)row0 * 3840 + u.pn * BM + cw;
#pragma unroll
                for (int ai = 0; ai < 2; ++ai)
#pragma unroll
                    for (int m = 0; m < 4; ++m) {
                        const float rsv = rs8[ai * 4 + m] * sc;
#pragma unroll
                        for (int bj = 0; bj < 2; ++bj) {
                            f32x4 v0 = acc[ai][bj][m][0] * rsv, v1 = acc[ai][bj][m][1] * rsv;
                            if (act) { const f32x2 a = gelu_pk((f32x2){v0[0], v0[1]}), b = gelu_pk((f32x2){v0[2], v0[3]}), c = gelu_pk((f32x2){v1[0], v1[1]}), d = gelu_pk((f32x2){v1[2], v1[3]});
                                v0 = (f32x4){a.x, a.y, b.x, b.y}; v1 = (f32x4){c.x, c.y, d.x, d.y}; }
                            u32x4 w; w.x = cvt_pk_bf16(v0[0], v0[1]); w.y = cvt_pk_bf16(v0[2], v0[3]); w.z = cvt_pk_bf16(v1[0], v1[1]); w.w = cvt_pk_bf16(v1[2], v1[3]);
                            *(u32x4*)(obase + (ai * HALF + m * 16) * 3840 + bj * HALF) = w;
                        }
                    }
            } else {
                bf16_t* obase = ob + (size_t)row0 * 3072 + u.pn * BM + cw;
#pragma unroll
                for (int ai = 0; ai < 2; ++ai)
#pragma unroll
                    for (int m = 0; m < 4; ++m) {
                        const float rsv = rs8[ai * 4 + m];
#pragma unroll
                        for (int bj = 0; bj < 2; ++bj) {
                            const f32x4 v0 = acc[ai][bj][m][0] * rsv + bv[bj][0], v1 = acc[ai][bj][m][1] * rsv + bv[bj][1];
                            u32x4 w; w.x = cvt_pk_bf16(sigmoidf_(v0[0]), sigmoidf_(v0[1])); w.y = cvt_pk_bf16(sigmoidf_(v0[2]), sigmoidf_(v0[3]));
                            w.z = cvt_pk_bf16(sigmoidf_(v1[0]), sigmoidf_(v1[1])); w.w = cvt_pk_bf16(sigmoidf_(v1[2]), sigmoidf_(v1[3]));
                            *(u32x4*)(obase + (ai * HALF + m * 16) * 3072 + bj * HALF) = w;
                        }
                    }
            }
        } else if (mode == EM_RESID) {
            const float* xin = (const float*)aux; const size_t boff = (size_t)row0 * 1024 + u.pn * BM + cw; bf16_t* obase = ob + boff; const float* xbase = xin + boff; float* rsb = rs + (size_t)row0 * 16 + u.pn * 4 + wc;
#pragma unroll
            for (int ai = 0; ai < 2; ++ai) {
                u32x4 xo[4][2];
                if (!xin) {
#pragma unroll
                    for (int m = 0; m < 4; ++m)
#pragma unroll
                        for (int bj = 0; bj < 2; ++bj) xo[m][bj] = *(const u32x4*)(obase + (ai * HALF + m * 16) * 1024 + bj * HALF);
                }
#pragma unroll
                for (int m = 0; m < 4; ++m) {
                    float ss = 0.f;
#pragma unroll
                    for (int bj = 0; bj < 2; ++bj) {
                        const int off = (ai * HALF + m * 16) * 1024 + bj * HALF;
                        f32x4 x0, x1;
                        if (xin) { x0 = *(const f32x4*)(xbase + off); x1 = *(const f32x4*)(xbase + off + 4); }
                        else { const u32x4 q = xo[m][bj]; x0 = (f32x4){bf_lo(q.x), bf_hi(q.x), bf_lo(q.y), bf_hi(q.y)}; x1 = (f32x4){bf_lo(q.z), bf_hi(q.z), bf_lo(q.w), bf_hi(q.w)}; }
                        const f32x4 v0 = x0 + acc[ai][bj][m][0], v1 = x1 + acc[ai][bj][m][1];
                        u32x4 w; w.x = cvt_pk_bf16(v0[0], v0[1]); w.y = cvt_pk_bf16(v0[2], v0[3]); w.z = cvt_pk_bf16(v1[0], v1[1]); w.w = cvt_pk_bf16(v1[2], v1[3]);
                        *(u32x4*)(obase + off) = w;
                        ss += (v0[0] * v0[0] + v0[1] * v0[1]) + (v0[2] * v0[2] + v0[3] * v0[3]) + (v1[0] * v1[0] + v1[1] * v1[1]) + (v1[2] * v1[2] + v1[3] * v1[3]);
                    }
                    ss += __shfl_xor(ss, 16); ss += __shfl_xor(ss, 32);
                    if (fq == 0) rsb[(ai * HALF + m * 16) * 16] = ss;
                }
            }
        } else if (mode == EM_DRY) {
            if (acc[0][0][0][0][0] == 123.456f) ob[0] = 1;
        } else {
            const bool accum = (mode == EM_PROJ1); const bf16_t* gbase = (const bf16_t*)aux + (size_t)row0 * 3072 + u.pn * BM + cw; bf16_t* obase = ob + (size_t)row0 * 1024 + u.pn * BM + cw;
#pragma unroll
            for (int ai = 0; ai < 2; ++ai) {
                u32x4 gv[4][2], old[4][2];
#pragma unroll
                for (int m = 0; m < 4; ++m)
#pragma unroll
                    for (int bj = 0; bj < 2; ++bj) gv[m][bj] = *(const u32x4*)(gbase + (ai * HALF + m * 16) * 3072 + bj * HALF);
                if (accum) {
#pragma unroll
                    for (int m = 0; m < 4; ++m)
#pragma unroll
                        for (int bj = 0; bj < 2; ++bj) old[m][bj] = *(const u32x4*)(obase + (ai * HALF + m * 16) * 1024 + bj * HALF);
                } else {
#pragma unroll
                    for (int m = 0; m < 4; ++m)
#pragma unroll
                        for (int bj = 0; bj < 2; ++bj) old[m][bj] = (u32x4){0u, 0u, 0u, 0u};
                }
#pragma unroll
                for (int m = 0; m < 4; ++m)
#pragma unroll
                    for (int bj = 0; bj < 2; ++bj) {
                        const u32x4 g4 = gv[m][bj], o4 = old[m][bj]; const f32x4 a0 = acc[ai][bj][m][0], a1 = acc[ai][bj][m][1];
                        u32x4 w;
                        w.x = cvt_pk_bf16(bf_lo(o4.x) + bf_lo(g4.x) * a0[0], bf_hi(o4.x) + bf_hi(g4.x) * a0[1]);
                        w.y = cvt_pk_bf16(bf_lo(o4.y) + bf_lo(g4.y) * a0[2], bf_hi(o4.y) + bf_hi(g4.y) * a0[3]);
                        w.z = cvt_pk_bf16(bf_lo(o4.z) + bf_lo(g4.z) * a1[0], bf_hi(o4.z) + bf_hi(g4.z) * a1[1]);
                        w.w = cvt_pk_bf16(bf_lo(o4.w) + bf_lo(g4.w) * a1[2], bf_hi(o4.w) + bf_hi(g4.w) * a1[3]);
                        *(u32x4*)(obase + (ai * HALF + m * 16) * 1024 + bj * HALF) = w;
                    }
            }
        }
    }
};

template <class Epi, class Sched, bool ALIGN_EPI = false, bool SP2 = false>
__device__ __forceinline__ void gemm_phase(PG8_LAS unsigned char* lds, const Gemm g, const Sched& S, const Epi& E) {
    const int tid = threadIdx.x, wid = __builtin_amdgcn_readfirstlane(tid >> 6), lane = tid & 63, wr = wid >> 2, wc = wid & 3, fr = lane & 15, fq = lane >> 4;
    const int K = g.K, nt = K / BK;
    unsigned voffA[2], voffB[2];
#pragma unroll
    for (int i = 0; i < 2; ++i) { int R, C; stage_rc(tid * 16 + i * 8192, R, C); const int Rb = Epi::PERM ? ((R & ~31) + perm32(R & 31)) : R;
        voffA[i] = (unsigned)(R * K + C) * 2u; voffB[i] = (unsigned)(Rb * K + C) * 2u; }
    const size_t kstep = (size_t)(BK * 2);
    const size_t hstep = (size_t)HALF * K * 2;
    const size_t tstep = 2 * hstep;
    const unsigned ldsw = (unsigned)wid * 1024u;
    const int aoff = lds_byte(wr * 64 + fr, fq * 8), boff = lds_byte(wc * 32 + fr, fq * 8);
#define PG8_SA(b, h) (((b) * 2 + (h)) * HTB)
#define PG8_SB(b, h) ((4 + (b) * 2 + (h)) * HTB)
#define PG8_STAGE(bufoff, gbase, voff) do { _Pragma("unroll") for (int _i = 0; _i < 2; ++_i) \
        __builtin_amdgcn_global_load_lds((const unsigned*)((const char*)(gbase) + (voff)[_i]), (PG8_LAS unsigned*)(lds + (bufoff) + ldsw + _i * 8192), 16, 0, 0); } while (0)
#define PG8_LDA(dst, b, h) do { _Pragma("unroll") for (int m = 0; m < 4; ++m) _Pragma("unroll") for (int k = 0; k < 2; ++k) dst[m][k] = *(const PG8_LAS bf16x8*)(lds + PG8_SA(b, h) + aoff + m * 2048 + k * 1024); } while (0)
#define PG8_LDB(dst, b, h) do { _Pragma("unroll") for (int n = 0; n < 2; ++n) _Pragma("unroll") for (int k = 0; k < 2; ++k) dst[n][k] = *(const PG8_LAS bf16x8*)(lds + PG8_SB(b, h) + boff + n * 2048 + k * 1024); } while (0)
#define PG8_MMA(ai, bj, At, Bt) do { __builtin_amdgcn_s_setprio(1); _Pragma("unroll") for (int m = 0; m < 4; ++m) _Pragma("unroll") for (int n = 0; n < 2; ++n) _Pragma("unroll") for (int k = 0; k < 2; ++k) \
        acc[ai][bj][m][n] = __builtin_amdgcn_mfma_f32_16x16x32_bf16(Bt[n][k], At[m][k], acc[ai][bj][m][n], 0, 0, 0); __builtin_amdgcn_s_setprio(0); } while (0)
#define PG8_WAIT_V(n) asm volatile("s_waitcnt vmcnt(" #n ")" ::: "memory")
#define PG8_WAIT_L(n) asm volatile("s_waitcnt lgkmcnt(" #n ")" ::: "memory")
#define PG8_BAR __builtin_amdgcn_s_barrier()
#define PG8_SCHED __builtin_amdgcn_sched_barrier(0)
    Unit cur, nxt; int ui = 0;
    if (!S.next(0, cur)) return;
    f32x4 acc[2][2][4][2];
#pragma unroll
    for (int a = 0; a < 2; ++a)
#pragma unroll
        for (int b = 0; b < 2; ++b)
#pragma unroll
            for (int m = 0; m < 4; ++m)
#pragma unroll
                for (int n = 0; n < 2; ++n) acc[a][b][m][n] = (f32x4){0.f, 0.f, 0.f, 0.f};
    bf16x8 At[4][2], B0[2][2], B1[2][2];
    const char* cA = (const char*)g.A + (size_t)cur.pm * tstep; const char* cB = (const char*)g.Bt + (size_t)cur.pn * tstep;
    S.a_ready(cur);
    if constexpr (SP2) {
        PG8_STAGE(PG8_SB(0, 0), cB, voffB); PG8_STAGE(PG8_SB(0, 1), cB + hstep, voffB); PG8_STAGE(PG8_SA(0, 0), cA, voffA); PG8_STAGE(PG8_SA(0, 1), cA + hstep, voffA);
        if (wr == 1) PG8_BAR;
        PG8_WAIT_V(2); PG8_BAR;
        PG8_STAGE(PG8_SB(1, 0), cB + kstep, voffB); PG8_STAGE(PG8_SA(1, 0), cA + kstep, voffA); PG8_STAGE(PG8_SB(1, 1), cB + hstep + kstep, voffB);
        PG8_WAIT_V(6); PG8_BAR;
    } else {
        PG8_STAGE(PG8_SB(0, 0), cB, voffB); PG8_STAGE(PG8_SA(0, 0), cA, voffA); PG8_STAGE(PG8_SB(0, 1), cB + hstep, voffB); PG8_STAGE(PG8_SA(0, 1), cA + hstep, voffA);
        if (wr == 1) PG8_BAR;
        PG8_WAIT_V(4); PG8_BAR;
        PG8_STAGE(PG8_SB(1, 0), cB + kstep, voffB); PG8_STAGE(PG8_SA(1, 0), cA + kstep, voffA); PG8_STAGE(PG8_SB(1, 1), cB + hstep + kstep, voffB);
        PG8_WAIT_V(6); PG8_BAR;
    }
    for (;;) {
        const bool has_next = S.next(ui + 1, nxt);
        const char* nA = has_next ? (const char*)g.A + (size_t)nxt.pm * tstep : cA; const char* nB = has_next ? (const char*)g.Bt + (size_t)nxt.pn * tstep : cB;
        for (int t = 0; t < nt; t += 2) {
            const bool last = (t == nt - 2);
            const char* a1 = cA + (size_t)(t + 1) * kstep;
            const char* a2 = last ? nA : cA + (size_t)(t + 2) * kstep; const char* b2 = last ? nB : cB + (size_t)(t + 2) * kstep;
            const char* a3 = a2 + kstep; const char* b3 = b2 + kstep;
            if (last && has_next) S.a_ready(nxt);
            if constexpr (SP2) {
            PG8_LDB(B0, 0, 0); PG8_LDB(B1, 0, 1); PG8_SCHED; PG8_LDA(At, 0, 0); PG8_STAGE(PG8_SA(1, 1), a1 + hstep, voffA);
            PG8_WAIT_V(8); PG8_WAIT_L(0); PG8_BAR; PG8_MMA(0, 0, At, B0); PG8_MMA(0, 1, At, B1); PG8_BAR; PG8_SCHED;
            PG8_LDA(At, 0, 1); PG8_STAGE(PG8_SB(0, 0), b2, voffB); PG8_STAGE(PG8_SB(0, 1), b2 + hstep, voffB); PG8_STAGE(PG8_SA(0, 0), a2, voffA);
            PG8_WAIT_V(8); PG8_WAIT_L(0); PG8_BAR; PG8_MMA(1, 0, At, B0); PG8_MMA(1, 1, At, B1); PG8_BAR; PG8_SCHED;
            PG8_LDB(B0, 1, 0); PG8_LDB(B1, 1, 1); PG8_SCHED; PG8_LDA(At, 1, 0); PG8_STAGE(PG8_SA(0, 1), a2 + hstep, voffA);
            PG8_WAIT_V(8); PG8_WAIT_L(0); PG8_BAR; PG8_MMA(0, 0, At, B0); PG8_MMA(0, 1, At, B1); PG8_BAR; PG8_SCHED;
            PG8_LDA(At, 1, 1); PG8_STAGE(PG8_SB(1, 0), b3, voffB); PG8_STAGE(PG8_SB(1, 1), b3 + hstep, voffB); PG8_STAGE(PG8_SA(1, 0), a3, voffA);
            PG8_WAIT_V(8); PG8_WAIT_L(0); PG8_BAR; PG8_MMA(1, 0, At, B0); PG8_MMA(1, 1, At, B1); PG8_BAR; PG8_SCHED;
            } else {
            PG8_LDB(B0, 0, 0); PG8_SCHED; PG8_LDA(At, 0, 0); PG8_STAGE(PG8_SA(1, 1), a1 + hstep, voffA);
            PG8_WAIT_L(8); PG8_BAR; PG8_WAIT_L(0); PG8_MMA(0, 0, At, B0); PG8_BAR; PG8_SCHED;
            PG8_LDB(B1, 0, 1); PG8_STAGE(PG8_SB(0, 0), b2, voffB);
            PG8_BAR; PG8_WAIT_L(0); PG8_MMA(0, 1, At, B1); PG8_BAR;
            PG8_LDA(At, 0, 1); PG8_STAGE(PG8_SA(0, 0), a2, voffA);
            PG8_BAR; PG8_WAIT_L(0); PG8_MMA(1, 0, At, B0); PG8_BAR; PG8_SCHED;
            PG8_STAGE(PG8_SB(0, 1), b2 + hstep, voffB);
            PG8_WAIT_V(6); PG8_BAR; PG8_MMA(1, 1, At, B1); PG8_BAR;
            PG8_LDB(B0, 1, 0); PG8_SCHED; PG8_LDA(At, 1, 0); PG8_STAGE(PG8_SA(0, 1), a2 + hstep, voffA);
            PG8_WAIT_L(8); PG8_BAR; PG8_WAIT_L(0); PG8_MMA(0, 0, At, B0); PG8_BAR; PG8_SCHED;
            PG8_LDB(B1, 1, 1); PG8_STAGE(PG8_SB(1, 0), b3, voffB);
            PG8_BAR; PG8_WAIT_L(0); PG8_MMA(0, 1, At, B1); PG8_BAR;
            PG8_LDA(At, 1, 1); PG8_STAGE(PG8_SA(1, 0), a3, voffA);
            PG8_BAR; PG8_WAIT_L(0); PG8_MMA(1, 0, At, B0); PG8_BAR; PG8_SCHED;
            PG8_STAGE(PG8_SB(1, 1), b3 + hstep, voffB);
            PG8_WAIT_V(6); PG8_BAR; PG8_MMA(1, 1, At, B1); PG8_BAR;
            }
        }
        if constexpr (ALIGN_EPI) { if (wr == 0) PG8_BAR; }
        if constexpr (!Epi::AFTER_DRAIN) { E(acc, cur, wr, wc, fr, fq); S.done(cur); }
        if (!has_next) break;
#pragma unroll
        for (int a = 0; a < 2; ++a)
#pragma unroll
            for (int b = 0; b < 2; ++b)
#pragma unroll
                for (int m = 0; m < 4; ++m)
#pragma unroll
                    for (int n = 0; n < 2; ++n) acc[a][b][m][n] = (f32x4){0.f, 0.f, 0.f, 0.f};
        cur = nxt; cA = nA; cB = nB; ++ui;
        if constexpr (ALIGN_EPI) { if (wr == 1) PG8_BAR; }
    }
    PG8_WAIT_V(0);
    if constexpr (!ALIGN_EPI) { if (wr == 0) PG8_BAR; }
    PG8_BAR;
    if constexpr (Epi::AFTER_DRAIN) { E.fused(acc, cur, wr, wc, fr, fq, lds, wid, lane); S.done(cur); }
#undef PG8_SA
#undef PG8_SB
#undef PG8_STAGE
#undef PG8_LDA
#undef PG8_LDB
#undef PG8_MMA
#undef PG8_WAIT_V
#undef PG8_WAIT_L
#undef PG8_BAR
#undef PG8_SCHED
}
}
namespace cg = cooperative_groups;
#define LAS __attribute__((address_space(3)))
using pg8::bf16_t; using pg8::bf16x8; using pg8::f32x4; using pg8::u32x4; using pg8::u32x2; using pg8::f32x2;
using pg8::bf_lo; using pg8::bf_hi;
using pg8::cvt_pk_bf16;

constexpr int NT = 32768, DM = 1024, FF = 2816, SEQ = 4096;
constexpr int ZP = 3840;
constexpr int NTHREADS = 512, LDS_STAGE = 131072, LDS_BYTES = LDS_STAGE + 256;
constexpr size_t MiB = 1u << 20;
constexpr size_t WS_ROWSS = 0;
constexpr size_t WS_BAR = 960 * 1024;
constexpr size_t WS_LSE = 1 * MiB;
constexpr size_t WS_WST = 3 * MiB;
constexpr size_t WS_WCT = 3 * MiB + 256 * 1024;
constexpr size_t WS_W = 4 * MiB;
constexpr size_t W_LAYER = 26738688;
constexpr size_t WO_GU1 = 0, WO_D1 = 5767168, WO_IN = 8650752, WO_PA = 15728640, WO_PB = 15990784, WO_PC = 16515072, WO_OUT = 17039360, WO_GU2 = 18087936, WO_D2 = 23855104;
constexpr size_t WS_XB = 106 * MiB;
constexpr size_t WS_YA = 170 * MiB, WS_YB = 186 * MiB, WS_YC = 218 * MiB;
constexpr size_t WS_A = 250 * MiB;
constexpr size_t WS_MERGED = WS_A + 192 * MiB;
constexpr size_t WS_RS6 = 506 * MiB;
constexpr size_t WS_END = 508 * MiB;

__device__ __forceinline__ float wave_sum(float v) {
#pragma unroll
    for (int o = 1; o < 64; o <<= 1) v += __shfl_xor(v, o);
    return v;
}
__device__ __forceinline__ f32x4 mfma16(bf16x8 a, bf16x8 b, f32x4 c) { return __builtin_amdgcn_mfma_f32_16x16x32_bf16(a, b, c, 0, 0, 0); }

__device__ __forceinline__ void transpose_item(const float* W, int K, int N, bf16_t* WT, int n0, int drow0, int k0, const float* kscale, float cs, LAS float* scr, int lane) {
    const int kr = lane >> 3, n4 = (lane & 7) * 4;
    f32x4 v[8]; float sc[8];
#pragma unroll
    for (int i = 0; i < 8; ++i) { v[i] = *(const f32x4*)(W + (size_t)(k0 + 8 * i + kr) * N + n0 + n4); sc[i] = kscale ? kscale[k0 + 8 * i + kr] * cs : cs; }
#pragma unroll
    for (int i = 0; i < 8; ++i) { LAS float* d = scr + (8 * i + kr) * 33 + n4; d[0] = v[i][0] * sc[i]; d[1] = v[i][1] * sc[i]; d[2] = v[i][2] * sc[i]; d[3] = v[i][3] * sc[i]; }
    asm volatile("s_waitcnt lgkmcnt(0)" ::: "memory");
    const int c = lane & 7;
#pragma unroll
    for (int j = 0; j < 4; ++j) { const int n = (lane >> 3) + 8 * j; const LAS float* s = scr + (8 * c) * 33 + n;
        u32x4 o; o.x = cvt_pk_bf16(s[0 * 33], s[1 * 33]); o.y = cvt_pk_bf16(s[2 * 33], s[3 * 33]); o.z = cvt_pk_bf16(s[4 * 33], s[5 * 33]); o.w = cvt_pk_bf16(s[6 * 33], s[7 * 33]);
        *(u32x4*)(WT + (size_t)(drow0 + n) * K + k0 + 8 * c) = o; }
    asm volatile("s_waitcnt lgkmcnt(0)" ::: "memory");
}

__device__ __forceinline__ void mm128(const LAS unsigned char* A, const LAS unsigned char* B, int w, int fr, int fq, f32x4 (&acc)[8]) {
    bf16x8 bw[4];
#pragma unroll
    for (int ks = 0; ks < 4; ++ks) bw[ks] = *(const LAS bf16x8*)(B + (16 * w + fr) * 272 + ks * 64 + fq * 16);
#pragma unroll
    for (int ct = 0; ct < 8; ++ct) {
        f32x4 c = (f32x4){0.f, 0.f, 0.f, 0.f};
#pragma unroll
        for (int ks = 0; ks < 4; ++ks) { const bf16x8 a = *(const LAS bf16x8*)(A + (16 * ct + fr) * 272 + ks * 64 + fq * 16); c = mfma16(a, bw[ks], c); }
        acc[ct] = c;
    }
}

struct AttnRegs { u32x4 kv[4], vv[4]; bf16x8 q0, q1; };
__device__ __forceinline__ void attn_decode(int k, int xcd, int& g, int& j, int& sh, int& r, int& n) {
    g = k >> 7; j = (k >> 5) & 3; const int rn = k & 31; sh = 2 * g; r = rn >> (5 - sh); n = rn & ((32 >> sh) - 1); (void)xcd;
}
__device__ __forceinline__ void attn_load(AttnRegs& R, const bf16_t* Z1, int k, int xcd, int tid, int w, int fr, int fq) {
    int g, j, sh, r, n; attn_decode(k, xcd, g, j, sh, r, n);
    const int colq = g * 256 + j * 64; const size_t tok_b = (size_t)xcd * SEQ + r;
#pragma unroll
    for (int it = 0; it < 4; ++it) {
        const int c = tid + NTHREADS * it; const int key = c & 255, dc = c >> 8;
        const int p = (n - 1) * 128 + key; const int pc = p < 0 ? 0 : p;
        const bf16_t* src = Z1 + (tok_b + ((size_t)pc << sh)) * ZP + colq + dc * 8;
        R.kv[it] = *(const u32x4*)(src + 768); R.vv[it] = *(const u32x4*)(src + 1536);
    }
    const bf16_t* qp = Z1 + (tok_b + ((size_t)(n * 128 + 16 * w + fr) << sh)) * ZP + colq;
    R.q0 = *(const bf16x8*)(qp + fq * 8); R.q1 = *(const bf16x8*)(qp + 32 + fq * 8);
}
__device__ __forceinline__ void attn_stage(const AttnRegs& R, LAS unsigned char* lds, int k, int xcd, int tid) {
    int g, j, sh, r, n; attn_decode(k, xcd, g, j, sh, r, n);
#pragma unroll
    for (int it = 0; it < 4; ++it) {
        const int c = tid + NTHREADS * it; const int key = c & 255, dc = c >> 8;
        const bool ok = ((n - 1) * 128 + key) >= 0; const u32x4 z = (u32x4){0u, 0u, 0u, 0u};
        const u32x4 kv = ok ? R.kv[it] : z, vv = ok ? R.vv[it] : z;
        *(LAS u32x4*)(lds + key * 144 + dc * 16) = kv;
        const int k32 = key & 31; const int pos = (key & ~31) + 8 * ((k32 & 15) >> 2) + 4 * (k32 >> 4) + (k32 & 3);
        LAS bf16_t* vt = (LAS bf16_t*)(lds + 36864) + (dc * 8) * 264 + pos;
        vt[0 * 264] = (bf16_t)(vv.x & 0xffffu); vt[1 * 264] = (bf16_t)(vv.x >> 16); vt[2 * 264] = (bf16_t)(vv.y & 0xffffu); vt[3 * 264] = (bf16_t)(vv.y >> 16);
        vt[4 * 264] = (bf16_t)(vv.z & 0xffffu); vt[5 * 264] = (bf16_t)(vv.z >> 16); vt[6 * 264] = (bf16_t)(vv.w & 0xffffu); vt[7 * 264] = (bf16_t)(vv.w >> 16);
    }
}
__device__ __forceinline__ void attn_compute(LAS unsigned char* lds, bf16_t* Z1, float* lse, int k, int xcd, bf16x8 q0, bf16x8 q1, int w, int fr, int fq, bool dostore = true) {
    int g, j, sh, r, n; attn_decode(k, xcd, g, j, sh, r, n);
    const int colq = g * 256 + j * 64; const size_t tok_b = (size_t)xcd * SEQ + r; const int qi = 16 * w + fr;
    bf16_t* qp = Z1 + (tok_b + ((size_t)(n * 128 + qi) << sh)) * ZP + colq;
    const int kt0 = (w < 6 ? w : 6) & ~1;
    f32x4 s[10];
#pragma unroll
    for (int t = 0; t < 10; ++t) {
        const LAS unsigned char* kp = lds + (16 * (kt0 + t) + fr) * 144 + fq * 16;
        const bf16x8 a0 = *(const LAS bf16x8*)kp, a1 = *(const LAS bf16x8*)(kp + 64);
        s[t] = mfma16(a0, q0, (f32x4){0.f, 0.f, 0.f, 0.f}); s[t] = mfma16(a1, q1, s[t]);
    }
    constexpr float L2E = 1.4426950408889634f;
    float mx = -1e30f;
#pragma unroll
    for (int t = 0; t < 10; ++t)
#pragma unroll
        for (int i = 0; i < 4; ++i) {
            const int kj = 16 * (kt0 + t) + 4 * fq + i; const int dist = qi + 128 - kj;
            const bool valid = (dist >= 0) && (dist <= 128) && !(n == 0 && kj < 128);
            const float v = valid ? s[t][i] * L2E : -1e30f; s[t][i] = v; mx = fmaxf(mx, v);
        }
    mx = fmaxf(mx, __shfl_xor(mx, 16)); mx = fmaxf(mx, __shfl_xor(mx, 32));
    float l = 0.f;
#pragma unroll
    for (int t = 0; t < 10; ++t)
#pragma unroll
        for (int i = 0; i < 4; ++i) { const float p = __builtin_amdgcn_exp2f(s[t][i] - mx); s[t][i] = p; l += p; }
    l += __shfl_xor(l, 16); l += __shfl_xor(l, 32);
    f32x4 o[4];
#pragma unroll
    for (int dt = 0; dt < 4; ++dt) o[dt] = (f32x4){0.f, 0.f, 0.f, 0.f};
#pragma unroll
    for (int G = 0; G < 5; ++G) {
        u32x4 pw; pw.x = cvt_pk_bf16(s[2 * G][0], s[2 * G][1]); pw.y = cvt_pk_bf16(s[2 * G][2], s[2 * G][3]); pw.z = cvt_pk_bf16(s[2 * G + 1][0], s[2 * G + 1][1]); pw.w = cvt_pk_bf16(s[2 * G + 1][2], s[2 * G + 1][3]);
        const bf16x8 pb = __builtin_bit_cast(bf16x8, pw);
#pragma unroll
        for (int dt = 0; dt < 4; ++dt) {
            const bf16x8 va = *(const LAS bf16x8*)(lds + 36864 + (16 * dt + fr) * 528 + (32 * (kt0 / 2 + G) + 8 * fq) * 2);
            o[dt] = mfma16(va, pb, o[dt]);
        }
    }
    const float rl = 1.0f / l;
    if (!dostore) { if (rl == 123.456f) lse[0] = o[0][0] + o[1][1] + o[2][2] + o[3][3]; return; }
#pragma unroll
    for (int dt = 0; dt < 4; ++dt) { u32x2 wv; wv.x = cvt_pk_bf16(o[dt][0] * rl, o[dt][1] * rl); wv.y = cvt_pk_bf16(o[dt][2] * rl, o[dt][3] * rl); *(u32x2*)(qp + 16 * dt + 4 * fq) = wv; }
    if (fq == 0) lse[(size_t)((g * 4 + j) * 8 + xcd) * SEQ + r * (SEQ >> sh) + n * 128 + qi] = (mx + __log2f(l)) * 0.6931471805599453f;
}
__device__ __forceinline__ void attn_phase(LAS unsigned char* lds, bf16_t* Z1, float* lse, int xcd, int slot, int nslot, int tid, bool dostore = true) {
    asm volatile("" : "+v"(tid));
    const int lane = tid & 63, w = __builtin_amdgcn_readfirstlane(tid >> 6), fr = lane & 15, fq = lane >> 4;
    int k = slot; if (k >= 384) return;
    AttnRegs R0, R1; attn_load(R0, Z1, k, xcd, tid, w, fr, fq);
    for (;;) {
        const int k1 = k + nslot;
        if (k1 < 384) attn_load(R1, Z1, k1, xcd, tid, w, fr, fq);
        attn_stage(R0, lds, k, xcd, tid);
        __syncthreads();
        attn_compute(lds, Z1, lse, k, xcd, R0.q0, R0.q1, w, fr, fq, dostore);
        __syncthreads();
        if (k1 >= 384) break;
        const int k2 = k1 + nslot;
        if (k2 < 384) attn_load(R0, Z1, k2, xcd, tid, w, fr, fq);
        attn_stage(R1, lds, k1, xcd, tid);
        __syncthreads();
        attn_compute(lds, Z1, lse, k1, xcd, R1.q0, R1.q1, w, fr, fq, dostore);
        __syncthreads();
        if (k2 >= 384) break;
        k = k2;
    }
}

__device__ __forceinline__ void gate_unit(LAS unsigned char* lds, const bf16_t* Z1, bf16_t* yb, const bf16_t* wsT, const float* lng, const float* lnb, const float* bbs, int ch, int tid) {
    asm volatile("" : "+v"(tid));
    const int lane = tid & 63, w = __builtin_amdgcn_readfirstlane(tid >> 6), fr = lane & 15, fq = lane >> 4;
    const size_t t0 = (size_t)ch * 128;
    LAS float* st = (LAS float*)lds;
    {
        u32x4 raw[16]; float sm[16], mean[16], q[16];
        const bf16_t* vp = Z1 + (t0 + 16 * w) * ZP + 2816 + lane * 8;
#pragma unroll
        for (int i = 0; i < 16; ++i) raw[i] = *(const u32x4*)(vp + (size_t)i * ZP);
#pragma unroll
        for (int i = 0; i < 16; ++i) sm[i] = ((bf_lo(raw[i].x) + bf_hi(raw[i].x)) + (bf_lo(raw[i].y) + bf_hi(raw[i].y))) + ((bf_lo(raw[i].z) + bf_hi(raw[i].z)) + (bf_lo(raw[i].w) + bf_hi(raw[i].w)));
#pragma unroll
        for (int o = 1; o < 64; o <<= 1)
#pragma unroll
            for (int i = 0; i < 16; ++i) sm[i] += __shfl_xor(sm[i], o);
#pragma unroll
        for (int i = 0; i < 16; ++i) { mean[i] = sm[i] * (1.0f / 512.0f); const float m_ = mean[i];
            const float d0 = bf_lo(raw[i].x) - m_, d1 = bf_hi(raw[i].x) - m_, d2 = bf_lo(raw[i].y) - m_, d3 = bf_hi(raw[i].y) - m_, d4 = bf_lo(raw[i].z) - m_, d5 = bf_hi(raw[i].z) - m_, d6 = bf_lo(raw[i].w) - m_, d7 = bf_hi(raw[i].w) - m_;
            q[i] = ((d0 * d0 + d1 * d1) + (d2 * d2 + d3 * d3)) + ((d4 * d4 + d5 * d5) + (d6 * d6 + d7 * d7)); }
#pragma unroll
        for (int o = 1; o < 64; o <<= 1)
#pragma unroll
            for (int i = 0; i < 16; ++i) q[i] += __shfl_xor(q[i], o);
        if (lane < 16) {
            float mm = mean[0], qq = q[0];
#pragma unroll
            for (int i = 1; i < 16; ++i) { mm = (lane == i) ? mean[i] : mm; qq = (lane == i) ? q[i] : qq; }
            st[2 * (16 * w + lane)] = mm; st[2 * (16 * w + lane) + 1] = rsqrtf(qq * (1.0f / 512.0f) + 1e-6f);
        }
    }
    __syncthreads();
    const int t = 16 * w + fr;
    for (int g = 0; g < 4; ++g) {
        u32x4 wv[4], vv[4]; u32x2 uu[8]; f32x4 lg[4][2], lb[4][2];
#pragma unroll
        for (int it = 0; it < 4; ++it) {
            const int c = tid + NTHREADS * it;
            wv[it] = *(const u32x4*)(wsT + (size_t)(g * 128 + (c >> 4)) * 128 + (c & 15) * 8);
            const int sidx = c & 127, c8 = c >> 7; const int chn = g * 128 + c8 * 8;
            vv[it] = *(const u32x4*)(Z1 + (t0 + sidx) * ZP + 2816 + chn);
            lg[it][0] = *(const f32x4*)(lng + chn); lg[it][1] = *(const f32x4*)(lng + chn + 4); lb[it][0] = *(const f32x4*)(lnb + chn); lb[it][1] = *(const f32x4*)(lnb + chn + 4);
        }
#pragma unroll
        for (int ct = 0; ct < 8; ++ct) uu[ct] = *(const u32x2*)(Z1 + (t0 + t) * ZP + 2304 + g * 128 + 16 * ct + 4 * fq);
        const float bias = bbs[g * 128 + t];
#pragma unroll
        for (int it = 0; it < 4; ++it) {
            const int c = tid + NTHREADS * it;
            *(LAS u32x4*)(lds + 1024 + (c >> 4) * 272 + (c & 15) * 16) = wv[it];
            const int sidx = c & 127, c8 = c >> 7; const u32x4 raw = vv[it];
            const float mean = st[2 * sidx], rstd = st[2 * sidx + 1];
            const float x[8] = {bf_lo(raw.x), bf_hi(raw.x), bf_lo(raw.y), bf_hi(raw.y), bf_lo(raw.z), bf_hi(raw.z), bf_lo(raw.w), bf_hi(raw.w)};
            const float gg[8] = {lg[it][0][0], lg[it][0][1], lg[it][0][2], lg[it][0][3], lg[it][1][0], lg[it][1][1], lg[it][1][2], lg[it][1][3]};
            const float bb[8] = {lb[it][0][0], lb[it][0][1], lb[it][0][2], lb[it][0][3], lb[it][1][0], lb[it][1][1], lb[it][1][2], lb[it][1][3]};
            LAS bf16_t* vt = (LAS bf16_t*)(lds + 35840) + (c8 * 8) * 136 + sidx;
#pragma unroll
            for (int e = 0; e < 8; e += 2) { const unsigned pk = cvt_pk_bf16((x[e] - mean) * rstd * gg[e] + bb[e], (x[e + 1] - mean) * rstd * gg[e + 1] + bb[e + 1]); vt[e * 136] = (bf16_t)(pk & 0xffffu); vt[(e + 1) * 136] = (bf16_t)(pk >> 16); }
        }
        __syncthreads();
        f32x4 acc[8];
        mm128(lds + 35840, lds + 1024, w, fr, fq, acc);
#pragma unroll
        for (int ct = 0; ct < 8; ++ct) {
            const int chn = g * 128 + 16 * ct + 4 * fq; const u32x2 u2 = uu[ct];
            u32x2 o; o.x = cvt_pk_bf16(bf_lo(u2.x) * (acc[ct][0] + bias), bf_hi(u2.x) * (acc[ct][1] + bias)); o.y = cvt_pk_bf16(bf_lo(u2.y) * (acc[ct][2] + bias), bf_hi(u2.y) * (acc[ct][3] + bias));
            *(u32x2*)(yb + (t0 + t) * 512 + chn) = o;
        }
        __syncthreads();
    }
}

struct PoolRegs { u32x4 xr[5], wr4[4]; };
__device__ __forceinline__ void pool_load(PoolRegs& R, const bf16_t* Z1, const bf16_t* wcT, int unit, int tid) {
    const int tile = unit >> 2, gi = unit & 3; const size_t t0 = (size_t)tile * 128; const int tpos0 = (int)(t0 & (SEQ - 1));
#pragma unroll
    for (int it = 0; it < 5; ++it) {
        const int c = tid + NTHREADS * it; const int row = c >> 4, c8 = c & 15; const int tt = row - 15;
        const bool ok = (c < 143 * 16) && (tpos0 + tt >= 0);
        const long trow = ok ? ((long)t0 + tt) : (long)t0;
        R.xr[it] = *(const u32x4*)(Z1 + (size_t)trow * ZP + 3328 + gi * 128 + c8 * 8);
    }
#pragma unroll
    for (int it = 0; it < 4; ++it) { const int c = tid + NTHREADS * it; R.wr4[it] = *(const u32x4*)(wcT + (size_t)(gi * 128 + (c >> 4)) * 128 + (c & 15) * 8); }
}
__device__ __forceinline__ void pool_stage(const PoolRegs& R, LAS unsigned char* lds, int unit, int tid) {
    const int tile = unit >> 2; const size_t t0 = (size_t)tile * 128; const int tpos0 = (int)(t0 & (SEQ - 1));
#pragma unroll
    for (int it = 0; it < 5; ++it) { const int c = tid + NTHREADS * it; const int tt = (c >> 4) - 15; const bool ok = (tpos0 + tt >= 0);
        if (c < 143 * 16) *(LAS u32x4*)(lds + (c >> 4) * 272 + (c & 15) * 16) = ok ? R.xr[it] : (u32x4){0u, 0u, 0u, 0u}; }
#pragma unroll
    for (int it = 0; it < 4; ++it) { const int c = tid + NTHREADS * it; *(LAS u32x4*)(lds + 73728 + (c >> 4) * 272 + (c & 15) * 16) = R.wr4[it]; }
}
__device__ __forceinline__ void pool_compute(LAS unsigned char* lds, bf16_t* yc, const float* cscale, int unit, int tid, int w, int fr, int fq) {
    const int tile = unit >> 2, gi = unit & 3; const size_t t0 = (size_t)tile * 128; const int tpos0 = (int)(t0 & (SEQ - 1)); const int win = 2 << gi;
#pragma unroll
    for (int it = 0; it < 4; ++it) {
        const int c = tid + NTHREADS * it; const int t = c >> 4, c8 = c & 15;
        const int cnt = (tpos0 + t + 1 < win) ? (tpos0 + t + 1) : win;
        float sm[8] = {0.f, 0.f, 0.f, 0.f, 0.f, 0.f, 0.f, 0.f};
        for (int i = 0; i < cnt; ++i) { const u32x4 raw = *(const LAS u32x4*)(lds + (t + 15 - i) * 272 + c8 * 16);
            sm[0] += bf_lo(raw.x); sm[1] += bf_hi(raw.x); sm[2] += bf_lo(raw.y); sm[3] += bf_hi(raw.y); sm[4] += bf_lo(raw.z); sm[5] += bf_hi(raw.z); sm[6] += bf_lo(raw.w); sm[7] += bf_hi(raw.w); }
        const u32x4 xt = *(const LAS u32x4*)(lds + (t + 15) * 272 + c8 * 16); const float ic = 1.0f / (float)cnt;
        u32x4 o; o.x = cvt_pk_bf16(sm[0] * ic - bf_lo(xt.x), sm[1] * ic - bf_hi(xt.x)); o.y = cvt_pk_bf16(sm[2] * ic - bf_lo(xt.y), sm[3] * ic - bf_hi(xt.y));
        o.z = cvt_pk_bf16(sm[4] * ic - bf_lo(xt.z), sm[5] * ic - bf_hi(xt.z)); o.w = cvt_pk_bf16(sm[6] * ic - bf_lo(xt.w), sm[7] * ic - bf_hi(xt.w));
        *(LAS u32x4*)(lds + 38912 + t * 272 + c8 * 16) = o;
    }
    __syncthreads();
    f32x4 acc[8];
    mm128(lds + 73728, lds + 38912, w, fr, fq, acc);
    const int t = 16 * w + fr;
#pragma unroll
    for (int dt = 0; dt < 8; ++dt) {
        const int d = gi * 128 + 16 * dt + 4 * fq; const f32x4 sc = *(const f32x4*)(cscale + d);
        u32x2 o; o.x = cvt_pk_bf16(acc[dt][0] * sc[0], acc[dt][1] * sc[1]); o.y = cvt_pk_bf16(acc[dt][2] * sc[2], acc[dt][3] * sc[3]);
        *(u32x2*)(yc + (t0 + t) * 512 + d) = o;
    }
}
__device__ __forceinline__ void pool_phase(LAS unsigned char* lds, const bf16_t* Z1, bf16_t* yc, const bf16_t* wcT, const float* cscale, int xcd, int slot, int nslot, int tid) {
    asm volatile("" : "+v"(tid));
    const int lane = tid & 63, w = __builtin_amdgcn_readfirstlane(tid >> 6), fr = lane & 15, fq = lane >> 4;
    int k = slot; if (k >= 128) return;
    PoolRegs R; pool_load(R, Z1, wcT, xcd * 128 + k, tid);
    for (;;) {
        pool_stage(R, lds, xcd * 128 + k, tid);
        __syncthreads();
        const int kn = k + nslot;
        if (kn < 128) pool_load(R, Z1, wcT, xcd * 128 + kn, tid);
        pool_compute(lds, yc, cscale, xcd * 128 + k, tid, w, fr, fq);
        __syncthreads();
        if (kn >= 128) break;
        k = kn;
    }
}

typedef unsigned v4u __attribute__((ext_vector_type(4)));
#define XB_TMO      128
#define XB_XCNT(j)  (256  + 64 * (j))
#define XB_XSUB(j)  (1280 + 64 * (j))
#define XB_XGEN(j)  (2304 + 64 * (j))
#define XB_TOP      3328
#define XB_TOPGEN   3392
#define XCD_BAR_WORDS 3456
#define XB_SPIN_CAP (1u << 18)

__device__ __forceinline__ unsigned xb_ld(unsigned* p)              { return __hip_atomic_load(p, __ATOMIC_RELAXED, __HIP_MEMORY_SCOPE_AGENT); }
__device__ __forceinline__ unsigned xb_add(unsigned* p, unsigned v) { return __hip_atomic_fetch_add(p, v, __ATOMIC_RELAXED, __HIP_MEMORY_SCOPE_AGENT); }
__device__ __forceinline__ unsigned xb_xcc_id() { return (unsigned)__builtin_amdgcn_s_getreg((3 << 11) | 20) & 0xFu; }
#define XB_SPIN(cond, bar) do { unsigned _sp = 0; while (cond) { __builtin_amdgcn_s_sleep(1); \
    if ((++_sp & 255u) == 0u) { if (xb_ld(&(bar)[XB_TMO])) break; if (_sp > XB_SPIN_CAP) { atomicAdd(&(bar)[XB_TMO], 1u); break; } } } } while (0)

struct XcdBarrier {
    unsigned* bar; unsigned x;
    volatile LAS unsigned* st;
};

__device__ __forceinline__ XcdBarrier xcd_barrier_post(unsigned* bar, volatile LAS unsigned* st) {
    XcdBarrier b; b.bar = bar; b.x = xb_xcc_id(); b.st = st;
    if (threadIdx.x == 0) (void)xb_add(&bar[XB_XCNT(b.x)], 1u);
    return b;
}
__device__ __forceinline__ void xcd_barrier_complete(unsigned* bar, unsigned x, unsigned& nloc, unsigned& nx) {
    const unsigned G = gridDim.x * gridDim.y * gridDim.z;
    unsigned sum, cnt, mine, sp = 0u;
    for (;;) {
        sum = 0u; cnt = 0u; mine = 0u;
#pragma unroll
        for (unsigned j = 0; j < 16; ++j) { const unsigned c = xb_ld(&bar[XB_XCNT(j)]); sum += c; cnt += (c > 0u) ? 1u : 0u; mine = (j == x) ? c : mine; }
        if (sum == G) break;
        __builtin_amdgcn_s_sleep(1);
        if ((++sp & 255u) == 0u) { if (xb_ld(&bar[XB_TMO])) break; if (sp > XB_SPIN_CAP) { atomicAdd(&bar[XB_TMO], 1u); break; } }
    }
    nloc = mine > 0u ? mine : 1u; nx = cnt > 0u ? cnt : 1u;
}

__device__ __forceinline__ void xcd_barrier(const XcdBarrier& b) {
    asm volatile("s_waitcnt vmcnt(0)" ::: "memory");
    __syncthreads();
    if (threadIdx.x == 0) {
        unsigned* bar = b.bar;
        __builtin_amdgcn_s_waitcnt(0);
        unsigned nloc = b.st[0], nx = b.st[1];
        if (nloc == 0u) { xcd_barrier_complete(bar, b.x, nloc, nx); b.st[0] = nloc; b.st[1] = nx; }
        const unsigned old = xb_add(&bar[XB_XSUB(b.x)], 1u);
        const unsigned gen = old / nloc;
        if (old + 1u == (gen + 1u) * nloc) {
            __builtin_amdgcn_fence(__ATOMIC_RELEASE, "agent");
            asm volatile("s_waitcnt vmcnt(0)" ::: "memory");
            const unsigned og = xb_add(&bar[XB_TOP], 1u);
            const unsigned tg = og / nx;
            if (og + 1u == (tg + 1u) * nx) xb_add(&bar[XB_TOPGEN], 1u);
            else XB_SPIN(xb_ld(&bar[XB_TOPGEN]) == tg, bar);
            __builtin_amdgcn_fence(__ATOMIC_ACQUIRE, "agent");
            xb_add(&bar[XB_XGEN(b.x)], 1u);
            asm volatile("s_waitcnt vmcnt(0)" ::: "memory");
        } else {
            XB_SPIN(xb_ld(&bar[XB_XGEN(b.x)]) == gen, bar);
            __builtin_amdgcn_fence(__ATOMIC_ACQUIRE, "agent");
            asm volatile("s_waitcnt vmcnt(0)" ::: "memory");
        }
    }
    __syncthreads();
}


__device__ __forceinline__ void grid_seam(unsigned* bar, unsigned target) {
    asm volatile("s_waitcnt vmcnt(0) lgkmcnt(0)" ::: "memory");
    __syncthreads();
    if (threadIdx.x == 0) {
        __builtin_amdgcn_fence(__ATOMIC_RELEASE, "agent"); asm volatile("s_waitcnt vmcnt(0)" ::: "memory");
        __hip_atomic_fetch_add(bar, 1u, __ATOMIC_RELAXED, __HIP_MEMORY_SCOPE_AGENT);
        unsigned spins = 0;
        while (__hip_atomic_load(bar, __ATOMIC_RELAXED, __HIP_MEMORY_SCOPE_AGENT) < target) { __builtin_amdgcn_s_sleep(2); if (++spins > (1u << 24)) break; }
        __builtin_amdgcn_fence(__ATOMIC_ACQUIRE, "agent"); asm volatile("s_waitcnt vmcnt(0)" ::: "memory");
    }
    __syncthreads();
}

__device__ __forceinline__ float* rowss_arr(float* dout, unsigned char* ws, int k) { return k < 6 ? dout + (size_t)k * NT * 16 : (float*)(ws + WS_RS6); }
#ifndef MK_WITH_MEMSET
#define MK_NO_MEMSET 1
#endif
#ifndef MK_ALIGN
#define MK_ALIGN true
#endif
#ifndef MK_SP2
#define MK_SP2 true
#endif
#ifndef MK_LOCAL_SEAMS
#define SEAM_LOCAL() SEAM()
#else
#define SEAM_LOCAL() grid_seam((unsigned*)(a.ws + WS_BAR) + 4096 + 64 * (bid & 7), nseam_local_ += (unsigned)(G >> 3))
#endif
#ifdef MK_FLAT_BAR
#define SEAM() grid_seam((unsigned*)(a.ws + WS_BAR) + 4096, nseam * (unsigned)G)
#else
#define SEAM() xcd_barrier(xbar)
#endif
struct Args { const float* in[23]; float* out; unsigned char* ws; int ph_lo, ph_hi; };

__global__ void __launch_bounds__(NTHREADS, 2) mega_fwd(Args a) {
    extern __shared__ __attribute__((aligned(16))) unsigned char lds_raw[];
    cg::grid_group grid = cg::this_grid();
    LAS unsigned char* lds = (LAS unsigned char*)lds_raw;
    const int G = gridDim.x, bid = blockIdx.x;
    const int ph_lo = a.ph_lo, ph_hi = a.ph_hi;
    volatile LAS unsigned* bst = (volatile LAS unsigned*)(lds + LDS_STAGE);
    if (threadIdx.x < 2) bst[threadIdx.x] = 0u;
#ifdef MK_NO_MEMSET
    if (ph_hi - ph_lo == 26) {
        if (blockIdx.x == 0) { for (int i = threadIdx.x; i < 8192; i += NTHREADS) __hip_atomic_store((unsigned*)(a.ws + WS_BAR) + i, 0u, __ATOMIC_RELAXED, __HIP_MEMORY_SCOPE_AGENT); asm volatile("s_waitcnt vmcnt(0)" ::: "memory"); }
        __syncthreads();
        grid.sync();
    }
#endif
    __syncthreads();
    const XcdBarrier xbar = xcd_barrier_post((unsigned*)(a.ws + WS_BAR), bst);
#ifndef MK_NO_MEMSET
    if (ph_hi - ph_lo == 26) grid.sync();
#endif

    if (ph_lo <= 0) {
        int tid = threadIdx.x; asm volatile("" : "+v"(tid));
        const int lane = tid & 63, wave = __builtin_amdgcn_readfirstlane(tid >> 6);
        unsigned char* ws = a.ws;
        bf16_t* Wb = (bf16_t*)(ws + WS_W); bf16_t* wcT = (bf16_t*)(ws + WS_WCT); bf16_t* wsT = (bf16_t*)(ws + WS_WST); bf16_t* xb = (bf16_t*)(ws + WS_XB); float* rowss = rowss_arr(a.out, ws, 0);
        const int gw = bid * 8 + wave, NGW = G * 8;
        LAS float* scr = (LAS float*)(lds + wave * 16384);
        for (int it0 = gw; it0 < 2 * 13056 + 64; it0 += NGW) {
            const float* src; bf16_t* dst; const float* ksc = nullptr; float cs = 1.f; int K, N, map = 0, it;
            if (it0 < 2 * 13056) {
                const int l = it0 >= 13056 ? 1 : 0; const int r = it0 - l * 13056; bf16_t* Wl = Wb + (size_t)l * W_LAYER;
                if (r < 1408)       { it = r;         src = a.in[2] + (size_t)l * DM * FF; K = DM; N = FF; dst = Wl + WO_GU1; ksc = a.in[1] + l * DM; map = 1; }
                else if (r < 2816)  { it = r - 1408;  src = a.in[3] + (size_t)l * DM * FF; K = DM; N = FF; dst = Wl + WO_GU1; ksc = a.in[1] + l * DM; map = 2; }
                else if (r < 4224)  { it = r - 2816;  src = a.in[4] + (size_t)l * DM * FF; K = FF; N = DM; dst = Wl + WO_D1; cs = 0.5f; }
                else if (r < 7680)  { it = r - 4224;  src = a.in[6] + (size_t)l * DM * 6912; K = DM; N = 6912; dst = Wl + WO_IN; ksc = a.in[5] + l * DM; }
                else if (r < 7808)  { it = r - 7680;  src = a.in[14] + (size_t)l * 256 * DM; K = 256; N = DM; dst = Wl + WO_PA; }
                else if (r < 8064)  { it = r - 7808;  src = a.in[15] + (size_t)l * 512 * DM; K = 512; N = DM; dst = Wl + WO_PB; }
                else if (r < 8320)  { it = r - 8064;  src = a.in[16] + (size_t)l * 512 * DM; K = 512; N = DM; dst = Wl + WO_PC; }
                else if (r < 8832)  { it = r - 8320;  src = a.in[17] + (size_t)l * DM * DM; K = DM; N = DM; dst = Wl + WO_OUT; }
                else if (r < 10240) { it = r - 8832;  src = a.in[19] + (size_t)l * DM * FF; K = DM; N = FF; dst = Wl + WO_GU2; ksc = a.in[18] + l * DM; map = 1; }
                else if (r < 11648) { it = r - 10240; src = a.in[20] + (size_t)l * DM * FF; K = DM; N = FF; dst = Wl + WO_GU2; ksc = a.in[18] + l * DM; map = 2; }
                else                { it = r - 11648; src = a.in[21] + (size_t)l * DM * FF; K = FF; N = DM; dst = Wl + WO_D2; cs = 0.5f; }
            } else { const int q = (it0 - 2 * 13056) >> 3; it = (it0 - 2 * 13056) & 7; src = a.in[12] + (size_t)q * 16384; K = 128; N = 128; dst = wcT + (size_t)q * 16384; }
            const int nblk = N / 32;
            const int kb = it / nblk, nb = it % nblk, n0 = 32 * nb;
            const int drow0 = (map == 0) ? n0 : ((n0 >> 7) * 256 + (n0 & 127) + (map == 2 ? 128 : 0));
            transpose_item(src, K, N, dst, n0, drow0, 64 * kb, ksc, cs, scr, lane);
        }
        const int xcd = bid & 7, slot = bid >> 3, nslot = G >> 3;
        for (int i = bid * NTHREADS + tid; i < 2 * 4 * 128 * 128; i += G * NTHREADS) {
            const int t = (i >> 7) & 127, s = i & 127; const float v = (s <= t) ? a.in[10][i] : 0.f;
            wsT[i] = (bf16_t)(cvt_pk_bf16(v, 0.f) & 0xffffu);
        }
        const float* x = a.in[0];
        for (int m = xcd * SEQ + slot * 8 + wave; m < (xcd + 1) * SEQ; m += nslot * 8) {
            const f32x4* xr = (const f32x4*)(x + (size_t)m * DM) + lane; u32x2* o8 = (u32x2*)(xb + (size_t)m * DM) + lane; float ss = 0.f;
#pragma unroll
            for (int jj = 0; jj < 4; ++jj) { const f32x4 v = xr[64 * jj]; ss += (v[0] * v[0] + v[1] * v[1]) + (v[2] * v[2] + v[3] * v[3]); u32x2 o; o.x = cvt_pk_bf16(v[0], v[1]); o.y = cvt_pk_bf16(v[2], v[3]); o8[64 * jj] = o; }
            ss = wave_sum(ss); if (lane < 4) ((f32x4*)(rowss + (size_t)m * 16))[lane] = (f32x4){lane == 0 ? ss : 0.f, 0.f, 0.f, 0.f};
        }
    }
    unsigned nseam = 0, nseam_local_ = 0;
    if (ph_lo <= 0 && ph_hi > 1) { ++nseam; SEAM(); }

    for (int lst = 0; lst < 24; ++lst) {
        if (lst + 1 < ph_lo || lst + 1 >= ph_hi) continue;
        int lq = __builtin_amdgcn_readfirstlane(lst / 12), st = __builtin_amdgcn_readfirstlane(lst % 12), zoff = __builtin_amdgcn_readfirstlane(0);
        asm volatile("" : "+s"(lq), "+s"(st), "+s"(zoff));
        unsigned char* ws = a.ws + zoff;
        const int l = lq;
        bf16_t* RA = (bf16_t*)(ws + WS_A);
        const bf16_t* Wl = (const bf16_t*)(ws + WS_W) + (size_t)l * W_LAYER;
        bool isg = true, sync = true;
        pg8::Gemm g{nullptr, nullptr, NT, 0, 0};
        pg8::EpiMix e{}; e.mode = 0; e.rs = nullptr; e.aux = nullptr; e.ob = nullptr; e.ldo = 0;
        switch (st) {
            case 0: g.A = (bf16_t*)(ws + WS_XB); g.Bt = Wl + WO_GU1; g.N = 2 * FF; g.K = DM; e.mode = pg8::EM_SWIGLU; e.rs = rowss_arr(a.out, ws, 3 * l); e.ob = RA; e.ldo = FF; break;
            case 1: g.A = RA; g.Bt = Wl + WO_D1; g.N = DM; g.K = FF; e.mode = pg8::EM_RESID; e.aux = (l == 0) ? (const void*)a.in[0] : nullptr; e.ob = (bf16_t*)(ws + WS_XB); e.ldo = DM; e.rs = rowss_arr(a.out, ws, 3 * l + 1); break;
            case 2: g.A = (bf16_t*)(ws + WS_XB); g.Bt = Wl + WO_IN; g.N = ZP; g.K = DM; e.mode = pg8::EM_Z1; e.rs = rowss_arr(a.out, ws, 3 * l + 1); e.ob = RA; e.ldo = ZP; break;
            case 3: isg = false; break;
            case 4: isg = false; break;
            case 5: g.A = (bf16_t*)(ws + WS_XB); g.Bt = Wl + WO_IN + (size_t)ZP * DM; g.N = 3072; g.K = DM; e.mode = pg8::EM_GATE; e.rs = rowss_arr(a.out, ws, 3 * l + 1); e.aux = a.in[7] + l * 3072; e.ob = RA; e.ldo = 3072; break;
            case 6: g.A = (bf16_t*)(ws + WS_YA); g.Bt = Wl + WO_PA; g.N = DM; g.K = 256; e.mode = pg8::EM_PROJ0; e.aux = RA; e.ob = (bf16_t*)(ws + WS_MERGED); e.ldo = DM; sync = false; break;
            case 7: g.A = (bf16_t*)(ws + WS_YB); g.Bt = Wl + WO_PB; g.N = DM; g.K = 512; e.mode = pg8::EM_PROJ1; e.aux = RA + 1024; e.ob = (bf16_t*)(ws + WS_MERGED); e.ldo = DM; sync = false; break;
            case 8: g.A = (bf16_t*)(ws + WS_YC); g.Bt = Wl + WO_PC; g.N = DM; g.K = 512; e.mode = pg8::EM_PROJ1; e.aux = RA + 2048; e.ob = (bf16_t*)(ws + WS_MERGED); e.ldo = DM; break;
            case 9: g.A = (bf16_t*)(ws + WS_MERGED); g.Bt = Wl + WO_OUT; g.N = DM; g.K = DM; e.mode = pg8::EM_RESID; e.aux = nullptr; e.ob = (bf16_t*)(ws + WS_XB); e.ldo = DM; e.rs = rowss_arr(a.out, ws, 3 * l + 2); break;
            case 10: g.A = (bf16_t*)(ws + WS_XB); g.Bt = Wl + WO_GU2; g.N = 2 * FF; g.K = DM; e.mode = pg8::EM_SWIGLU; e.rs = rowss_arr(a.out, ws, 3 * l + 2); e.ob = RA; e.ldo = FF; break;
            default: g.A = RA; g.Bt = Wl + WO_D2; g.N = DM; g.K = FF; e.mode = pg8::EM_RESID; e.aux = nullptr; e.ob = (bf16_t*)(ws + WS_XB); e.ldo = DM; e.rs = rowss_arr(a.out, ws, 3 * l + 3); break;
        }
        if (isg) {
            pg8::StaticOrder S; S.init(NT, g.N, G, bid);
            pg8::gemm_phase<pg8::EpiMix, pg8::StaticOrder, MK_ALIGN, MK_SP2>(lds, g, S, e);
        } else if (st == 3) {
            const int tid = threadIdx.x;
            float* lse = (float*)(ws + WS_LSE);
            const int xcd = bid & 7, slot = bid >> 3, nslot = G >> 3;
            attn_phase(lds, RA, lse, xcd, slot, nslot, tid);
            for (int k = slot; k < 32; k += nslot) gate_unit(lds, RA, (bf16_t*)(ws + WS_YB), (const bf16_t*)(ws + WS_WST) + (size_t)l * 65536, a.in[8] + l * 512, a.in[9] + l * 512, a.in[11] + l * 512, xcd * 32 + k, tid);
            pool_phase(lds, RA, (bf16_t*)(ws + WS_YC), (const bf16_t*)(ws + WS_WCT) + (size_t)l * 65536, a.in[13] + l * 512, xcd, slot, nslot, tid);
        } else {
            int tid = threadIdx.x; asm volatile("" : "+v"(tid));
            const float* lse = (const float*)(ws + WS_LSE); bf16_t* ya = (bf16_t*)(ws + WS_YA);
            const int xcd = bid & 7, slot = bid >> 3, nslot = G >> 3;
            for (int i = xcd * (SEQ * 32) + slot * NTHREADS + tid; i < (xcd + 1) * (SEQ * 32); i += nslot * NTHREADS) {
                const int tok = i >> 5, j = (i >> 3) & 3, d8 = i & 7;
                const int bb = tok >> 12, tq = tok & (SEQ - 1);
                const float l0 = lse[(size_t)((0 * 4 + j) * 8 + bb) * SEQ + tq], l1 = lse[(size_t)((1 * 4 + j) * 8 + bb) * SEQ + (tq & 3) * (SEQ >> 2) + (tq >> 2)], l2 = lse[(size_t)((2 * 4 + j) * 8 + bb) * SEQ + (tq & 15) * (SEQ >> 4) + (tq >> 4)];
                const float mx = fmaxf(l0, fmaxf(l1, l2)); float e0 = __expf(l0 - mx), e1 = __expf(l1 - mx), e2 = __expf(l2 - mx); const float inv = 1.0f / (e0 + e1 + e2); e0 *= inv; e1 *= inv; e2 *= inv;
                const bf16_t* op = RA + (size_t)tok * ZP + j * 64 + d8 * 8;
                const u32x4 o0 = *(const u32x4*)op, o1 = *(const u32x4*)(op + 256), o2 = *(const u32x4*)(op + 512);
                u32x4 r;
                r.x = cvt_pk_bf16(e0 * bf_lo(o0.x) + e1 * bf_lo(o1.x) + e2 * bf_lo(o2.x), e0 * bf_hi(o0.x) + e1 * bf_hi(o1.x) + e2 * bf_hi(o2.x));
                r.y = cvt_pk_bf16(e0 * bf_lo(o0.y) + e1 * bf_lo(o1.y) + e2 * bf_lo(o2.y), e0 * bf_hi(o0.y) + e1 * bf_hi(o1.y) + e2 * bf_hi(o2.y));
                r.z = cvt_pk_bf16(e0 * bf_lo(o0.z) + e1 * bf_lo(o1.z) + e2 * bf_lo(o2.z), e0 * bf_hi(o0.z) + e1 * bf_hi(o1.z) + e2 * bf_hi(o2.z));
                r.w = cvt_pk_bf16(e0 * bf_lo(o0.w) + e1 * bf_lo(o1.w) + e2 * bf_lo(o2.w), e0 * bf_hi(o0.w) + e1 * bf_hi(o1.w) + e2 * bf_hi(o2.w));
                *(u32x4*)(ya + (size_t)tok * 256 + j * 64 + d8 * 8) = r;
            }
        }
        if (sync && lst + 2 < ph_hi) { ++nseam; if (st == 1 || st == 4 || st == 9) { SEAM(); } else { SEAM_LOCAL(); } }
    }
    if (ph_hi > 25) {
        int tid = threadIdx.x; asm volatile("" : "+v"(tid));
        const int lane = tid & 63, wave = __builtin_amdgcn_readfirstlane(tid >> 6);
        const float* fn = a.in[22]; const float* rs6 = (const float*)(a.ws + WS_RS6); float* X = a.out; const bf16_t* xb = (const bf16_t*)(a.ws + WS_XB);
        const int xcd = bid & 7, slot = bid >> 3, nslot = G >> 3;
        for (int m = xcd * SEQ + slot * 8 + wave; m < (xcd + 1) * SEQ; m += nslot * 8) {
            const float rs = pg8::rstd_of(rs6, m);
            const u32x4* xr = (const u32x4*)(xb + (size_t)m * DM) + lane; f32x4* orow = (f32x4*)(X + (size_t)m * DM) + 2 * lane; const f32x4* gr = (const f32x4*)fn + 2 * lane;
#pragma unroll
            for (int jj = 0; jj < 2; ++jj) { const u32x4 v = xr[64 * jj]; const f32x4 g0 = gr[128 * jj], g1 = gr[128 * jj + 1];
                f32x4 o0 = (f32x4){bf_lo(v.x), bf_hi(v.x), bf_lo(v.y), bf_hi(v.y)} * rs * g0, o1 = (f32x4){bf_lo(v.z), bf_hi(v.z), bf_lo(v.w), bf_hi(v.w)} * rs * g1;
                orow[128 * jj] = o0; orow[128 * jj + 1] = o1; }
        }
    }
}

extern "C" void kernel_launch(void* const* d_in, const int* in_sizes, int n_in, void* d_out, int out_size, void* d_ws, size_t ws_size, hipStream_t stream) {
    static int grid = 0;
    if (grid == 0) {
        if (n_in != 23 || in_sizes[0] != NT * DM || out_size != NT * DM || ws_size < WS_END) { fprintf(stderr, "kernel_launch: unexpected problem (n_in %d, in0 %d, out %d, ws %zu)\n", n_in, n_in > 0 ? in_sizes[0] : -1, out_size, ws_size); grid = -1; return; }
        int dev = 0, cus = 0, per_cu = 0;
        if (hipGetDevice(&dev) != hipSuccess || hipDeviceGetAttribute(&cus, hipDeviceAttributeMultiprocessorCount, dev) != hipSuccess) { grid = -1; return; }
        if (hipFuncSetAttribute((const void*)mega_fwd, hipFuncAttributeMaxDynamicSharedMemorySize, LDS_BYTES) != hipSuccess) { fprintf(stderr, "kernel_launch: hipFuncSetAttribute failed\n"); grid = -1; return; }
        if (hipOccupancyMaxActiveBlocksPerMultiprocessor(&per_cu, (const void*)mega_fwd, NTHREADS, LDS_BYTES) != hipSuccess || per_cu < 1) { fprintf(stderr, "kernel_launch: occupancy query says %d\n", per_cu); per_cu = 1; }
        (void)hipGetLastError();
        grid = cus & ~7;
    }
    if (grid < 0) return;
#ifndef MK_NO_MEMSET
    (void)hipMemsetAsync((char*)d_ws + WS_BAR, 0, 32768, stream);
#endif
    Args a{};
    for (int i = 0; i < 23; ++i) a.in[i] = (const float*)d_in[i];
    a.out = (float*)d_out; a.ws = (unsigned char*)d_ws;
#ifndef MK_N_LAUNCHES
#define MK_N_LAUNCHES 1
#endif
#if MK_N_LAUNCHES == 1
    a.ph_lo = 0; a.ph_hi = 26;
    void* args[] = {&a};
    hipError_t e = hipLaunchCooperativeKernel((const void*)mega_fwd, dim3(grid), dim3(NTHREADS), args, LDS_BYTES, stream);
    if (e != hipSuccess) fprintf(stderr, "cooperative launch failed: %s (grid %d)\n", hipGetErrorString(e), grid);
#else
    for (int ph = 0; ph < 26; ++ph) {
        int hi = ph + 1; const int stp = (ph >= 1 && ph <= 24) ? (ph - 1) % 12 : -1; if (stp == 6) hi = ph + 3;
        a.ph_lo = ph; a.ph_hi = hi;
        hipLaunchKernelGGL(mega_fwd, dim3(grid), dim3(NTHREADS), LDS_BYTES, stream, a);
        ph = hi - 1;
    }
#endif
}
```

```cpp
#include <hip/hip_runtime.h>
#include <hip/hip_cooperative_groups.h>
#include <cstdio>
#include <cstdint>
namespace pg8 {
#define PG8_LAS __attribute__((address_space(3)))
typedef unsigned short bf16_t;
typedef short bf16x8 __attribute__((ext_vector_type(8)));
typedef float f32x4 __attribute__((ext_vector_type(4)));
typedef unsigned u32x4 __attribute__((ext_vector_type(4)));
constexpr int BM = 256, BK = 64, HALF = 128, HTB = HALF * BK * 2  , STAGE_BYTES = 8 * HTB, NXCD = 8, WGM = 8;

__host__ __device__ __forceinline__ int lds_byte(int r, int c) { const int st = (r >> 4) * 2 + (c >> 5), rr = r & 15, cc = c & 31, ob = rr * 64 + cc * 2; return st * 1024 + (ob ^ (((ob >> 9) & 1) << 5)); }
__host__ __device__ __forceinline__ void stage_rc(int b, int& R, int& C) { const int st = b / 1024, sb = b % 1024, swz = sb ^ (((sb >> 9) & 1) << 5); R = (st >> 1) * 16 + swz / 64; C = (st & 1) * 32 + (swz % 64) / 2; }
__host__ __device__ __forceinline__ int perm32(int rho) { const int n = rho >> 4, i = rho & 15; return 8 * (i >> 2) + 4 * n + (i & 3); }

struct Unit { int pm, pn; };
struct Gemm { const bf16_t* A; const bf16_t* Bt; int M, N, K; };

struct StaticOrder {
    int nM, nN, nwg, G, c;
    __host__ __device__ void init(int M, int N, int G_, int c_) { nM = M / BM; nN = N / BM; nwg = nM * nN; G = G_; c = c_; }
    __host__ __device__ bool next(int i, Unit& u) const {
        const long L = (long)i * G + c; if (L >= nwg) return false;
        int wgid = (int)L; { const int q = nwg / NXCD, r = nwg % NXCD, xcd = wgid % NXCD, off = wgid / NXCD; wgid = (xcd < r ? xcd * (q + 1) : r * (q + 1) + (xcd - r) * q) + off; }
        const int nig = WGM * nN, gid = wgid / nig, fm = gid * WGM, gsz = (nM - fm) < WGM ? (nM - fm) : WGM;
        u.pm = fm + ((wgid % nig) % gsz); u.pn = (wgid % nig) / gsz; return true;
    }
    __device__ __forceinline__ void a_ready(const Unit&) const {}
    __device__ __forceinline__ void done(const Unit&) const {}
};

typedef float f32x2 __attribute__((ext_vector_type(2)));
typedef __bf16 bf16x2_c __attribute__((ext_vector_type(2)));
__device__ __forceinline__ unsigned cvt_pk_bf16(float lo, float hi) { const f32x2 v = {lo, hi}; const bf16x2_c b = __builtin_convertvector(v, bf16x2_c); return __builtin_bit_cast(unsigned, b); }
__device__ __forceinline__ f32x2 gelu_pk(f32x2 v) {
    const f32x2 av = __builtin_elementwise_abs(v), d = av * 0.2316418882f + 1.0f;
    f32x2 t; t.x = __builtin_amdgcn_rcpf(d.x); t.y = __builtin_amdgcn_rcpf(d.y);
    f32x2 q = t * 0.5307027145f + (-0.7265760135f); q = q * t + 0.7107068705f; q = q * t + (-0.142248368f); q = q * t + 0.127414796f; q = q * t;
    const f32x2 s = (v * v) * (-0.72134752044f);
    f32x2 e; e.x = __builtin_amdgcn_exp2f(s.x); e.y = __builtin_amdgcn_exp2f(s.y);
    const f32x2 m = v * (q * e), r = v - m;
    f32x2 o; o.x = v.x < 0.f ? m.x : r.x; o.y = v.y < 0.f ? m.y : r.y; return o;
}
typedef unsigned u32x2 __attribute__((ext_vector_type(2)));
__device__ __forceinline__ float bf_lo(unsigned u) { return __uint_as_float(u << 16); }
__device__ __forceinline__ float bf_hi(unsigned u) { return __uint_as_float(u & 0xffff0000u); }
__device__ __forceinline__ float sigmoidf_(float v) { return __builtin_amdgcn_rcpf(1.0f + __expf(-v)); }
constexpr float RMS_EPS = 1e-6f;
__device__ __forceinline__ float rstd_of(const float* part, int r) {
    const f32x4* p = (const f32x4*)(part + (size_t)r * 16); const f32x4 a = p[0], b = p[1], c = p[2], d = p[3];
    const float s = ((a[0] + a[1]) + (a[2] + a[3])) + ((b[0] + b[1]) + (b[2] + b[3])) + (((c[0] + c[1]) + (c[2] + c[3])) + ((d[0] + d[1]) + (d[2] + d[3])));
    return rsqrtf(s * (1.0f / 1024.0f) + RMS_EPS);
}
enum { EM_SWIGLU = 0, EM_RESID = 1, EM_Z1 = 2, EM_GATE = 3, EM_PROJ0 = 4, EM_PROJ1 = 5, EM_DRY = 6 };
struct EpiMix {
    static constexpr bool PERM = true, AFTER_DRAIN = false;
    int mode;
    float* rs;
    const void* aux;
    bf16_t* ob; int ldo;
    __device__ __forceinline__ void operator()(const f32x4 (&acc)[2][2][4][2], const Unit& u, int wr, int wc, int fr, int fq) const {
        const int row0 = u.pm * BM + wr * 64 + fr;
        const int cw = wc * 32 + 8 * fq;
        if (mode == EM_SWIGLU || mode == EM_Z1 || mode == EM_GATE) {
            f32x4 pp[8]; float rs8[8];
            const float* rsb = rs + (size_t)row0 * 16 + 4 * fq;
#pragma unroll
            for (int i = 0; i < 8; ++i) pp[i] = *(const f32x4*)(rsb + ((i >> 2) * HALF + (i & 3) * 16) * 16);
            f32x4 bv[2][2];
            if (mode == EM_GATE) {
#pragma unroll
                for (int bj = 0; bj < 2; ++bj) { const float* bp = (const float*)aux + u.pn * BM + cw + bj * HALF; bv[bj][0] = *(const f32x4*)bp; bv[bj][1] = *(const f32x4*)(bp + 4); }
            }
#pragma unroll
            for (int i = 0; i < 8; ++i) { float t = (pp[i][0] + pp[i][1]) + (pp[i][2] + pp[i][3]); t += __shfl_xor(t, 16); t += __shfl_xor(t, 32); rs8[i] = rsqrtf(t * (1.0f / 1024.0f) + RMS_EPS); }
            if (mode == EM_SWIGLU) {
                bf16_t* obase = ob + (size_t)row0 * 2816 + u.pn * HALF + cw;
#pragma unroll
                for (int ai = 0; ai < 2; ++ai)
#pragma unroll
                    for (int m = 0; m < 4; ++m) {
                        const float rsv = rs8[ai * 4 + m];
                        float h[8];
#pragma unroll
                        for (int n = 0; n < 2; ++n)
#pragma unroll
                            for (int e = 0; e < 4; ++e) { const float g = acc[ai][0][m][n][e] * rsv, up = acc[ai][1][m][n][e] * rsv; h[n * 4 + e] = g * sigmoidf_(g) * up; }
                        u32x4 w; w.x = cvt_pk_bf16(h[0], h[1]); w.y = cvt_pk_bf16(h[2], h[3]); w.z = cvt_pk_bf16(h[4], h[5]); w.w = cvt_pk_bf16(h[6], h[7]);
                        *(u32x4*)(obase + (ai * HALF + m * 16) * 2816) = w;
                    }
            } else if (mode == EM_Z1) {
                const float sc = (u.pn < 3) ? 0.125f : 1.0f; const bool act = (u.pn >= 9 && u.pn <= 12);
                bf16_t* obase = ob + (size_t)row0 * 3840 + u.pn * BM + cw;
#pragma unroll
                for (int ai = 0; ai < 2; ++ai)
#pragma unroll
                    for (int m = 0; m < 4; ++m) {
                        const float rsv = rs8[ai * 4 + m] * sc;
#pragma unroll
                        for (int bj = 0; bj < 2; ++bj) {
                            f32x4 v0 = acc[ai][bj][m][0] * rsv, v1 = acc[ai][bj][m][1] * rsv;
                            if (act) { const f32x2 a = gelu_pk((f32x2){v0[0], v0[1]}), b = gelu_pk((f32x2){v0[2], v0[3]}), c = gelu_pk((f32x2){v1[0], v1[1]}), d = gelu_pk((f32x2){v1[2], v1[3]});
                                v0 = (f32x4){a.x, a.y, b.x, b.y}; v1 = (f32x4){c.x, c.y, d.x, d.y}; }
                            u32x4 w; w.x = cvt_pk_bf16(v0[0], v0[1]); w.y = cvt_pk_bf16(v0[2], v0[3]); w.z = cvt_pk_bf16(v1[0], v1[1]); w.w = cvt_pk_bf16(v1[2], v1[3]);
                            *(u32x4*)(obase + (ai * HALF + m * 16) * 3840 + bj * HALF) = w;
                        }
                    }
            } else {
                bf16_t* obase = ob + (size_t)row0 * 3072 + u.pn * BM + cw;
#pragma unroll
                for (int ai = 0; ai < 2; ++ai)
#pragma unroll
                    for (int m = 0; m < 4; ++m) {
                        const float rsv = rs8[ai * 4 + m];
#pragma unroll
                        for (int bj = 0; bj < 2; ++bj) {
                            const f32x4 v0 = acc[ai][bj][m][0] * rsv + bv[bj][0], v1 = acc[ai][bj][m][1] * rsv + bv[bj][1];
                            u32x4 w; w.x = cvt_pk_bf16(sigmoidf_(v0[0]), sigmoidf_(v0[1])); w.y = cvt_pk_bf16(sigmoidf_(v0[2]), sigmoidf_(v0[3]));
                            w.z = cvt_pk_bf16(sigmoidf_(v1[0]), sigmoidf_(v1[1])); w.w = cvt_pk_bf16(sigmoidf_(v1[2]), sigmoidf_(v1[3]));
                            *(u32x4*)(obase + (ai * HALF + m * 16) * 3072 + bj * HALF) = w;
                        }
                    }
            }
        } else if (mode == EM_RESID) {
            const float* xin = (const float*)aux; const size_t boff = (size_t)row0 * 1024 + u.pn * BM + cw; bf16_t* obase = ob + boff; const float* xbase = xin + boff; float* rsb = rs + (size_t)row0 * 16 + u.pn * 4 + wc;
#pragma unroll
            for (int ai = 0; ai < 2; ++ai) {
                u32x4 xo[4][2];
                if (!xin) {
#pragma unroll
                    for (int m = 0; m < 4; ++m)
#pragma unroll
                        for (int bj = 0; bj < 2; ++bj) xo[m][bj] = *(const u32x4*)(obase + (ai * HALF + m * 16) * 1024 + bj * HALF);
                }
#pragma unroll
                for (int m = 0; m < 4; ++m) {
                    float ss = 0.f;
#pragma unroll
                    for (int bj = 0; bj < 2; ++bj) {
                        const int off = (ai * HALF + m * 16) * 1024 + bj * HALF;
                        f32x4 x0, x1;
                        if (xin) { x0 = *(const f32x4*)(xbase + off); x1 = *(const f32x4*)(xbase + off + 4); }
                        else { const u32x4 q = xo[m][bj]; x0 = (f32x4){bf_lo(q.x), bf_hi(q.x), bf_lo(q.y), bf_hi(q.y)}; x1 = (f32x4){bf_lo(q.z), bf_hi(q.z), bf_lo(q.w), bf_hi(q.w)}; }
                        const f32x4 v0 = x0 + acc[ai][bj][m][0], v1 = x1 + acc[ai][bj][m][1];
                        u32x4 w; w.x = cvt_pk_bf16(v0[0], v0[1]); w.y = cvt_pk_bf16(v0[2], v0[3]); w.z = cvt_pk_bf16(v1[0], v1[1]); w.w = cvt_pk_bf16(v1[2], v1[3]);
                        *(u32x4*)(obase + off) = w;
                        ss += (v0[0] * v0[0] + v0[1] * v0[1]) + (v0[2] * v0[2] + v0[3] * v0[3]) + (v1[0] * v1[0] + v1[1] * v1[1]) + (v1[2] * v1[2] + v1[3] * v1[3]);
                    }
                    ss += __shfl_xor(ss, 16); ss += __shfl_xor(ss, 32);
                    if (fq == 0) rsb[(ai * HALF + m * 16) * 16] = ss;
                }
            }
        } else if (mode == EM_DRY) {
            if (acc[0][0][0][0][0] == 123.456f) ob[0] = 1;
        } else {
            const bool accum = (mode == EM_PROJ1); const bf16_t* gbase = (const bf16_t*)aux + (size_t)row0 * 3072 + u.pn * BM + cw; bf16_t* obase = ob + (size_t)row0 * 1024 + u.pn * BM + cw;
#pragma unroll
            for (int ai = 0; ai < 2; ++ai) {
                u32x4 gv[4][2], old[4][2];
#pragma unroll
                for (int m = 0; m < 4; ++m)
#pragma unroll
                    for (int bj = 0; bj < 2; ++bj) gv[m][bj] = *(const u32x4*)(gbase + (ai * HALF + m * 16) * 3072 + bj * HALF);
                if (accum) {
#pragma unroll
                    for (int m = 0; m < 4; ++m)
#pragma unroll
                        for (int bj = 0; bj < 2; ++bj) old[m][bj] = *(const u32x4*)(obase + (ai * HALF + m * 16) * 1024 + bj * HALF);
                } else {
#pragma unroll
                    for (int m = 0; m < 4; ++m)
#pragma unroll
                        for (int bj = 0; bj < 2; ++bj) old[m][bj] = (u32x4){0u, 0u, 0u, 0u};
                }
#pragma unroll
                for (int m = 0; m < 4; ++m)
#pragma unroll
                    for (int bj = 0; bj < 2; ++bj) {
                        const u32x4 g4 = gv[m][bj], o4 = old[m][bj]; const f32x4 a0 = acc[ai][bj][m][0], a1 = acc[ai][bj][m][1];
                        u32x4 w;
                        w.x = cvt_pk_bf16(bf_lo(o4.x) + bf_lo(g4.x) * a0[0], bf_hi(o4.x) + bf_hi(g4.x) * a0[1]);
                        w.y = cvt_pk_bf16(bf_lo(o4.y) + bf_lo(g4.y) * a0[2], bf_hi(o4.y) + bf_hi(g4.y) * a0[3]);
                        w.z = cvt_pk_bf16(bf_lo(o4.z) + bf_lo(g4.z) * a1[0], bf_hi(o4.z) + bf_hi(g4.z) * a1[1]);
                        w.w = cvt_pk_bf16(bf_lo(o4.w) + bf_lo(g4.w) * a1[2], bf_hi(o4.w) + bf_hi(g4.w) * a1[3]);
                        *(u32x4*)(obase + (ai * HALF + m * 16) * 1024 + bj * HALF) = w;
                    }
            }
        }
    }
};

template <class Epi, class Sched, bool ALIGN_EPI = false, bool SP2 = false>
__device__ __forceinline__ void gemm_phase(PG8_LAS unsigned char* lds, const Gemm g, const Sched& S, const Epi& E) {
    const int tid = threadIdx.x, wid = __builtin_amdgcn_readfirstlane(tid >> 6), lane = tid & 63, wr = wid >> 2, wc = wid & 3, fr = lane & 15, fq = lane >> 4;
    const int K = g.K, nt = K / BK;
    unsigned voffA[2], voffB[2];
#pragma unroll
    for (int i = 0; i < 2; ++i) { int R, C; stage_rc(tid * 16 + i * 8192, R, C); const int Rb = Epi::PERM ? ((R & ~31) + perm32(R & 31)) : R;
        voffA[i] = (unsigned)(R * K + C) * 2u; voffB[i] = (unsigned)(Rb * K + C) * 2u; }
    const size_t kstep = (size_t)(BK * 2);
    const size_t hstep = (size_t)HALF * K * 2;
    const size_t tstep = 2 * hstep;
    const unsigned ldsw = (unsigned)wid * 1024u;
    const int aoff = lds_byte(wr * 64 + fr, fq * 8), boff = lds_byte(wc * 32 + fr, fq * 8);
#define PG8_SA(b, h) (((b) * 2 + (h)) * HTB)
#define PG8_SB(b, h) ((4 + (b) * 2 + (h)) * HTB)
#define PG8_STAGE(bufoff, gbase, voff) do { _Pragma("unroll") for (int _i = 0; _i < 2; ++_i) \
        __builtin_amdgcn_global_load_lds((const unsigned*)((const char*)(gbase) + (voff)[_i]), (PG8_LAS unsigned*)(lds + (bufoff) + ldsw + _i * 8192), 16, 0, 0); } while (0)
#define PG8_LDA(dst, b, h) do { _Pragma("unroll") for (int m = 0; m < 4; ++m) _Pragma("unroll") for (int k = 0; k < 2; ++k) dst[m][k] = *(const PG8_LAS bf16x8*)(lds + PG8_SA(b, h) + aoff + m * 2048 + k * 1024); } while (0)
#define PG8_LDB(dst, b, h) do { _Pragma("unroll") for (int n = 0; n < 2; ++n) _Pragma("unroll") for (int k = 0; k < 2; ++k) dst[n][k] = *(const PG8_LAS bf16x8*)(lds + PG8_SB(b, h) + boff + n * 2048 + k * 1024); } while (0)
#define PG8_MMA(ai, bj, At, Bt) do { __builtin_amdgcn_s_setprio(1); _Pragma("unroll") for (int m = 0; m < 4; ++m) _Pragma("unroll") for (int n = 0; n < 2; ++n) _Pragma("unroll") for (int k = 0; k < 2; ++k) \
        acc[ai][bj][m][n] = __builtin_amdgcn_mfma_f32_16x16x32_bf16(Bt[n][k], At[m][k], acc[ai][bj][m][n], 0, 0, 0); __builtin_amdgcn_s_setprio(0); } while (0)
#define PG8_WAIT_V(n) asm volatile("s_waitcnt vmcnt(" #n ")" ::: "memory")
#define PG8_WAIT_L(n) asm volatile("s_waitcnt lgkmcnt(" #n ")" ::: "memory")
#define PG8_BAR __builtin_amdgcn_s_barrier()
#define PG8_SCHED __builtin_amdgcn_sched_barrier(0)
    Unit cur, nxt; int ui = 0;
    if (!S.next(0, cur)) return;
    f32x4 acc[2][2][4][2];
#pragma unroll
    for (int a = 0; a < 2; ++a)
#pragma unroll
        for (int b = 0; b < 2; ++b)
#pragma unroll
            for (int m = 0; m < 4; ++m)
#pragma unroll
                for (int n = 0; n < 2; ++n) acc[a][b][m][n] = (f32x4){0.f, 0.f, 0.f, 0.f};
    bf16x8 At[4][2], B0[2][2], B1[2][2];
    const char* cA = (const char*)g.A + (size_t)cur.pm * tstep; const char* cB = (const char*)g.Bt + (size_t)cur.pn * tstep;
    S.a_ready(cur);
    if constexpr (SP2) {
        PG8_STAGE(PG8_SB(0, 0), cB, voffB); PG8_STAGE(PG8_SB(0, 1), cB + hstep, voffB); PG8_STAGE(PG8_SA(0, 0), cA, voffA); PG8_STAGE(PG8_SA(0, 1), cA + hstep, voffA);
        if (wr == 1) PG8_BAR;
        PG8_WAIT_V(2); PG8_BAR;
        PG8_STAGE(PG8_SB(1, 0), cB + kstep, voffB); PG8_STAGE(PG8_SA(1, 0), cA + kstep, voffA); PG8_STAGE(PG8_SB(1, 1), cB + hstep + kstep, voffB);
        PG8_WAIT_V(6); PG8_BAR;
    } else {
        PG8_STAGE(PG8_SB(0, 0), cB, voffB); PG8_STAGE(PG8_SA(0, 0), cA, voffA); PG8_STAGE(PG8_SB(0, 1), cB + hstep, voffB); PG8_STAGE(PG8_SA(0, 1), cA + hstep, voffA);
        if (wr == 1) PG8_BAR;
        PG8_WAIT_V(4); PG8_BAR;
        PG8_STAGE(PG8_SB(1, 0), cB + kstep, voffB); PG8_STAGE(PG8_SA(1, 0), cA + kstep, voffA); PG8_STAGE(PG8_SB(1, 1), cB + hstep + kstep, voffB);
        PG8_WAIT_V(6); PG8_BAR;
    }
    for (;;) {
        const bool has_next = S.next(ui + 1, nxt);
        const char* nA = has_next ? (const char*)g.A + (size_t)nxt.pm * tstep : cA; const char* nB = has_next ? (const char*)g.Bt + (size_t)nxt.pn * tstep : cB;
        for (int t = 0; t < nt; t += 2) {
            const bool last = (t == nt - 2);
            const char* a1 = cA + (size_t)(t + 1) * kstep;
            const char* a2 = last ? nA : cA + (size_t)(t + 2) * kstep; const char* b2 = last ? nB : cB + (size_t)(t + 2) * kstep;
            const char* a3 = a2 + kstep; const char* b3 = b2 + kstep;
            if (last && has_next) S.a_ready(nxt);
            if constexpr (SP2) {
            PG8_LDB(B0, 0, 0); PG8_LDB(B1, 0, 1); PG8_SCHED; PG8_LDA(At, 0, 0); PG8_STAGE(PG8_SA(1, 1), a1 + hstep, voffA);
            PG8_WAIT_V(8); PG8_WAIT_L(0); PG8_BAR; PG8_MMA(0, 0, At, B0); PG8_MMA(0, 1, At, B1); PG8_BAR; PG8_SCHED;
            PG8_LDA(At, 0, 1); PG8_STAGE(PG8_SB(0, 0), b2, voffB); PG8_STAGE(PG8_SB(0, 1), b2 + hstep, voffB); PG8_STAGE(PG8_SA(0, 0), a2, voffA);
            PG8_WAIT_V(8); PG8_WAIT_L(0); PG8_BAR; PG8_MMA(1, 0, At, B0); PG8_MMA(1, 1, At, B1); PG8_BAR; PG8_SCHED;
            PG8_LDB(B0, 1, 0); PG8_LDB(B1, 1, 1); PG8_SCHED; PG8_LDA(At, 1, 0); PG8_STAGE(PG8_SA(0, 1), a2 + hstep, voffA);
            PG8_WAIT_V(8); PG8_WAIT_L(0); PG8_BAR; PG8_MMA(0, 0, At, B0); PG8_MMA(0, 1, At, B1); PG8_BAR; PG8_SCHED;
            PG8_LDA(At, 1, 1); PG8_STAGE(PG8_SB(1, 0), b3, voffB); PG8_STAGE(PG8_SB(1, 1), b3 + hstep, voffB); PG8_STAGE(PG8_SA(1, 0), a3, voffA);
            PG8_WAIT_V(8); PG8_WAIT_L(0); PG8_BAR; PG8_MMA(1, 0, At, B0); PG8_MMA(1, 1, At, B1); PG8_BAR; PG8_SCHED;
            } else {
            PG8_LDB(B0, 0, 0); PG8_SCHED; PG8_LDA(At, 0, 0); PG8_STAGE(PG8_SA(1, 1), a1 + hstep, voffA);
            PG8_WAIT_L(8); PG8_BAR; PG8_WAIT_L(0); PG8_MMA(0, 0, At, B0); PG8_BAR; PG8_SCHED;
            PG8_LDB(B1, 0, 1); PG8_STAGE(PG8_SB(0, 0), b2, voffB);
            PG8_BAR; PG8_WAIT_L(0); PG8_MMA(0, 1, At, B1); PG8_BAR;
            PG8_LDA(At, 0, 1); PG8_STAGE(PG8_SA(0, 0), a2, voffA);
            PG8_BAR; PG8_WAIT_L(0); PG8_MMA(1, 0, At, B0); PG8_BAR; PG8_SCHED;
            PG8_STAGE(PG8_SB(0, 1), b2 + hstep, voffB);
            PG8_WAIT_V(6); PG8_BAR; PG8_MMA(1, 1, At, B1); PG8_BAR;
            PG8_LDB(B0, 1, 0); PG8_SCHED; PG8_LDA(At, 1, 0); PG8_STAGE(PG8_SA(0, 1), a2 + hstep, voffA);
            PG8_WAIT_L(8); PG8_BAR; PG8_WAIT_L(0); PG8_MMA(0, 0, At, B0); PG8_BAR; PG8_SCHED;
            PG8_LDB(B1, 1, 1); PG8_STAGE(PG8_SB(1, 0), b3, voffB);
            PG8_BAR; PG8_WAIT_L(0); PG8_MMA(0, 1, At, B1); PG8_BAR;
            PG8_LDA(At, 1, 1); PG8_STAGE(PG8_SA(1, 0), a3, voffA);
            PG8_BAR; PG8_WAIT_L(0); PG8_MMA(1, 0, At, B0); PG8_BAR; PG8_SCHED;
            PG8_STAGE(PG8_SB(1, 1), b3 + hstep, voffB);
            PG8_WAIT_V(6); PG8_BAR; PG8_MMA(1, 1, At, B1); PG8_BAR;
            }
        }
        if constexpr (ALIGN_EPI) { if (wr == 0) PG8_BAR; }
        if constexpr (!Epi::AFTER_DRAIN) { E(acc, cur, wr, wc, fr, fq); S.done(cur); }
        if (!has_next) break;
#pragma unroll
        for (int a = 0; a < 2; ++a)
#pragma unroll
            for (int b = 0; b < 2; ++b)
#pragma unroll
                for (int m = 0; m < 4; ++m)
#pragma unroll
                    for (int n = 0; n < 2; ++n) acc[a][b][m][n] = (f32x4){0.f, 0.f, 0.f, 0.f};
        cur = nxt; cA = nA; cB = nB; ++ui;
        if constexpr (ALIGN_EPI) { if (wr == 1) PG8_BAR; }
    }
    PG8_WAIT_V(0);
    if constexpr (!ALIGN_EPI) { if (wr == 0) PG8_BAR; }
    PG8_BAR;
    if constexpr (Epi::AFTER_DRAIN) { E.fused(acc, cur, wr, wc, fr, fq, lds, wid, lane); S.done(cur); }
#undef PG8_SA
#undef PG8_SB
#undef PG8_STAGE
#undef PG8_LDA
#undef PG8_LDB
#undef PG8_MMA
#undef PG8_WAIT_V
#undef PG8_WAIT_L
#undef PG8_BAR
#undef PG8_SCHED
}
}
namespace cg = cooperative_groups;
#define LAS __attribute__((address_space(3)))
using pg8::bf16_t; using pg8::bf16x8; using pg8::f32x4; using pg8::u32x4; using pg8::u32x2; using pg8::f32x2;
using pg8::bf_lo; using pg8::bf_hi;
using pg8::cvt_pk_bf16;

constexpr int NT = 32768, DM = 1024, FF = 2816, SEQ = 4096;
constexpr int ZP = 3840;
constexpr int NTHREADS = 512, LDS_STAGE = 131072, LDS_BYTES = LDS_STAGE + 256;
constexpr size_t MiB = 1u << 20;
constexpr size_t WS_ROWSS = 0;
constexpr size_t WS_BAR = 960 * 1024;
constexpr size_t WS_LSE = 1 * MiB;
constexpr size_t WS_WST = 3 * MiB;
constexpr size_t WS_WCT = 3 * MiB + 256 * 1024;
constexpr size_t WS_W = 4 * MiB;
constexpr size_t W_LAYER = 26738688;
constexpr size_t WO_GU1 = 0, WO_D1 = 5767168, WO_IN = 8650752, WO_PA = 15728640, WO_PB = 15990784, WO_PC = 16515072, WO_OUT = 17039360, WO_GU2 = 18087936, WO_D2 = 23855104;
constexpr size_t WS_XB = 106 * MiB;
constexpr size_t WS_YA = 170 * MiB, WS_YB = 186 * MiB, WS_YC = 218 * MiB;
constexpr size_t WS_A = 250 * MiB;
constexpr size_t WS_MERGED = WS_A + 192 * MiB;
constexpr size_t WS_RS6 = 506 * MiB;
constexpr size_t WS_END = 508 * MiB;

__device__ __forceinline__ float wave_sum(float v) {
#pragma unroll
    for (int o = 1; o < 64; o <<= 1) v += __shfl_xor(v, o);
    return v;
}
__device__ __forceinline__ f32x4 mfma16(bf16x8 a, bf16x8 b, f32x4 c) { return __builtin_amdgcn_mfma_f32_16x16x32_bf16(a, b, c, 0, 0, 0); }

struct TItem { const float* src; bf16_t* dst; const float* ksc; float cs; int K, N, n0, drow0, k0; };
struct TRegs { f32x4 v[8]; float sc[8]; };
__device__ __forceinline__ void titem_load(TRegs& R, const TItem& I, int lane) {
    const int kr = lane >> 3, n4 = (lane & 7) * 4;
#pragma unroll
    for (int i = 0; i < 8; ++i) { R.v[i] = *(const f32x4*)(I.src + (size_t)(I.k0 + 8 * i + kr) * I.N + I.n0 + n4); R.sc[i] = I.ksc ? I.ksc[I.k0 + 8 * i + kr] * I.cs : I.cs; }
}
__device__ __forceinline__ void titem_finish(const TRegs& R, const TItem& I, LAS float* scr, int lane) {
    const int kr = lane >> 3, n4 = (lane & 7) * 4;
#pragma unroll
    for (int i = 0; i < 8; ++i) { LAS float* d = scr + (8 * i + kr) * 33 + n4; d[0] = R.v[i][0] * R.sc[i]; d[1] = R.v[i][1] * R.sc[i]; d[2] = R.v[i][2] * R.sc[i]; d[3] = R.v[i][3] * R.sc[i]; }
    asm volatile("s_waitcnt lgkmcnt(0)" ::: "memory");
    const int c = lane & 7;
#pragma unroll
    for (int j = 0; j < 4; ++j) { const int n = (lane >> 3) + 8 * j; const LAS float* s = scr + (8 * c) * 33 + n;
        u32x4 o; o.x = cvt_pk_bf16(s[0 * 33], s[1 * 33]); o.y = cvt_pk_bf16(s[2 * 33], s[3 * 33]); o.z = cvt_pk_bf16(s[4 * 33], s[5 * 33]); o.w = cvt_pk_bf16(s[6 * 33], s[7 * 33]);
        *(u32x4*)(I.dst + (size_t)(I.drow0 + n) * I.K + I.k0 + 8 * c) = o; }
    asm volatile("s_waitcnt lgkmcnt(0)" ::: "memory");
}

__device__ __forceinline__ void mm128(const LAS unsigned char* A, const LAS unsigned char* B, int w, int fr, int fq, f32x4 (&acc)[8]) {
    bf16x8 bw[4];
#pragma unroll
    for (int ks = 0; ks < 4; ++ks) bw[ks] = *(const LAS bf16x8*)(B + (16 * w + fr) * 272 + ks * 64 + fq * 16);
#pragma unroll
    for (int ct = 0; ct < 8; ++ct) {
        f32x4 c = (f32x4){0.f, 0.f, 0.f, 0.f};
#pragma unroll
        for (int ks = 0; ks < 4; ++ks) { const bf16x8 a = *(const LAS bf16x8*)(A + (16 * ct + fr) * 272 + ks * 64 + fq * 16); c = mfma16(a, bw[ks], c); }
        acc[ct] = c;
    }
}

struct AttnRegs { u32x4 kv[4], vv[4]; bf16x8 q0, q1; };
__device__ __forceinline__ void attn_decode(int k, int xcd, int& g, int& j, int& sh, int& r, int& n) {
    g = k >> 7; j = (k >> 5) & 3; const int rn = k & 31; sh = 2 * g; r = rn >> (5 - sh); n = rn & ((32 >> sh) - 1); (void)xcd;
}
__device__ __forceinline__ void attn_load(AttnRegs& R, const bf16_t* Z1, int k, int xcd, int tid, int w, int fr, int fq) {
    int g, j, sh, r, n; attn_decode(k, xcd, g, j, sh, r, n);
    const int colq = g * 256 + j * 64; const size_t tok_b = (size_t)xcd * SEQ + r;
#pragma unroll
    for (int it = 0; it < 4; ++it) {
        const int c = tid + NTHREADS * it; const int key = c & 255, dc = c >> 8;
        const int p = (n - 1) * 128 + key; const int pc = p < 0 ? 0 : p;
        const bf16_t* src = Z1 + (tok_b + ((size_t)pc << sh)) * ZP + colq + dc * 8;
        R.kv[it] = *(const u32x4*)(src + 768); R.vv[it] = *(const u32x4*)(src + 1536);
    }
    const bf16_t* qp = Z1 + (tok_b + ((size_t)(n * 128 + 16 * w + fr) << sh)) * ZP + colq;
    R.q0 = *(const bf16x8*)(qp + fq * 8); R.q1 = *(const bf16x8*)(qp + 32 + fq * 8);
}
__device__ __forceinline__ void attn_stage(const AttnRegs& R, LAS unsigned char* lds, int k, int xcd, int tid) {
    int g, j, sh, r, n; attn_decode(k, xcd, g, j, sh, r, n);
#pragma unroll
    for (int it = 0; it < 4; ++it) {
        const int c = tid + NTHREADS * it; const int key = c & 255, dc = c >> 8;
        const bool ok = ((n - 1) * 128 + key) >= 0; const u32x4 z = (u32x4){0u, 0u, 0u, 0u};
        const u32x4 kv = ok ? R.kv[it] : z, vv = ok ? R.vv[it] : z;
        *(LAS u32x4*)(lds + key * 144 + dc * 16) = kv;
        const int k32 = key & 31; const int pos = (key & ~31) + 8 * ((k32 & 15) >> 2) + 4 * (k32 >> 4) + (k32 & 3);
        LAS bf16_t* vt = (LAS bf16_t*)(lds + 36864) + (dc * 8) * 264 + pos;
        vt[0 * 264] = (bf16_t)(vv.x & 0xffffu); vt[1 * 264] = (bf16_t)(vv.x >> 16); vt[2 * 264] = (bf16_t)(vv.y & 0xffffu); vt[3 * 264] = (bf16_t)(vv.y >> 16);
        vt[4 * 264] = (bf16_t)(vv.z & 0xffffu); vt[5 * 264] = (bf16_t)(vv.z >> 16); vt[6 * 264] = (bf16_t)(vv.w & 0xffffu); vt[7 * 264] = (bf16_t)(vv.w >> 16);
    }
}
__device__ __forceinline__ void attn_compute(LAS unsigned char* lds, bf16_t* Z1, float* lse, int k, int xcd, bf16x8 q0, bf16x8 q1, int w, int fr, int fq, bool dostore = true) {
    int g, j, sh, r, n; attn_decode(k, xcd, g, j, sh, r, n);
    const int colq = g * 256 + j * 64; const size_t tok_b = (size_t)xcd * SEQ + r; const int qi = 16 * w + fr;
    bf16_t* qp = Z1 + (tok_b + ((size_t)(n * 128 + qi) << sh)) * ZP + colq;
    const int kt0 = (w < 6 ? w : 6) & ~1;
    f32x4 s[10];
#pragma unroll
    for (int t = 0; t < 10; ++t) {
        const LAS unsigned char* kp = lds + (16 * (kt0 + t) + fr) * 144 + fq * 16;
        const bf16x8 a0 = *(const LAS bf16x8*)kp, a1 = *(const LAS bf16x8*)(kp + 64);
        s[t] = mfma16(a0, q0, (f32x4){0.f, 0.f, 0.f, 0.f}); s[t] = mfma16(a1, q1, s[t]);
    }
    constexpr float L2E = 1.4426950408889634f;
    float mx = -1e30f;
#pragma unroll
    for (int t = 0; t < 10; ++t)
#pragma unroll
        for (int i = 0; i < 4; ++i) {
            const int kj = 16 * (kt0 + t) + 4 * fq + i; const int dist = qi + 128 - kj;
            const bool valid = (dist >= 0) && (dist <= 128) && !(n == 0 && kj < 128);
            const float v = valid ? s[t][i] * L2E : -1e30f; s[t][i] = v; mx = fmaxf(mx, v);
        }
    mx = fmaxf(mx, __shfl_xor(mx, 16)); mx = fmaxf(mx, __shfl_xor(mx, 32));
    float l = 0.f;
#pragma unroll
    for (int t = 0; t < 10; ++t)
#pragma unroll
        for (int i = 0; i < 4; ++i) { const float p = __builtin_amdgcn_exp2f(s[t][i] - mx); s[t][i] = p; l += p; }
    l += __shfl_xor(l, 16); l += __shfl_xor(l, 32);
    f32x4 o[4];
#pragma unroll
    for (int dt = 0; dt < 4; ++dt) o[dt] = (f32x4){0.f, 0.f, 0.f, 0.f};
#pragma unroll
    for (int G = 0; G < 5; ++G) {
        u32x4 pw; pw.x = cvt_pk_bf16(s[2 * G][0], s[2 * G][1]); pw.y = cvt_pk_bf16(s[2 * G][2], s[2 * G][3]); pw.z = cvt_pk_bf16(s[2 * G + 1][0], s[2 * G + 1][1]); pw.w = cvt_pk_bf16(s[2 * G + 1][2], s[2 * G + 1][3]);
        const bf16x8 pb = __builtin_bit_cast(bf16x8, pw);
#pragma unroll
        for (int dt = 0; dt < 4; ++dt) {
            const bf16x8 va = *(const LAS bf16x8*)(lds + 36864 + (16 * dt + fr) * 528 + (32 * (kt0 / 2 + G) + 8 * fq) * 2);
            o[dt] = mfma16(va, pb, o[dt]);
        }
    }
    const float rl = 1.0f / l;
    if (!dostore) { if (rl == 123.456f) lse[0] = o[0][0] + o[1][1] + o[2][2] + o[3][3]; return; }
#pragma unroll
    for (int dt = 0; dt < 4; ++dt) { u32x2 wv; wv.x = cvt_pk_bf16(o[dt][0] * rl, o[dt][1] * rl); wv.y = cvt_pk_bf16(o[dt][2] * rl, o[dt][3] * rl); *(u32x2*)(qp + 16 * dt + 4 * fq) = wv; }
    if (fq == 0) lse[(size_t)((g * 4 + j) * 8 + xcd) * SEQ + r * (SEQ >> sh) + n * 128 + qi] = (mx + __log2f(l)) * 0.6931471805599453f;
}
__device__ __forceinline__ void attn_phase(LAS unsigned char* lds, bf16_t* Z1, float* lse, int xcd, int slot, int nslot, int tid, bool dostore = true) {
    asm volatile("" : "+v"(tid));
    const int lane = tid & 63, w = __builtin_amdgcn_readfirstlane(tid >> 6), fr = lane & 15, fq = lane >> 4;
    int k = slot; if (k >= 384) return;
    AttnRegs R0, R1; attn_load(R0, Z1, k, xcd, tid, w, fr, fq);
    for (;;) {
        const int k1 = k + nslot;
        if (k1 < 384) attn_load(R1, Z1, k1, xcd, tid, w, fr, fq);
        attn_stage(R0, lds, k, xcd, tid);
        __syncthreads();
        attn_compute(lds, Z1, lse, k, xcd, R0.q0, R0.q1, w, fr, fq, dostore);
        __syncthreads();
        if (k1 >= 384) break;
        const int k2 = k1 + nslot;
        if (k2 < 384) attn_load(R0, Z1, k2, xcd, tid, w, fr, fq);
        attn_stage(R1, lds, k1, xcd, tid);
        __syncthreads();
        attn_compute(lds, Z1, lse, k1, xcd, R1.q0, R1.q1, w, fr, fq, dostore);
        __syncthreads();
        if (k2 >= 384) break;
        k = k2;
    }
}

__device__ __forceinline__ void gate_unit(LAS unsigned char* lds, const bf16_t* Z1, bf16_t* yb, const bf16_t* wsT, const float* lng, const float* lnb, const float* bbs, int ch, int tid) {
    asm volatile("" : "+v"(tid));
    const int lane = tid & 63, w = __builtin_amdgcn_readfirstlane(tid >> 6), fr = lane & 15, fq = lane >> 4;
    const size_t t0 = (size_t)ch * 128;
    LAS float* st = (LAS float*)lds;
    {
        u32x4 raw[16]; float sm[16], mean[16], q[16];
        const bf16_t* vp = Z1 + (t0 + 16 * w) * ZP + 2816 + lane * 8;
#pragma unroll
        for (int i = 0; i < 16; ++i) raw[i] = *(const u32x4*)(vp + (size_t)i * ZP);
#pragma unroll
        for (int i = 0; i < 16; ++i) sm[i] = ((bf_lo(raw[i].x) + bf_hi(raw[i].x)) + (bf_lo(raw[i].y) + bf_hi(raw[i].y))) + ((bf_lo(raw[i].z) + bf_hi(raw[i].z)) + (bf_lo(raw[i].w) + bf_hi(raw[i].w)));
#pragma unroll
        for (int o = 1; o < 64; o <<= 1)
#pragma unroll
            for (int i = 0; i < 16; ++i) sm[i] += __shfl_xor(sm[i], o);
#pragma unroll
        for (int i = 0; i < 16; ++i) { mean[i] = sm[i] * (1.0f / 512.0f); const float m_ = mean[i];
            const float d0 = bf_lo(raw[i].x) - m_, d1 = bf_hi(raw[i].x) - m_, d2 = bf_lo(raw[i].y) - m_, d3 = bf_hi(raw[i].y) - m_, d4 = bf_lo(raw[i].z) - m_, d5 = bf_hi(raw[i].z) - m_, d6 = bf_lo(raw[i].w) - m_, d7 = bf_hi(raw[i].w) - m_;
            q[i] = ((d0 * d0 + d1 * d1) + (d2 * d2 + d3 * d3)) + ((d4 * d4 + d5 * d5) + (d6 * d6 + d7 * d7)); }
#pragma unroll
        for (int o = 1; o < 64; o <<= 1)
#pragma unroll
            for (int i = 0; i < 16; ++i) q[i] += __shfl_xor(q[i], o);
        if (lane < 16) {
            float mm = mean[0], qq = q[0];
#pragma unroll
            for (int i = 1; i < 16; ++i) { mm = (lane == i) ? mean[i] : mm; qq = (lane == i) ? q[i] : qq; }
            st[2 * (16 * w + lane)] = mm; st[2 * (16 * w + lane) + 1] = rsqrtf(qq * (1.0f / 512.0f) + 1e-6f);
        }
    }
    __syncthreads();
    const int t = 16 * w + fr;
    for (int g = 0; g < 4; ++g) {
        u32x4 wv[4], vv[4]; u32x2 uu[8]; f32x4 lg[4][2], lb[4][2];
#pragma unroll
        for (int it = 0; it < 4; ++it) {
            const int c = tid + NTHREADS * it;
            wv[it] = *(const u32x4*)(wsT + (size_t)(g * 128 + (c >> 4)) * 128 + (c & 15) * 8);
            const int sidx = c & 127, c8 = c >> 7; const int chn = g * 128 + c8 * 8;
            vv[it] = *(const u32x4*)(Z1 + (t0 + sidx) * ZP + 2816 + chn);
            lg[it][0] = *(const f32x4*)(lng + chn); lg[it][1] = *(const f32x4*)(lng + chn + 4); lb[it][0] = *(const f32x4*)(lnb + chn); lb[it][1] = *(const f32x4*)(lnb + chn + 4);
        }
#pragma unroll
        for (int ct = 0; ct < 8; ++ct) uu[ct] = *(const u32x2*)(Z1 + (t0 + t) * ZP + 2304 + g * 128 + 16 * ct + 4 * fq);
        const float bias = bbs[g * 128 + t];
#pragma unroll
        for (int it = 0; it < 4; ++it) {
            const int c = tid + NTHREADS * it;
            *(LAS u32x4*)(lds + 1024 + (c >> 4) * 272 + (c & 15) * 16) = wv[it];
            const int sidx = c & 127, c8 = c >> 7; const u32x4 raw = vv[it];
            const float mean = st[2 * sidx], rstd = st[2 * sidx + 1];
            const float x[8] = {bf_lo(raw.x), bf_hi(raw.x), bf_lo(raw.y), bf_hi(raw.y), bf_lo(raw.z), bf_hi(raw.z), bf_lo(raw.w), bf_hi(raw.w)};
            const float gg[8] = {lg[it][0][0], lg[it][0][1], lg[it][0][2], lg[it][0][3], lg[it][1][0], lg[it][1][1], lg[it][1][2], lg[it][1][3]};
            const float bb[8] = {lb[it][0][0], lb[it][0][1], lb[it][0][2], lb[it][0][3], lb[it][1][0], lb[it][1][1], lb[it][1][2], lb[it][1][3]};
            LAS bf16_t* vt = (LAS bf16_t*)(lds + 35840) + (c8 * 8) * 136 + sidx;
#pragma unroll
            for (int e = 0; e < 8; e += 2) { const unsigned pk = cvt_pk_bf16((x[e] - mean) * rstd * gg[e] + bb[e], (x[e + 1] - mean) * rstd * gg[e + 1] + bb[e + 1]); vt[e * 136] = (bf16_t)(pk & 0xffffu); vt[(e + 1) * 136] = (bf16_t)(pk >> 16); }
        }
        __syncthreads();
        f32x4 acc[8];
        mm128(lds + 35840, lds + 1024, w, fr, fq, acc);
#pragma unroll
        for (int ct = 0; ct < 8; ++ct) {
            const int chn = g * 128 + 16 * ct + 4 * fq; const u32x2 u2 = uu[ct];
            u32x2 o; o.x = cvt_pk_bf16(bf_lo(u2.x) * (acc[ct][0] + bias), bf_hi(u2.x) * (acc[ct][1] + bias)); o.y = cvt_pk_bf16(bf_lo(u2.y) * (acc[ct][2] + bias), bf_hi(u2.y) * (acc[ct][3] + bias));
            *(u32x2*)(yb + (t0 + t) * 512 + chn) = o;
        }
        __syncthreads();
    }
}

struct PoolRegs { u32x4 xr[5], wr4[4]; };
__device__ __forceinline__ void pool_load(PoolRegs& R, const bf16_t* Z1, const bf16_t* wcT, int unit, int tid) {
    const int tile = unit >> 2, gi = unit & 3; const size_t t0 = (size_t)tile * 128; const int tpos0 = (int)(t0 & (SEQ - 1));
#pragma unroll
    for (int it = 0; it < 5; ++it) {
        const int c = tid + NTHREADS * it; const int row = c >> 4, c8 = c & 15; const int tt = row - 15;
        const bool ok = (c < 143 * 16) && (tpos0 + tt >= 0);
        const long trow = ok ? ((long)t0 + tt) : (long)t0;
        R.xr[it] = *(const u32x4*)(Z1 + (size_t)trow * ZP + 3328 + gi * 128 + c8 * 8);
    }
#pragma unroll
    for (int it = 0; it < 4; ++it) { const int c = tid + NTHREADS * it; R.wr4[it] = *(const u32x4*)(wcT + (size_t)(gi * 128 + (c >> 4)) * 128 + (c & 15) * 8); }
}
__device__ __forceinline__ void pool_stage(const PoolRegs& R, LAS unsigned char* lds, int unit, int tid) {
    const int tile = unit >> 2; const size_t t0 = (size_t)tile * 128; const int tpos0 = (int)(t0 & (SEQ - 1));
#pragma unroll
    for (int it = 0; it < 5; ++it) { const int c = tid + NTHREADS * it; const int tt = (c >> 4) - 15; const bool ok = (tpos0 + tt >= 0);
        if (c < 143 * 16) *(LAS u32x4*)(lds + (c >> 4) * 272 + (c & 15) * 16) = ok ? R.xr[it] : (u32x4){0u, 0u, 0u, 0u}; }
#pragma unroll
    for (int it = 0; it < 4; ++it) { const int c = tid + NTHREADS * it; *(LAS u32x4*)(lds + 73728 + (c >> 4) * 272 + (c & 15) * 16) = R.wr4[it]; }
}
__device__ __forceinline__ void pool_compute(LAS unsigned char* lds, bf16_t* yc, const float* cscale, int unit, int tid, int w, int fr, int fq) {
    const int tile = unit >> 2, gi = unit & 3; const size_t t0 = (size_t)tile * 128; const int tpos0 = (int)(t0 & (SEQ - 1)); const int win = 2 << gi;
#pragma unroll
    for (int it = 0; it < 4; ++it) {
        const int c = tid + NTHREADS * it; const int t = c >> 4, c8 = c & 15;
        const int cnt = (tpos0 + t + 1 < win) ? (tpos0 + t + 1) : win;
        float sm[8] = {0.f, 0.f, 0.f, 0.f, 0.f, 0.f, 0.f, 0.f};
        for (int i = 0; i < cnt; ++i) { const u32x4 raw = *(const LAS u32x4*)(lds + (t + 15 - i) * 272 + c8 * 16);
            sm[0] += bf_lo(raw.x); sm[1] += bf_hi(raw.x); sm[2] += bf_lo(raw.y); sm[3] += bf_hi(raw.y); sm[4] += bf_lo(raw.z); sm[5] += bf_hi(raw.z); sm[6] += bf_lo(raw.w); sm[7] += bf_hi(raw.w); }
        const u32x4 xt = *(const LAS u32x4*)(lds + (t + 15) * 272 + c8 * 16); const float ic = 1.0f / (float)cnt;
        u32x4 o; o.x = cvt_pk_bf16(sm[0] * ic - bf_lo(xt.x), sm[1] * ic - bf_hi(xt.x)); o.y = cvt_pk_bf16(sm[2] * ic - bf_lo(xt.y), sm[3] * ic - bf_hi(xt.y));
        o.z = cvt_pk_bf16(sm[4] * ic - bf_lo(xt.z), sm[5] * ic - bf_hi(xt.z)); o.w = cvt_pk_bf16(sm[6] * ic - bf_lo(xt.w), sm[7] * ic - bf_hi(xt.w));
        *(LAS u32x4*)(lds + 38912 + t * 272 + c8 * 16) = o;
    }
    __syncthreads();
    f32x4 acc[8];
    mm128(lds + 73728, lds + 38912, w, fr, fq, acc);
    const int t = 16 * w + fr;
#pragma unroll
    for (int dt = 0; dt < 8; ++dt) {
        const int d = gi * 128 + 16 * dt + 4 * fq; const f32x4 sc = *(const f32x4*)(cscale + d);
        u32x2 o; o.x = cvt_pk_bf16(acc[dt][0] * sc[0], acc[dt][1] * sc[1]); o.y = cvt_pk_bf16(acc[dt][2] * sc[2], acc[dt][3] * sc[3]);
        *(u32x2*)(yc + (t0 + t) * 512 + d) = o;
    }
}
__device__ __forceinline__ void pool_phase(LAS unsigned char* lds, const bf16_t* Z1, bf16_t* yc, const bf16_t* wcT, const float* cscale, int xcd, int slot, int nslot, int tid) {
    asm volatile("" : "+v"(tid));
    const int lane = tid & 63, w = __builtin_amdgcn_readfirstlane(tid >> 6), fr = lane & 15, fq = lane >> 4;
    int k = slot; if (k >= 128) return;
    PoolRegs R; pool_load(R, Z1, wcT, xcd * 128 + k, tid);
    for (;;) {
        pool_stage(R, lds, xcd * 128 + k, tid);
        __syncthreads();
        const int kn = k + nslot;
        if (kn < 128) pool_load(R, Z1, wcT, xcd * 128 + kn, tid);
        pool_compute(lds, yc, cscale, xcd * 128 + k, tid, w, fr, fq);
        __syncthreads();
        if (kn >= 128) break;
        k = kn;
    }
}

typedef unsigned v4u __attribute__((ext_vector_type(4)));
#define XB_TMO      128
#define XB_XCNT(j)  (256  + 64 * (j))
#define XB_XSUB(j)  (1280 + 64 * (j))
#define XB_XGEN(j)  (2304 + 64 * (j))
#define XB_TOP      3328
#define XB_TOPGEN   3392
#define XCD_BAR_WORDS 3456
#define XB_SPIN_CAP (1u << 18)

__device__ __forceinline__ unsigned xb_ld(unsigned* p)              { return __hip_atomic_load(p, __ATOMIC_RELAXED, __HIP_MEMORY_SCOPE_AGENT); }
__device__ __forceinline__ unsigned xb_add(unsigned* p, unsigned v) { return __hip_atomic_fetch_add(p, v, __ATOMIC_RELAXED, __HIP_MEMORY_SCOPE_AGENT); }
__device__ __forceinline__ unsigned xb_xcc_id() { return (unsigned)__builtin_amdgcn_s_getreg((3 << 11) | 20) & 0xFu; }
#define XB_SPIN(cond, bar) do { unsigned _sp = 0; while (cond) { __builtin_amdgcn_s_sleep(1); \
    if ((++_sp & 255u) == 0u) { if (xb_ld(&(bar)[XB_TMO])) break; if (_sp > XB_SPIN_CAP) { atomicAdd(&(bar)[XB_TMO], 1u); break; } } } } while (0)

struct XcdBarrier {
    unsigned* bar; unsigned x;
    volatile LAS unsigned* st;
};

__device__ __forceinline__ XcdBarrier xcd_barrier_post(unsigned* bar, volatile LAS unsigned* st) {
    XcdBarrier b; b.bar = bar; b.x = xb_xcc_id(); b.st = st;
    if (threadIdx.x == 0) (void)xb_add(&bar[XB_XCNT(b.x)], 1u);
    return b;
}
__device__ __forceinline__ void xcd_barrier_complete(unsigned* bar, unsigned x, unsigned& nloc, unsigned& nx) {
    const unsigned G = gridDim.x * gridDim.y * gridDim.z;
    unsigned sum, cnt, mine, sp = 0u;
    for (;;) {
        sum = 0u; cnt = 0u; mine = 0u;
#pragma unroll
        for (unsigned j = 0; j < 16; ++j) { const unsigned c = xb_ld(&bar[XB_XCNT(j)]); sum += c; cnt += (c > 0u) ? 1u : 0u; mine = (j == x) ? c : mine; }
        if (sum == G) break;
        __builtin_amdgcn_s_sleep(1);
        if ((++sp & 255u) == 0u) { if (xb_ld(&bar[XB_TMO])) break; if (sp > XB_SPIN_CAP) { atomicAdd(&bar[XB_TMO], 1u); break; } }
    }
    nloc = mine > 0u ? mine : 1u; nx = cnt > 0u ? cnt : 1u;
}

__device__ __forceinline__ void xcd_barrier(const XcdBarrier& b) {
    asm volatile("s_waitcnt vmcnt(0)" ::: "memory");
    __syncthreads();
    if (threadIdx.x == 0) {
        unsigned* bar = b.bar;
        __builtin_amdgcn_s_waitcnt(0);
        unsigned nloc = b.st[0], nx = b.st[1];
        if (nloc == 0u) { xcd_barrier_complete(bar, b.x, nloc, nx); b.st[0] = nloc; b.st[1] = nx; }
        const unsigned old = xb_add(&bar[XB_XSUB(b.x)], 1u);
        const unsigned gen = old / nloc;
        if (old + 1u == (gen + 1u) * nloc) {
#ifdef DBG_SKIP_WBL2
            if (xb_ld(&bar[XB_TOP]) < 8u)
#endif
            __builtin_amdgcn_fence(__ATOMIC_RELEASE, "agent");
            asm volatile("s_waitcnt vmcnt(0)" ::: "memory");
            const unsigned og = xb_add(&bar[XB_TOP], 1u);
            const unsigned tg = og / nx;
            if (og + 1u == (tg + 1u) * nx) xb_add(&bar[XB_TOPGEN], 1u);
            else XB_SPIN(xb_ld(&bar[XB_TOPGEN]) == tg, bar);
            __builtin_amdgcn_fence(__ATOMIC_ACQUIRE, "agent");
            xb_add(&bar[XB_XGEN(b.x)], 1u);
            asm volatile("s_waitcnt vmcnt(0)" ::: "memory");
        } else {
            XB_SPIN(xb_ld(&bar[XB_XGEN(b.x)]) == gen, bar);
            __builtin_amdgcn_fence(__ATOMIC_ACQUIRE, "agent");
            asm volatile("s_waitcnt vmcnt(0)" ::: "memory");
        }
    }
    __syncthreads();
}


__device__ __forceinline__ void grid_seam(unsigned* bar, unsigned target) {
#ifdef DBG_REP_SEAM
  for (int rep_ = 0; rep_ < 2; ++rep_) {
    target = 2 * target - (1 - rep_) * gridDim.x;
#endif
    asm volatile("s_waitcnt vmcnt(0) lgkmcnt(0)" ::: "memory");
    __syncthreads();
    if (threadIdx.x == 0) {
        __builtin_amdgcn_fence(__ATOMIC_RELEASE, "agent"); asm volatile("s_waitcnt vmcnt(0)" ::: "memory");
        __hip_atomic_fetch_add(bar, 1u, __ATOMIC_RELAXED, __HIP_MEMORY_SCOPE_AGENT);
        unsigned spins = 0;
        while (__hip_atomic_load(bar, __ATOMIC_RELAXED, __HIP_MEMORY_SCOPE_AGENT) < target) { __builtin_amdgcn_s_sleep(2); if (++spins > (1u << 24)) break; }
        __builtin_amdgcn_fence(__ATOMIC_ACQUIRE, "agent"); asm volatile("s_waitcnt vmcnt(0)" ::: "memory");
    }
    __syncthreads();
#ifdef DBG_REP_SEAM
    target = (target + (1 - rep_) * gridDim.x) / 2;
  }
#endif
}

#ifndef DBG_SEAM_ALL
#define DBG_SEAM_ALL 0
#endif
__device__ __forceinline__ float* rowss_arr(float* dout, unsigned char* ws, int k) { return k < 6 ? dout + (size_t)k * NT * 16 : (float*)(ws + WS_RS6); }
#ifndef MK_WITH_MEMSET
#define MK_NO_MEMSET 1
#endif
#ifndef MK_ALIGN
#define MK_ALIGN true
#endif
#ifndef MK_SP2
#define MK_SP2 true
#endif
#ifndef MK_LOCAL_SEAMS
#define SEAM_LOCAL() SEAM()
#else
#define SEAM_LOCAL() grid_seam((unsigned*)(a.ws + WS_BAR) + 4096 + 64 * (bid & 7), nseam_local_ += (unsigned)(G >> 3))
#endif
#ifdef MK_FLAT_BAR
#define SEAM() grid_seam((unsigned*)(a.ws + WS_BAR) + 4096, nseam * (unsigned)G)
#elif defined(DBG_REP_XB)
#define SEAM() do { xcd_barrier(xbar); xcd_barrier(xbar); } while (0)
#else
#define SEAM() xcd_barrier(xbar)
#endif
#ifndef DBG_TIME_BLK
#define DBG_TIME_BLK 0
#endif
#ifndef DBG_TIME_L
#define DBG_TIME_L 0
#endif
struct Args { const float* in[23]; float* out; unsigned char* ws; int ph_lo, ph_hi; };

__device__ __forceinline__ void titem_desc(TItem& I, const Args& a, bf16_t* Wb, bf16_t* wcT, int it0) {
    I.ksc = nullptr; I.cs = 1.f; int map = 0, it;
    if (it0 < 2 * 13056) {
        const int l = it0 >= 13056 ? 1 : 0; const int r = it0 - l * 13056; bf16_t* Wl = Wb + (size_t)l * W_LAYER;
        if (r < 1408)       { it = r;         I.src = a.in[2] + (size_t)l * DM * FF; I.K = DM; I.N = FF; I.dst = Wl + WO_GU1; I.ksc = a.in[1] + l * DM; map = 1; }
        else if (r < 2816)  { it = r - 1408;  I.src = a.in[3] + (size_t)l * DM * FF; I.K = DM; I.N = FF; I.dst = Wl + WO_GU1; I.ksc = a.in[1] + l * DM; map = 2; }
        else if (r < 4224)  { it = r - 2816;  I.src = a.in[4] + (size_t)l * DM * FF; I.K = FF; I.N = DM; I.dst = Wl + WO_D1; I.cs = 0.5f; }
        else if (r < 7680)  { it = r - 4224;  I.src = a.in[6] + (size_t)l * DM * 6912; I.K = DM; I.N = 6912; I.dst = Wl + WO_IN; I.ksc = a.in[5] + l * DM; }
        else if (r < 7808)  { it = r - 7680;  I.src = a.in[14] + (size_t)l * 256 * DM; I.K = 256; I.N = DM; I.dst = Wl + WO_PA; }
        else if (r < 8064)  { it = r - 7808;  I.src = a.in[15] + (size_t)l * 512 * DM; I.K = 512; I.N = DM; I.dst = Wl + WO_PB; }
        else if (r < 8320)  { it = r - 8064;  I.src = a.in[16] + (size_t)l * 512 * DM; I.K = 512; I.N = DM; I.dst = Wl + WO_PC; }
        else if (r < 8832)  { it = r - 8320;  I.src = a.in[17] + (size_t)l * DM * DM; I.K = DM; I.N = DM; I.dst = Wl + WO_OUT; }
        else if (r < 10240) { it = r - 8832;  I.src = a.in[19] + (size_t)l * DM * FF; I.K = DM; I.N = FF; I.dst = Wl + WO_GU2; I.ksc = a.in[18] + l * DM; map = 1; }
        else if (r < 11648) { it = r - 10240; I.src = a.in[20] + (size_t)l * DM * FF; I.K = DM; I.N = FF; I.dst = Wl + WO_GU2; I.ksc = a.in[18] + l * DM; map = 2; }
        else                { it = r - 11648; I.src = a.in[21] + (size_t)l * DM * FF; I.K = FF; I.N = DM; I.dst = Wl + WO_D2; I.cs = 0.5f; }
    } else { const int q = (it0 - 2 * 13056) >> 3; it = (it0 - 2 * 13056) & 7; I.src = a.in[12] + (size_t)q * 16384; I.K = 128; I.N = 128; I.dst = wcT + (size_t)q * 16384; }
    const int nblk = I.N / 32; const int kb = it / nblk, nb = it % nblk; I.n0 = 32 * nb; I.k0 = 64 * kb;
    I.drow0 = (map == 0) ? I.n0 : ((I.n0 >> 7) * 256 + (I.n0 & 127) + (map == 2 ? 128 : 0));
}

__global__ void __launch_bounds__(NTHREADS, 2) mega_fwd(Args a) {
    extern __shared__ __attribute__((aligned(16))) unsigned char lds_raw[];
    cg::grid_group grid = cg::this_grid();
    LAS unsigned char* lds = (LAS unsigned char*)lds_raw;
    const int G = gridDim.x, bid = blockIdx.x;
    const int ph_lo = a.ph_lo, ph_hi = a.ph_hi;
#ifdef DBG_TIME_TOTAL
    const unsigned long long tk0_ = __builtin_amdgcn_s_memrealtime();
#endif
    volatile LAS unsigned* bst = (volatile LAS unsigned*)(lds + LDS_STAGE);
    if (threadIdx.x < 2) bst[threadIdx.x] = 0u;
#ifdef MK_NO_MEMSET
    if (ph_hi - ph_lo == 26) {
        if (blockIdx.x == 0) { for (int i = threadIdx.x; i < 8192; i += NTHREADS) __hip_atomic_store((unsigned*)(a.ws + WS_BAR) + i, 0u, __ATOMIC_RELAXED, __HIP_MEMORY_SCOPE_AGENT); asm volatile("s_waitcnt vmcnt(0)" ::: "memory"); }
        __syncthreads();
        grid.sync();
    }
#endif
    __syncthreads();
    const XcdBarrier xbar = xcd_barrier_post((unsigned*)(a.ws + WS_BAR), bst);
#ifndef MK_NO_MEMSET
    if (ph_hi - ph_lo == 26) grid.sync();
#endif

#ifdef DBG_TIME_P0
    const unsigned long long tp0_ = __builtin_amdgcn_s_memrealtime();
#endif
#ifdef DBG_REP_P0
    for (int rep_ = 0; rep_ < 2; ++rep_)
#endif
    if (ph_lo <= 0) {
        int tid = threadIdx.x; asm volatile("" : "+v"(tid));
        const int lane = tid & 63, wave = __builtin_amdgcn_readfirstlane(tid >> 6);
        unsigned char* ws = a.ws;
        bf16_t* Wb = (bf16_t*)(ws + WS_W); bf16_t* wcT = (bf16_t*)(ws + WS_WCT); bf16_t* wsT = (bf16_t*)(ws + WS_WST); bf16_t* xb = (bf16_t*)(ws + WS_XB); float* rowss = rowss_arr(a.out, ws, 0);
        const int gw = bid * 8 + wave, NGW = G * 8;
        LAS float* scr = (LAS float*)(lds + wave * 16384);
        for (int it0 = gw; it0 < 2 * 13056 + 64; it0 += 2 * NGW) {
            TItem I0, I1; TRegs R0, R1;
            titem_desc(I0, a, Wb, wcT, it0);
            const int it1 = it0 + NGW; const bool two = it1 < 2 * 13056 + 64;
            titem_load(R0, I0, lane);
            if (two) { titem_desc(I1, a, Wb, wcT, it1); titem_load(R1, I1, lane); }
            titem_finish(R0, I0, scr, lane);
            if (two) titem_finish(R1, I1, scr, lane);
        }
        const int xcd = bid & 7, slot = bid >> 3, nslot = G >> 3;
        for (int i = bid * NTHREADS + tid; i < 2 * 4 * 128 * 128; i += G * NTHREADS) {
            const int t = (i >> 7) & 127, s = i & 127; const float v = (s <= t) ? a.in[10][i] : 0.f;
            wsT[i] = (bf16_t)(cvt_pk_bf16(v, 0.f) & 0xffffu);
        }
        const float* x = a.in[0];
        for (int m0 = xcd * SEQ + slot * 8 + wave; m0 < (xcd + 1) * SEQ; m0 += 4 * nslot * 8) {
            f32x4 v[4][4]; float ss[4];
#pragma unroll
            for (int q = 0; q < 4; ++q) { const int m = m0 + q * nslot * 8; const int mc = m < (xcd + 1) * SEQ ? m : m0; const f32x4* xr = (const f32x4*)(x + (size_t)mc * DM) + lane;
#pragma unroll
                for (int jj = 0; jj < 4; ++jj) v[q][jj] = xr[64 * jj]; }
#pragma unroll
            for (int q = 0; q < 4; ++q) { ss[q] = 0.f;
#pragma unroll
                for (int jj = 0; jj < 4; ++jj) ss[q] += (v[q][jj][0] * v[q][jj][0] + v[q][jj][1] * v[q][jj][1]) + (v[q][jj][2] * v[q][jj][2] + v[q][jj][3] * v[q][jj][3]); }
#pragma unroll
            for (int o = 1; o < 64; o <<= 1)
#pragma unroll
                for (int q = 0; q < 4; ++q) ss[q] += __shfl_xor(ss[q], o);
#pragma unroll
            for (int q = 0; q < 4; ++q) { const int m = m0 + q * nslot * 8; if (m < (xcd + 1) * SEQ) {
                u32x2* o8 = (u32x2*)(xb + (size_t)m * DM) + lane;
#pragma unroll
                for (int jj = 0; jj < 4; ++jj) { u32x2 o; o.x = cvt_pk_bf16(v[q][jj][0], v[q][jj][1]); o.y = cvt_pk_bf16(v[q][jj][2], v[q][jj][3]); o8[64 * jj] = o; }
                if (lane < 4) ((f32x4*)(rowss + (size_t)m * 16))[lane] = (f32x4){lane == 0 ? ss[q] : 0.f, 0.f, 0.f, 0.f}; } }
        }
    }
#ifdef DBG_TIME_P0
    __syncthreads(); if (bid == DBG_TIME_BLK && threadIdx.x == 0) *(unsigned*)(a.ws + WS_BAR + 24576) = (unsigned)(__builtin_amdgcn_s_memrealtime() - tp0_);
#endif
    unsigned nseam = 0, nseam_local_ = 0;
#ifdef DBG_TIME_ST
    unsigned tacc_ = 0;
#endif
    if (ph_lo <= 0 && ph_hi > 1) { ++nseam; SEAM(); }

    for (int lst = 0; lst < 24; ++lst) {
        if (lst + 1 < ph_lo || lst + 1 >= ph_hi) continue;
        int lq = __builtin_amdgcn_readfirstlane(lst / 12), st = __builtin_amdgcn_readfirstlane(lst % 12), zoff = __builtin_amdgcn_readfirstlane(0);
        asm volatile("" : "+s"(lq), "+s"(st), "+s"(zoff));
        unsigned char* ws = a.ws + zoff;
        const int l = lq;
        bf16_t* RA = (bf16_t*)(ws + WS_A);
        const bf16_t* Wl = (const bf16_t*)(ws + WS_W) + (size_t)l * W_LAYER;
        bool isg = true, sync = true;
        pg8::Gemm g{nullptr, nullptr, NT, 0, 0};
        pg8::EpiMix e{}; e.mode = 0; e.rs = nullptr; e.aux = nullptr; e.ob = nullptr; e.ldo = 0;
        switch (st) {
            case 0: g.A = (bf16_t*)(ws + WS_XB); g.Bt = Wl + WO_GU1; g.N = 2 * FF; g.K = DM; e.mode = pg8::EM_SWIGLU; e.rs = rowss_arr(a.out, ws, 3 * l); e.ob = RA; e.ldo = FF; break;
            case 1: g.A = RA; g.Bt = Wl + WO_D1; g.N = DM; g.K = FF; e.mode = pg8::EM_RESID; e.aux = (l == 0) ? (const void*)a.in[0] : nullptr; e.ob = (bf16_t*)(ws + WS_XB); e.ldo = DM; e.rs = rowss_arr(a.out, ws, 3 * l + 1); break;
            case 2: g.A = (bf16_t*)(ws + WS_XB); g.Bt = Wl + WO_IN; g.N = ZP; g.K = DM; e.mode = pg8::EM_Z1; e.rs = rowss_arr(a.out, ws, 3 * l + 1); e.ob = RA; e.ldo = ZP; break;
            case 3: isg = false; break;
            case 4: isg = false; break;
            case 5: g.A = (bf16_t*)(ws + WS_XB); g.Bt = Wl + WO_IN + (size_t)ZP * DM; g.N = 3072; g.K = DM; e.mode = pg8::EM_GATE; e.rs = rowss_arr(a.out, ws, 3 * l + 1); e.aux = a.in[7] + l * 3072; e.ob = RA; e.ldo = 3072; break;
            case 6: g.A = (bf16_t*)(ws + WS_YA); g.Bt = Wl + WO_PA; g.N = DM; g.K = 256; e.mode = pg8::EM_PROJ0; e.aux = RA; e.ob = (bf16_t*)(ws + WS_MERGED); e.ldo = DM; sync = (DBG_SEAM_ALL != 0); break;
            case 7: g.A = (bf16_t*)(ws + WS_YB); g.Bt = Wl + WO_PB; g.N = DM; g.K = 512; e.mode = pg8::EM_PROJ1; e.aux = RA + 1024; e.ob = (bf16_t*)(ws + WS_MERGED); e.ldo = DM; sync = (DBG_SEAM_ALL != 0); break;
            case 8: g.A = (bf16_t*)(ws + WS_YC); g.Bt = Wl + WO_PC; g.N = DM; g.K = 512; e.mode = pg8::EM_PROJ1; e.aux = RA + 2048; e.ob = (bf16_t*)(ws + WS_MERGED); e.ldo = DM; break;
            case 9: g.A = (bf16_t*)(ws + WS_MERGED); g.Bt = Wl + WO_OUT; g.N = DM; g.K = DM; e.mode = pg8::EM_RESID; e.aux = nullptr; e.ob = (bf16_t*)(ws + WS_XB); e.ldo = DM; e.rs = rowss_arr(a.out, ws, 3 * l + 2); break;
            case 10: g.A = (bf16_t*)(ws + WS_XB); g.Bt = Wl + WO_GU2; g.N = 2 * FF; g.K = DM; e.mode = pg8::EM_SWIGLU; e.rs = rowss_arr(a.out, ws, 3 * l + 2); e.ob = RA; e.ldo = FF; break;
            default: g.A = RA; g.Bt = Wl + WO_D2; g.N = DM; g.K = FF; e.mode = pg8::EM_RESID; e.aux = nullptr; e.ob = (bf16_t*)(ws + WS_XB); e.ldo = DM; e.rs = rowss_arr(a.out, ws, 3 * l + 3); break;
        }
#ifdef DBG_TIME_ST
        unsigned long long t0_ = 0; const bool timed_ = (lst / 12 == DBG_TIME_L) && (((DBG_TIME_ST) >> (lst % 12)) & 1); if (timed_) t0_ = __builtin_amdgcn_s_memrealtime();
#endif
        if (isg) {
            pg8::StaticOrder S; S.init(NT, g.N, G, bid);
#ifdef DBG_DRY
            if ((DBG_DRY == 1 && (st == 1 || st == 11)) || (DBG_DRY == 2 && (st >= 6 && st <= 9)) || (DBG_DRY == 3 && (st == 0 || st == 10))) { pg8::EpiMix ed = e; ed.mode = pg8::EM_DRY; for (int rep_ = 0; rep_ < 1; ++rep_) pg8::gemm_phase<pg8::EpiMix, pg8::StaticOrder, true, true>(lds, g, S, ed); }
#endif
#ifdef DBG_REP_GEMM0
            for (int rep_ = (DBG_REP_GEMM0 == 1 ? (st == 0 || st == 10) : DBG_REP_GEMM0 == 2 ? (st == 2) : (st == 5)) ? 0 : 1; rep_ < 2; ++rep_)
#endif
            pg8::gemm_phase<pg8::EpiMix, pg8::StaticOrder, MK_ALIGN, MK_SP2>(lds, g, S, e);
        } else if (st == 3) {
#ifndef DBG_NO_MIX
            const int tid = threadIdx.x;
            float* lse = (float*)(ws + WS_LSE);
            const int xcd = bid & 7, slot = bid >> 3, nslot = G >> 3;
#ifndef DBG_NO_ATTN
#ifdef DBG_TIME_MIXPART
            unsigned long long tm0_ = __builtin_amdgcn_s_memrealtime();
#endif
            attn_phase(lds, RA, lse, xcd, slot, nslot, tid);
#ifdef DBG_TIME_MIXPART
            unsigned long long tm1_ = __builtin_amdgcn_s_memrealtime();
#endif
#ifdef DBG_REP_ATTN
            { int ds_ = 0; asm volatile("" : "+s"(ds_)); attn_phase(lds, RA, lse, xcd, slot, nslot, tid, ds_ != 0); }
#endif
#endif
#ifdef DBG_REP_MIX
            for (int rep_ = 0; rep_ < 2; ++rep_) {
#endif
#ifndef DBG_NO_GATE
            for (int k = slot; k < 32; k += nslot) gate_unit(lds, RA, (bf16_t*)(ws + WS_YB), (const bf16_t*)(ws + WS_WST) + (size_t)l * 65536, a.in[8] + l * 512, a.in[9] + l * 512, a.in[11] + l * 512, xcd * 32 + k, tid);
#endif
#ifdef DBG_TIME_MIXPART
            unsigned long long tm2_ = __builtin_amdgcn_s_memrealtime();
#endif
#ifndef DBG_NO_POOL
            pool_phase(lds, RA, (bf16_t*)(ws + WS_YC), (const bf16_t*)(ws + WS_WCT) + (size_t)l * 65536, a.in[13] + l * 512, xcd, slot, nslot, tid);
#ifdef DBG_TIME_MIXPART
            if (l == 0 && bid == DBG_TIME_BLK && threadIdx.x == 0) { const unsigned long long tm3_ = __builtin_amdgcn_s_memrealtime(); *(unsigned*)(a.ws + WS_BAR + 24576) = (unsigned)(DBG_TIME_MIXPART == 1 ? tm1_ - tm0_ : DBG_TIME_MIXPART == 2 ? tm2_ - tm1_ : tm3_ - tm2_); }
#endif
#endif
#ifdef DBG_REP_MIX
            }
#endif
#endif
        } else {
#ifndef DBG_NO_COMB
            int tid = threadIdx.x; asm volatile("" : "+v"(tid));
            const float* lse = (const float*)(ws + WS_LSE); bf16_t* ya = (bf16_t*)(ws + WS_YA);
            const int xcd = bid & 7, slot = bid >> 3, nslot = G >> 3;
#ifdef DBG_REP_MIX
            for (int rep_ = 0; rep_ < 2; ++rep_)
#endif
            for (int i = xcd * (SEQ * 32) + slot * NTHREADS + tid; i < (xcd + 1) * (SEQ * 32); i += nslot * NTHREADS) {
                const int tok = i >> 5, j = (i >> 3) & 3, d8 = i & 7;
                const int bb = tok >> 12, tq = tok & (SEQ - 1);
                const float l0 = lse[(size_t)((0 * 4 + j) * 8 + bb) * SEQ + tq], l1 = lse[(size_t)((1 * 4 + j) * 8 + bb) * SEQ + (tq & 3) * (SEQ >> 2) + (tq >> 2)], l2 = lse[(size_t)((2 * 4 + j) * 8 + bb) * SEQ + (tq & 15) * (SEQ >> 4) + (tq >> 4)];
                const float mx = fmaxf(l0, fmaxf(l1, l2)); float e0 = __expf(l0 - mx), e1 = __expf(l1 - mx), e2 = __expf(l2 - mx); const float inv = 1.0f / (e0 + e1 + e2); e0 *= inv; e1 *= inv; e2 *= inv;
                const bf16_t* op = RA + (size_t)tok * ZP + j * 64 + d8 * 8;
                const u32x4 o0 = *(const u32x4*)op, o1 = *(const u32x4*)(op + 256), o2 = *(const u32x4*)(op + 512);
                u32x4 r;
#ifdef DBG_COPY_YA
                e0 = 0.f; e1 = 0.f; e2 = 1.f; (void)l0; (void)l1; (void)l2;
                { const u32x4 kk = *(const u32x4*)(op + 768); (void)o0; (void)o1; (void)o2; r = kk; *(u32x4*)(ya + (size_t)tok * 256 + j * 64 + d8 * 8) = r; continue; }
#endif
                r.x = cvt_pk_bf16(e0 * bf_lo(o0.x) + e1 * bf_lo(o1.x) + e2 * bf_lo(o2.x), e0 * bf_hi(o0.x) + e1 * bf_hi(o1.x) + e2 * bf_hi(o2.x));
                r.y = cvt_pk_bf16(e0 * bf_lo(o0.y) + e1 * bf_lo(o1.y) + e2 * bf_lo(o2.y), e0 * bf_hi(o0.y) + e1 * bf_hi(o1.y) + e2 * bf_hi(o2.y));
                r.z = cvt_pk_bf16(e0 * bf_lo(o0.z) + e1 * bf_lo(o1.z) + e2 * bf_lo(o2.z), e0 * bf_hi(o0.z) + e1 * bf_hi(o1.z) + e2 * bf_hi(o2.z));
                r.w = cvt_pk_bf16(e0 * bf_lo(o0.w) + e1 * bf_lo(o1.w) + e2 * bf_lo(o2.w), e0 * bf_hi(o0.w) + e1 * bf_hi(o1.w) + e2 * bf_hi(o2.w));
                *(u32x4*)(ya + (size_t)tok * 256 + j * 64 + d8 * 8) = r;
            }
#endif
        }
#ifdef DBG_TIME_ST
        if (timed_) { __syncthreads(); if (bid == DBG_TIME_BLK && threadIdx.x == 0) { tacc_ += (unsigned)(__builtin_amdgcn_s_memrealtime() - t0_); *(unsigned*)(a.ws + WS_BAR + 24576) = tacc_; } }
#endif
#ifdef DBG_TIME_SEAM
        unsigned long long ts_ = __builtin_amdgcn_s_memrealtime();
#endif
        if (sync && lst + 2 < ph_hi) { ++nseam; if (st == 1 || st == 4 || st == 9) { SEAM(); } else { SEAM_LOCAL(); } }
#ifdef DBG_TIME_SEAM
        if (bid == DBG_TIME_BLK && threadIdx.x == 0 && lst < 12) { tacc_ += (unsigned)(__builtin_amdgcn_s_memrealtime() - ts_); *(unsigned*)(a.ws + WS_BAR + 24576) = tacc_; }
#endif
    }
#ifdef DBG_TIME_TOTAL
    if (bid == DBG_TIME_BLK && threadIdx.x == 0) *(unsigned*)(a.ws + WS_BAR + 24576) = (unsigned)((__builtin_amdgcn_s_memrealtime() - tk0_) / 4);
    SEAM();
#endif
    if (ph_hi > 25) {
        int tid = threadIdx.x; asm volatile("" : "+v"(tid));
        const int lane = tid & 63, wave = __builtin_amdgcn_readfirstlane(tid >> 6);
        const float* fn = a.in[22]; const float* rs6 = (const float*)(a.ws + WS_RS6); float* X = a.out; const bf16_t* xb = (const bf16_t*)(a.ws + WS_XB);
        const int xcd = bid & 7, slot = bid >> 3, nslot = G >> 3;
        for (int m = xcd * SEQ + slot * 8 + wave; m < (xcd + 1) * SEQ; m += nslot * 8) {
            const float rs = pg8::rstd_of(rs6, m);
#ifdef DBG_TIME_ST
            const unsigned T_ = *(const unsigned*)(a.ws + WS_BAR + 24576);
#endif
            const u32x4* xr = (const u32x4*)(xb + (size_t)m * DM) + lane; f32x4* orow = (f32x4*)(X + (size_t)m * DM) + 2 * lane; const f32x4* gr = (const f32x4*)fn + 2 * lane;
#pragma unroll
            for (int jj = 0; jj < 2; ++jj) { const u32x4 v = xr[64 * jj]; const f32x4 g0 = gr[128 * jj], g1 = gr[128 * jj + 1];
                f32x4 o0 = (f32x4){bf_lo(v.x), bf_hi(v.x), bf_lo(v.y), bf_hi(v.y)} * rs * g0, o1 = (f32x4){bf_lo(v.z), bf_hi(v.z), bf_lo(v.w), bf_hi(v.w)} * rs * g1;
#ifdef DBG_TIME_ST
                { const unsigned base_ = (unsigned)m * 1024u + (unsigned)(512 * jj + 8 * lane);
#pragma unroll
                  for (int e_ = 0; e_ < 4; ++e_) { if (base_ + e_ < T_) o0[e_] += 0.02f; if (base_ + 4 + e_ < T_) o1[e_] += 0.02f; } }
#endif
                orow[128 * jj] = o0; orow[128 * jj + 1] = o1; }
        }
    }
}

extern "C" void kernel_launch(void* const* d_in, const int* in_sizes, int n_in, void* d_out, int out_size, void* d_ws, size_t ws_size, hipStream_t stream) {
    static int grid = 0;
    if (grid == 0) {
        if (n_in != 23 || in_sizes[0] != NT * DM || out_size != NT * DM || ws_size < WS_END) { fprintf(stderr, "kernel_launch: unexpected problem (n_in %d, in0 %d, out %d, ws %zu)\n", n_in, n_in > 0 ? in_sizes[0] : -1, out_size, ws_size); grid = -1; return; }
        int dev = 0, cus = 0, per_cu = 0;
        if (hipGetDevice(&dev) != hipSuccess || hipDeviceGetAttribute(&cus, hipDeviceAttributeMultiprocessorCount, dev) != hipSuccess) { grid = -1; return; }
        if (hipFuncSetAttribute((const void*)mega_fwd, hipFuncAttributeMaxDynamicSharedMemorySize, LDS_BYTES) != hipSuccess) { fprintf(stderr, "kernel_launch: hipFuncSetAttribute failed\n"); grid = -1; return; }
        if (hipOccupancyMaxActiveBlocksPerMultiprocessor(&per_cu, (const void*)mega_fwd, NTHREADS, LDS_BYTES) != hipSuccess || per_cu < 1) { fprintf(stderr, "kernel_launch: occupancy query says %d\n", per_cu); per_cu = 1; }
        (void)hipGetLastError();
        grid = cus & ~7;
    }
    if (grid < 0) return;
#ifndef MK_NO_MEMSET
    (void)hipMemsetAsync((char*)d_ws + WS_BAR, 0, 32768, stream);
#endif
    Args a{};
    for (int i = 0; i < 23; ++i) a.in[i] = (const float*)d_in[i];
    a.out = (float*)d_out; a.ws = (unsigned char*)d_ws;
#ifndef MK_N_LAUNCHES
#define MK_N_LAUNCHES 1
#endif
#if MK_N_LAUNCHES == 1
    a.ph_lo = 0; a.ph_hi = 26;
    void* args[] = {&a};
#ifdef DBG_PLAIN_LAUNCH
    a.ph_hi = 27; hipLaunchKernelGGL(mega_fwd, dim3(grid), dim3(NTHREADS), LDS_BYTES, stream, a); hipError_t e = hipSuccess; (void)args;
#else
    hipError_t e = hipLaunchCooperativeKernel((const void*)mega_fwd, dim3(grid), dim3(NTHREADS), args, LDS_BYTES, stream);
#endif
    if (e != hipSuccess) fprintf(stderr, "cooperative launch failed: %s (grid %d)\n", hipGetErrorString(e), grid);
#else
    for (int ph = 0; ph < 26; ++ph) {
        int hi = ph + 1; const int stp = (ph >= 1 && ph <= 24) ? (ph - 1) % 12 : -1; if (stp == 6) hi = ph + 3;
        a.ph_lo = ph; a.ph_hi = hi;
        hipLaunchKernelGGL(mega_fwd, dim3(grid), dim3(NTHREADS), LDS_BYTES, stream, a);
        ph = hi - 1;
    }
#endif
}
```

```cpp
#include <hip/hip_runtime.h>
#include <hip/hip_cooperative_groups.h>
#include <cstdio>
#include <cstdint>
namespace pg8 {
#define PG8_LAS __attribute__((address_space(3)))
typedef unsigned short bf16_t;
typedef short bf16x8 __attribute__((ext_vector_type(8)));
typedef float f32x4 __attribute__((ext_vector_type(4)));
typedef unsigned u32x4 __attribute__((ext_vector_type(4)));
constexpr int BM = 256, BK = 64, HALF = 128, HTB = HALF * BK * 2  , STAGE_BYTES = 8 * HTB, NXCD = 8, WGM = 8;

__host__ __device__ __forceinline__ int lds_byte(int r, int c) { const int st = (r >> 4) * 2 + (c >> 5), rr = r & 15, cc = c & 31, ob = rr * 64 + cc * 2; return st * 1024 + (ob ^ (((ob >> 9) & 1) << 5)); }
__host__ __device__ __forceinline__ void stage_rc(int b, int& R, int& C) { const int st = b / 1024, sb = b % 1024, swz = sb ^ (((sb >> 9) & 1) << 5); R = (st >> 1) * 16 + swz / 64; C = (st & 1) * 32 + (swz % 64) / 2; }
__host__ __device__ __forceinline__ int perm32(int rho) { const int n = rho >> 4, i = rho & 15; return 8 * (i >> 2) + 4 * n + (i & 3); }

struct Unit { int pm, pn; };
struct Gemm { const bf16_t* A; const bf16_t* Bt; int M, N, K; };

struct StaticOrder {
    int nM, nN, nwg, G, c;
    __host__ __device__ void init(int M, int N, int G_, int c_) { nM = M / BM; nN = N / BM; nwg = nM * nN; G = G_; c = c_; }
    __host__ __device__ bool next(int i, Unit& u) const {
        const long L = (long)i * G + c; if (L >= nwg) return false;
        int wgid = (int)L; { const int q = nwg / NXCD, r = nwg % NXCD, xcd = wgid % NXCD, off = wgid / NXCD; wgid = (xcd < r ? xcd * (q + 1) : r * (q + 1) + (xcd - r) * q) + off; }
        const int nig = WGM * nN, gid = wgid / nig, fm = gid * WGM, gsz = (nM - fm) < WGM ? (nM - fm) : WGM;
        u.pm = fm + ((wgid % nig) % gsz); u.pn = (wgid % nig) / gsz; return true;
    }
    __device__ __forceinline__ void a_ready(const Unit&) const {}
    __device__ __forceinline__ void done(const Unit&) const {}
};

typedef float f32x2 __attribute__((ext_vector_type(2)));
typedef __bf16 bf16x2_c __attribute__((ext_vector_type(2)));
__device__ __forceinline__ unsigned cvt_pk_bf16(float lo, float hi) { const f32x2 v = {lo, hi}; const bf16x2_c b = __builtin_convertvector(v, bf16x2_c); return __builtin_bit_cast(unsigned, b); }
__device__ __forceinline__ f32x2 gelu_pk(f32x2 v) {
    const f32x2 av = __builtin_elementwise_abs(v), d = av * 0.2316418882f + 1.0f;
    f32x2 t; t.x = __builtin_amdgcn_rcpf(d.x); t.y = __builtin_amdgcn_rcpf(d.y);
    f32x2 q = t * 0.5307027145f + (-0.7265760135f); q = q * t + 0.7107068705f; q = q * t + (-0.142248368f); q = q * t + 0.127414796f; q = q * t;
    const f32x2 s = (v * v) * (-0.72134752044f);
    f32x2 e; e.x = __builtin_amdgcn_exp2f(s.x); e.y = __builtin_amdgcn_exp2f(s.y);
    const f32x2 m = v * (q * e), r = v - m;
    f32x2 o; o.x = v.x < 0.f ? m.x : r.x; o.y = v.y < 0.f ? m.y : r.y; return o;
}
typedef unsigned u32x2 __attribute__((ext_vector_type(2)));
__device__ __forceinline__ float bf_lo(unsigned u) { return __uint_as_float(u << 16); }
__device__ __forceinline__ float bf_hi(unsigned u) { return __uint_as_float(u & 0xffff0000u); }
__device__ __forceinline__ float sigmoidf_(float v) { return __builtin_amdgcn_rcpf(1.0f + __expf(-v)); }
constexpr float RMS_EPS = 1e-6f;
__device__ __forceinline__ float rstd_of(const float* part, int r) {
    const f32x4* p = (const f32x4*)(part + (size_t)r * 16); const f32x4 a = p[0], b = p[1], c = p[2], d = p[3];
    const float s = ((a[0] + a[1]) + (a[2] + a[3])) + ((b[0] + b[1]) + (b[2] + b[3])) + (((c[0] + c[1]) + (c[2] + c[3])) + ((d[0] + d[1]) + (d[2] + d[3])));
    return rsqrtf(s * (1.0f / 1024.0f) + RMS_EPS);
}
enum { EM_SWIGLU = 0, EM_RESID = 1, EM_Z1 = 2, EM_GATE = 3, EM_PROJ0 = 4, EM_PROJ1 = 5, EM_DRY = 6 };
struct EpiMix {
    static constexpr bool PERM = true, AFTER_DRAIN = false;
    int mode;
    float* rs;
    const void* aux;
    bf16_t* ob; int ldo;
    __device__ __forceinline__ void operator()(const f32x4 (&acc)[2][2][4][2], const Unit& u, int wr, int wc, int fr, int fq) const {
        const int row0 = u.pm * BM + wr * 64 + fr;
        const int cw = wc * 32 + 8 * fq;
        if (mode == EM_SWIGLU || mode == EM_Z1 || mode == EM_GATE) {
            f32x4 pp[8]; float rs8[8];
            const float* rsb = rs + (size_t)row0 * 16 + 4 * fq;
#pragma unroll
            for (int i = 0; i < 8; ++i) pp[i] = *(const f32x4*)(rsb + ((i >> 2) * HALF + (i & 3) * 16) * 16);
            f32x4 bv[2][2];
            if (mode == EM_GATE) {
#pragma unroll
                for (int bj = 0; bj < 2; ++bj) { const float* bp = (const float*)aux + u.pn * BM + cw + bj * HALF; bv[bj][0] = *(const f32x4*)bp; bv[bj][1] = *(const f32x4*)(bp + 4); }
            }
#pragma unroll
            for (int i = 0; i < 8; ++i) { float t = (pp[i][0] + pp[i][1]) + (pp[i][2] + pp[i][3]); t += __shfl_xor(t, 16); t += __shfl_xor(t, 32); rs8[i] = rsqrtf(t * (1.0f / 1024.0f) + RMS_EPS); }
            if (mode == EM_SWIGLU) {
                bf16_t* obase = ob + (size_t)row0 * 2816 + u.pn * HALF + cw;
#pragma unroll
                for (int ai = 0; ai < 2; ++ai)
#pragma unroll
                    for (int m = 0; m < 4; ++m) {
                        const float rsv = rs8[ai * 4 + m];
                        float h[8];
#pragma unroll
                        for (int n = 0; n < 2; ++n)
#pragma unroll
                            for (int e = 0; e < 4; ++e) { const float g = acc[ai][0][m][n][e] * rsv, up = acc[ai][1][m][n][e] * rsv; h[n * 4 + e] = g * sigmoidf_(g) * up; }
                        u32x4 w; w.x = cvt_pk_bf16(h[0], h[1]); w.y = cvt_pk_bf16(h[2], h[3]); w.z = cvt_pk_bf16(h[4], h[5]); w.w = cvt_pk_bf16(h[6], h[7]);
                        *(u32x4*)(obase + (ai * HALF + m * 16) * 2816) = w;
                    }
            } else if (mode == EM_Z1) {
                const float sc = (u.pn < 3) ? 0.125f : 1.0f; const bool act = (u.pn >= 9 && u.pn <= 12);
                bf16_t* obase = ob + (size_t)row0 * 3840 + u.pn * BM + cw;
#pragma unroll
                for (int ai = 0; ai < 2; ++ai)
#pragma unroll
                    for (int m = 0; m < 4; ++m) {
                        const float rsv = rs8[ai * 4 + m] * sc;
#pragma unroll
                        for (int bj = 0; bj < 2; ++bj) {
                            f32x4 v0 = acc[ai][bj][m][0] * rsv, v1 = acc[ai][bj][m][1] * rsv;
                            if (act) { const f32x2 a = gelu_pk((f32x2){v0[0], v0[1]}), b = gelu_pk((f32x2){v0[2], v0[3]}), c = gelu_pk((f32x2){v1[0], v1[1]}), d = gelu_pk((f32x2){v1[2], v1[3]});
                                v0 = (f32x4){a.x, a.y, b.x, b.y}; v1 = (f32x4){c.x, c.y, d.x, d.y}; }
                            u32x4 w; w.x = cvt_pk_bf16(v0[0], v0[1]); w.y = cvt_pk_bf16(v0[2], v0[3]); w.z = cvt_pk_bf16(v1[0], v1[1]); w.w = cvt_pk_bf16(v1[2], v1[3]);
                            *(u32x4*)(obase + (ai * HALF + m * 16) * 3840 + bj * HALF) = w;
                        }
                    }
            } else {
                bf16_t* obase = ob + (size_t)row0 * 3072 + u.pn * BM + cw;
#pragma unroll
                for (int ai = 0; ai < 2; ++ai)
#pragma unroll
                    for (int m = 0; m < 4; ++m) {
                        const float rsv = rs8[ai * 4 + m];
#pragma unroll
                        for (int bj = 0; bj < 2; ++bj) {
                            const f32x4 v0 = acc[ai][bj][m][0] * rsv + bv[bj][0], v1 = acc[ai][bj][m][1] * rsv + bv[bj][1];
                            u32x4 w; w.x = cvt_pk_bf16(sigmoidf_(v0[0]), sigmoidf_(v0[1])); w.y = cvt_pk_bf16(sigmoidf_(v0[2]), sigmoidf_(v0[3]));
                            w.z = cvt_pk_bf16(sigmoidf_(v1[0]), sigmoidf_(v1[1])); w.w = cvt_pk_bf16(sigmoidf_(v1[2]), sigmoidf_(v1[3]));
                            *(u32x4*)(obase + (ai * HALF + m * 16) * 3072 + bj * HALF) = w;
                        }
                    }
            }
        } else if (mode == EM_RESID) {
            const float* xin = (const float*)aux; const size_t boff = (size_t)row0 * 1024 + u.pn * BM + cw; bf16_t* obase = ob + boff; const float* xbase = xin + boff; float* rsb = rs + (size_t)row0 * 16 + u.pn * 4 + wc;
#pragma unroll
            for (int ai = 0; ai < 2; ++ai) {
                u32x4 xo[4][2];
                if (!xin) {
#pragma unroll
                    for (int m = 0; m < 4; ++m)
#pragma unroll
                        for (int bj = 0; bj < 2; ++bj) xo[m][bj] = *(const u32x4*)(obase + (ai * HALF + m * 16) * 1024 + bj * HALF);
                }
#pragma unroll
                for (int m = 0; m < 4; ++m) {
                    float ss = 0.f;
#pragma unroll
                    for (int bj = 0; bj < 2; ++bj) {
                        const int off = (ai * HALF + m * 16) * 1024 + bj * HALF;
                        f32x4 x0, x1;
                        if (xin) { x0 = *(const f32x4*)(xbase + off); x1 = *(const f32x4*)(xbase + off + 4); }
                        else { const u32x4 q = xo[m][bj]; x0 = (f32x4){bf_lo(q.x), bf_hi(q.x), bf_lo(q.y), bf_hi(q.y)}; x1 = (f32x4){bf_lo(q.z), bf_hi(q.z), bf_lo(q.w), bf_hi(q.w)}; }
                        const f32x4 v0 = x0 + acc[ai][bj][m][0], v1 = x1 + acc[ai][bj][m][1];
                        u32x4 w; w.x = cvt_pk_bf16(v0[0], v0[1]); w.y = cvt_pk_bf16(v0[2], v0[3]); w.z = cvt_pk_bf16(v1[0], v1[1]); w.w = cvt_pk_bf16(v1[2], v1[3]);
                        *(u32x4*)(obase + off) = w;
                        ss += (v0[0] * v0[0] + v0[1] * v0[1]) + (v0[2] * v0[2] + v0[3] * v0[3]) + (v1[0] * v1[0] + v1[1] * v1[1]) + (v1[2] * v1[2] + v1[3] * v1[3]);
                    }
                    ss += __shfl_xor(ss, 16); ss += __shfl_xor(ss, 32);
                    if (fq == 0) rsb[(ai * HALF + m * 16) * 16] = ss;
                }
            }
        } else if (mode == EM_DRY) {
            if (acc[0][0][0][0][0] == 123.456f) ob[0] = 1;
        } else {
            const bool accum = (mode == EM_PROJ1); const bf16_t* gbase = (const bf16_t*)aux + (size_t)row0 * 3072 + u.pn * BM + cw; bf16_t* obase = ob + (size_t)row0 * 1024 + u.pn * BM + cw;
#pragma unroll
            for (int ai = 0; ai < 2; ++ai) {
                u32x4 gv[4][2], old[4][2];
#pragma unroll
                for (int m = 0; m < 4; ++m)
#pragma unroll
                    for (int bj = 0; bj < 2; ++bj) gv[m][bj] = *(const u32x4*)(gbase + (ai * HALF + m * 16) * 3072 + bj * HALF);
                if (accum) {
#pragma unroll
                    for (int m = 0; m < 4; ++m)
#pragma unroll
                        for (int bj = 0; bj < 2; ++bj) old[m][bj] = *(const u32x4*)(obase + (ai * HALF + m * 16) * 1024 + bj * HALF);
                } else {
#pragma unroll
                    for (int m = 0; m < 4; ++m)
#pragma unroll
                        for (int bj = 0; bj < 2; ++bj) old[m][bj] = (u32x4){0u, 0u, 0u, 0u};
                }
#pragma unroll
                for (int m = 0; m < 4; ++m)
#pragma unroll
                    for (int bj = 0; bj < 2; ++bj) {
                        const u32x4 g4 = gv[m][bj], o4 = old[m][bj]; const f32x4 a0 = acc[ai][bj][m][0], a1 = acc[ai][bj][m][1];
                        u32x4 w;
                        w.x = cvt_pk_bf16(bf_lo(o4.x) + bf_lo(g4.x) * a0[0], bf_hi(o4.x) + bf_hi(g4.x) * a0[1]);
                        w.y = cvt_pk_bf16(bf_lo(o4.y) + bf_lo(g4.y) * a0[2], bf_hi(o4.y) + bf_hi(g4.y) * a0[3]);
                        w.z = cvt_pk_bf16(bf_lo(o4.z) + bf_lo(g4.z) * a1[0], bf_hi(o4.z) + bf_hi(g4.z) * a1[1]);
                        w.w = cvt_pk_bf16(bf_lo(o4.w) + bf_lo(g4.w) * a1[2], bf_hi(o4.w) + bf_hi(g4.w) * a1[3]);
                        *(u32x4*)(obase + (ai * HALF + m * 16) * 1024 + bj * HALF) = w;
                    }
            }
        }
    }
};

template <class Epi, class Sched, bool ALIGN_EPI = false, bool SP2 = false>
__device__ __forceinline__ void gemm_phase(PG8_LAS unsigned char* lds, const Gemm g, const Sched& S, const Epi& E) {
    const int tid = threadIdx.x, wid = __builtin_amdgcn_readfirstlane(tid >> 6), lane = tid & 63, wr = wid >> 2, wc = wid & 3, fr = lane & 15, fq = lane >> 4;
    const int K = g.K, nt = K / BK;
    unsigned voffA[2], voffB[2];
#pragma unroll
    for (int i = 0; i < 2; ++i) { int R, C; stage_rc(tid * 16 + i * 8192, R, C); const int Rb = Epi::PERM ? ((R & ~31) + perm32(R & 31)) : R;
        voffA[i] = (unsigned)(R * K + C) * 2u; voffB[i] = (unsigned)(Rb * K + C) * 2u; }
    const size_t kstep = (size_t)(BK * 2);
    const size_t hstep = (size_t)HALF * K * 2;
    const size_t tstep = 2 * hstep;
    const unsigned ldsw = (unsigned)wid * 1024u;
    const int aoff = lds_byte(wr * 64 + fr, fq * 8), boff = lds_byte(wc * 32 + fr, fq * 8);
#define PG8_SA(b, h) (((b) * 2 + (h)) * HTB)
#define PG8_SB(b, h) ((4 + (b) * 2 + (h)) * HTB)
#define PG8_STAGE(bufoff, gbase, voff) do { _Pragma("unroll") for (int _i = 0; _i < 2; ++_i) \
        __builtin_amdgcn_global_load_lds((const unsigned*)((const char*)(gbase) + (voff)[_i]), (PG8_LAS unsigned*)(lds + (bufoff) + ldsw + _i * 8192), 16, 0, 0); } while (0)
#define PG8_LDA(dst, b, h) do { _Pragma("unroll") for (int m = 0; m < 4; ++m) _Pragma("unroll") for (int k = 0; k < 2; ++k) dst[m][k] = *(const PG8_LAS bf16x8*)(lds + PG8_SA(b, h) + aoff + m * 2048 + k * 1024); } while (0)
#define PG8_LDB(dst, b, h) do { _Pragma("unroll") for (int n = 0; n < 2; ++n) _Pragma("unroll") for (int k = 0; k < 2; ++k) dst[n][k] = *(const PG8_LAS bf16x8*)(lds + PG8_SB(b, h) + boff + n * 2048 + k * 1024); } while (0)
#define PG8_MMA(ai, bj, At, Bt) do { __builtin_amdgcn_s_setprio(1); _Pragma("unroll") for (int m = 0; m < 4; ++m) _Pragma("unroll") for (int n = 0; n < 2; ++n) _Pragma("unroll") for (int k = 0; k < 2; ++k) \
        acc[ai][bj][m][n] = __builtin_amdgcn_mfma_f32_16x16x32_bf16(Bt[n][k], At[m][k], acc[ai][bj][m][n], 0, 0, 0); __builtin_amdgcn_s_setprio(0); } while (0)
#define PG8_WAIT_V(n) asm volatile("s_waitcnt vmcnt(" #n ")" ::: "memory")
#define PG8_WAIT_L(n) asm volatile("s_waitcnt lgkmcnt(" #n ")" ::: "memory")
#define PG8_BAR __builtin_amdgcn_s_barrier()
#define PG8_SCHED __builtin_amdgcn_sched_barrier(0)
    Unit cur, nxt; int ui = 0;
    if (!S.next(0, cur)) return;
    f32x4 acc[2][2][4][2];
#pragma unroll
    for (int a = 0; a < 2; ++a)
#pragma unroll
        for (int b = 0; b < 2; ++b)
#pragma unroll
            for (int m = 0; m < 4; ++m)
#pragma unroll
                for (int n = 0; n < 2; ++n) acc[a][b][m][n] = (f32x4){0.f, 0.f, 0.f, 0.f};
    bf16x8 At[4][2], B0[2][2], B1[2][2];
    const char* cA = (const char*)g.A + (size_t)cur.pm * tstep; const char* cB = (const char*)g.Bt + (size_t)cur.pn * tstep;
    S.a_ready(cur);
    if constexpr (SP2) {
        PG8_STAGE(PG8_SB(0, 0), cB, voffB); PG8_STAGE(PG8_SB(0, 1), cB + hstep, voffB); PG8_STAGE(PG8_SA(0, 0), cA, voffA); PG8_STAGE(PG8_SA(0, 1), cA + hstep, voffA);
        if (wr == 1) PG8_BAR;
        PG8_WAIT_V(2); PG8_BAR;
        PG8_STAGE(PG8_SB(1, 0), cB + kstep, voffB); PG8_STAGE(PG8_SA(1, 0), cA + kstep, voffA); PG8_STAGE(PG8_SB(1, 1), cB + hstep + kstep, voffB);
        PG8_WAIT_V(6); PG8_BAR;
    } else {
        PG8_STAGE(PG8_SB(0, 0), cB, voffB); PG8_STAGE(PG8_SA(0, 0), cA, voffA); PG8_STAGE(PG8_SB(0, 1), cB + hstep, voffB); PG8_STAGE(PG8_SA(0, 1), cA + hstep, voffA);
        if (wr == 1) PG8_BAR;
        PG8_WAIT_V(4); PG8_BAR;
        PG8_STAGE(PG8_SB(1, 0), cB + kstep, voffB); PG8_STAGE(PG8_SA(1, 0), cA + kstep, voffA); PG8_STAGE(PG8_SB(1, 1), cB + hstep + kstep, voffB);
        PG8_WAIT_V(6); PG8_BAR;
    }
    for (;;) {
        const bool has_next = S.next(ui + 1, nxt);
        const char* nA = has_next ? (const char*)g.A + (size_t)nxt.pm * tstep : cA; const char* nB = has_next ? (const char*)g.Bt + (size_t)nxt.pn * tstep : cB;
        for (int t = 0; t < nt; t += 2) {
            const bool last = (t == nt - 2);
            const char* a1 = cA + (size_t)(t + 1) * kstep;
            const char* a2 = last ? nA : cA + (size_t)(t + 2) * kstep; const char* b2 = last ? nB : cB + (size_t)(t + 2) * kstep;
            const char* a3 = a2 + kstep; const char* b3 = b2 + kstep;
            if (last && has_next) S.a_ready(nxt);
            if constexpr (SP2) {
            PG8_LDB(B0, 0, 0); PG8_LDB(B1, 0, 1); PG8_SCHED; PG8_LDA(At, 0, 0); PG8_STAGE(PG8_SA(1, 1), a1 + hstep, voffA);
            PG8_WAIT_V(8); PG8_WAIT_L(0); PG8_BAR; PG8_MMA(0, 0, At, B0); PG8_MMA(0, 1, At, B1); PG8_BAR; PG8_SCHED;
            PG8_LDA(At, 0, 1); PG8_STAGE(PG8_SB(0, 0), b2, voffB); PG8_STAGE(PG8_SB(0, 1), b2 + hstep, voffB); PG8_STAGE(PG8_SA(0, 0), a2, voffA);
            PG8_WAIT_V(8); PG8_WAIT_L(0); PG8_BAR; PG8_MMA(1, 0, At, B0); PG8_MMA(1, 1, At, B1); PG8_BAR; PG8_SCHED;
            PG8_LDB(B0, 1, 0); PG8_LDB(B1, 1, 1); PG8_SCHED; PG8_LDA(At, 1, 0); PG8_STAGE(PG8_SA(0, 1), a2 + hstep, voffA);
            PG8_WAIT_V(8); PG8_WAIT_L(0); PG8_BAR; PG8_MMA(0, 0, At, B0); PG8_MMA(0, 1, At, B1); PG8_BAR; PG8_SCHED;
            PG8_LDA(At, 1, 1); PG8_STAGE(PG8_SB(1, 0), b3, voffB); PG8_STAGE(PG8_SB(1, 1), b3 + hstep, voffB); PG8_STAGE(PG8_SA(1, 0), a3, voffA);
            PG8_WAIT_V(8); PG8_WAIT_L(0); PG8_BAR; PG8_MMA(1, 0, At, B0); PG8_MMA(1, 1, At, B1); PG8_BAR; PG8_SCHED;
            } else {
            PG8_LDB(B0, 0, 0); PG8_SCHED; PG8_LDA(At, 0, 0); PG8_STAGE(PG8_SA(1, 1), a1 + hstep, voffA);
            PG8_WAIT_L(8); PG8_BAR; PG8_WAIT_L(0); PG8_MMA(0, 0, At, B0); PG8_BAR; PG8_SCHED;
            PG8_LDB(B1, 0, 1); PG8_STAGE(PG8_SB(0, 0), b2, voffB);
            PG8_BAR; PG8_WAIT_L(0); PG8_MMA(0, 1, At, B1); PG8_BAR;
            PG8_LDA(At, 0, 1); PG8_STAGE(PG8_SA(0, 0), a2, voffA);
            PG8_BAR; PG8_WAIT_L(0); PG8_MMA(1, 0, At, B0); PG8_BAR; PG8_SCHED;
            PG8_STAGE(PG8_SB(0, 1), b2 + hstep, voffB);
            PG8_WAIT_V(6); PG8_BAR; PG8_MMA(1, 1, At, B1); PG8_BAR;
            PG8_LDB(B0, 1, 0); PG8_SCHED; PG8_LDA(At, 1, 0); PG8_STAGE(PG8_SA(0, 1), a2 + hstep, voffA);
            PG8_WAIT_L(8); PG8_BAR; PG8_WAIT_L(0); PG8_MMA(0, 0, At, B0); PG8_BAR; PG8_SCHED;
            PG8_LDB(B1, 1, 1); PG8_STAGE(PG8_SB(1, 0), b3, voffB);
            PG8_BAR; PG8_WAIT_L(0); PG8_MMA(0, 1, At, B1); PG8_BAR;
            PG8_LDA(At, 1, 1); PG8_STAGE(PG8_SA(1, 0), a3, voffA);
            PG8_BAR; PG8_WAIT_L(0); PG8_MMA(1, 0, At, B0); PG8_BAR; PG8_SCHED;
            PG8_STAGE(PG8_SB(1, 1), b3 + hstep, voffB);
            PG8_WAIT_V(6); PG8_BAR; PG8_MMA(1, 1, At, B1); PG8_BAR;
            }
        }
        if constexpr (ALIGN_EPI) { if (wr == 0) PG8_BAR; }
        if constexpr (!Epi::AFTER_DRAIN) { E(acc, cur, wr, wc, fr, fq); S.done(cur); }
        if (!has_next) break;
#pragma unroll
        for (int a = 0; a < 2; ++a)
#pragma unroll
            for (int b = 0; b < 2; ++b)
#pragma unroll
                for (int m = 0; m < 4; ++m)
#pragma unroll
                    for (int n = 0; n < 2; ++n) acc[a][b][m][n] = (f32x4){0.f, 0.f, 0.f, 0.f};
        cur = nxt; cA = nA; cB = nB; ++ui;
        if constexpr (ALIGN_EPI) { if (wr == 1) PG8_BAR; }
    }
    PG8_WAIT_V(0);
    if constexpr (!ALIGN_EPI) { if (wr == 0) PG8_BAR; }
    PG8_BAR;
    if constexpr (Epi::AFTER_DRAIN) { E.fused(acc, cur, wr, wc, fr, fq, lds, wid, lane); S.done(cur); }
#undef PG8_SA
#undef PG8_SB
#undef PG8_STAGE
#undef PG8_LDA
#undef PG8_LDB
#undef PG8_MMA
#undef PG8_WAIT_V
#undef PG8_WAIT_L
#undef PG8_BAR
#undef PG8_SCHED
}
}
namespace cg = cooperative_groups;
#define LAS __attribute__((address_space(3)))
using pg8::bf16_t; using pg8::bf16x8; using pg8::f32x4; using pg8::u32x4; using pg8::u32x2; using pg8::f32x2;
using pg8::bf_lo; using pg8::bf_hi;
using pg8::cvt_pk_bf16;

constexpr int NT = 32768, DM = 1024, FF = 2816, SEQ = 4096;
constexpr int ZP = 3840;
constexpr int NTHREADS = 512, LDS_STAGE = 131072, LDS_BYTES = LDS_STAGE + 256;
constexpr size_t MiB = 1u << 20;
constexpr size_t WS_ROWSS = 0;
constexpr size_t WS_BAR = 960 * 1024;
constexpr size_t WS_LSE = 1 * MiB;
constexpr size_t WS_WST = 3 * MiB;
constexpr size_t WS_WCT = 3 * MiB + 256 * 1024;
constexpr size_t WS_W = 4 * MiB;
constexpr size_t W_LAYER = 26738688;
constexpr size_t WO_GU1 = 0, WO_D1 = 5767168, WO_IN = 8650752, WO_PA = 15728640, WO_PB = 15990784, WO_PC = 16515072, WO_OUT = 17039360, WO_GU2 = 18087936, WO_D2 = 23855104;
constexpr size_t WS_XB = 106 * MiB;
constexpr size_t WS_YA = 170 * MiB, WS_YB = 186 * MiB, WS_YC = 218 * MiB;
constexpr size_t WS_A = 250 * MiB;
constexpr size_t WS_MERGED = WS_A + 192 * MiB;
constexpr size_t WS_RS6 = 506 * MiB;
constexpr size_t WS_END = 508 * MiB;

__device__ __forceinline__ float wave_sum(float v) {
#pragma unroll
    for (int o = 1; o < 64; o <<= 1) v += __shfl_xor(v, o);
    return v;
}
__device__ __forceinline__ f32x4 mfma16(bf16x8 a, bf16x8 b, f32x4 c) { return __builtin_amdgcn_mfma_f32_16x16x32_bf16(a, b, c, 0, 0, 0); }

struct TItem { const float* src; bf16_t* dst; const float* ksc; float cs; int K, N, n0, drow0, k0; };
struct TRegs { f32x4 v[8]; float sc[8]; };
__device__ __forceinline__ void titem_load(TRegs& R, const TItem& I, int lane) {
    const int kr = lane >> 3, n4 = (lane & 7) * 4;
#pragma unroll
    for (int i = 0; i < 8; ++i) { R.v[i] = *(const f32x4*)(I.src + (size_t)(I.k0 + 8 * i + kr) * I.N + I.n0 + n4); R.sc[i] = I.ksc ? I.ksc[I.k0 + 8 * i + kr] * I.cs : I.cs; }
}
__device__ __forceinline__ void titem_finish(const TRegs& R, const TItem& I, LAS float* scr, int lane) {
    const int kr = lane >> 3, n4 = (lane & 7) * 4;
#pragma unroll
    for (int i = 0; i < 8; ++i) { LAS float* d = scr + (8 * i + kr) * 33 + n4; d[0] = R.v[i][0] * R.sc[i]; d[1] = R.v[i][1] * R.sc[i]; d[2] = R.v[i][2] * R.sc[i]; d[3] = R.v[i][3] * R.sc[i]; }
    asm volatile("s_waitcnt lgkmcnt(0)" ::: "memory");
    const int c = lane & 7;
#pragma unroll
    for (int j = 0; j < 4; ++j) { const int n = (lane >> 3) + 8 * j; const LAS float* s = scr + (8 * c) * 33 + n;
        u32x4 o; o.x = cvt_pk_bf16(s[0 * 33], s[1 * 33]); o.y = cvt_pk_bf16(s[2 * 33], s[3 * 33]); o.z = cvt_pk_bf16(s[4 * 33], s[5 * 33]); o.w = cvt_pk_bf16(s[6 * 33], s[7 * 33]);
        *(u32x4*)(I.dst + (size_t)(I.drow0 + n) * I.K + I.k0 + 8 * c) = o; }
    asm volatile("s_waitcnt lgkmcnt(0)" ::: "memory");
}

__device__ __forceinline__ void mm128(const LAS unsigned char* A, const LAS unsigned char* B, int w, int fr, int fq, f32x4 (&acc)[8]) {
    bf16x8 bw[4];
#pragma unroll
    for (int ks = 0; ks < 4; ++ks) bw[ks] = *(const LAS bf16x8*)(B + (16 * w + fr) * 272 + ks * 64 + fq * 16);
#pragma unroll
    for (int ct = 0; ct < 8; ++ct) {
        f32x4 c = (f32x4){0.f, 0.f, 0.f, 0.f};
#pragma unroll
        for (int ks = 0; ks < 4; ++ks) { const bf16x8 a = *(const LAS bf16x8*)(A + (16 * ct + fr) * 272 + ks * 64 + fq * 16); c = mfma16(a, bw[ks], c); }
        acc[ct] = c;
    }
}

struct AttnRegs { u32x4 kv[4], vv[4]; bf16x8 q0, q1; };
__device__ __forceinline__ void attn_decode(int k, int xcd, int& g, int& j, int& sh, int& r, int& n) {
    g = k >> 7; j = (k >> 5) & 3; const int rn = k & 31; sh = 2 * g; r = rn >> (5 - sh); n = rn & ((32 >> sh) - 1); (void)xcd;
}
__device__ __forceinline__ void attn_load(AttnRegs& R, const bf16_t* Z1, int k, int xcd, int tid, int w, int fr, int fq) {
    int g, j, sh, r, n; attn_decode(k, xcd, g, j, sh, r, n);
    const int colq = g * 256 + j * 64; const size_t tok_b = (size_t)xcd * SEQ + r;
#pragma unroll
    for (int it = 0; it < 4; ++it) {
        const int c = tid + NTHREADS * it; const int key = c & 255, dc = c >> 8;
        const int p = (n - 1) * 128 + key; const int pc = p < 0 ? 0 : p;
        const bf16_t* src = Z1 + (tok_b + ((size_t)pc << sh)) * ZP + colq + dc * 8;
        R.kv[it] = *(const u32x4*)(src + 768); R.vv[it] = *(const u32x4*)(src + 1536);
    }
    const bf16_t* qp = Z1 + (tok_b + ((size_t)(n * 128 + 16 * w + fr) << sh)) * ZP + colq;
    R.q0 = *(const bf16x8*)(qp + fq * 8); R.q1 = *(const bf16x8*)(qp + 32 + fq * 8);
}
__device__ __forceinline__ void attn_stage(const AttnRegs& R, LAS unsigned char* lds, int k, int xcd, int tid) {
    int g, j, sh, r, n; attn_decode(k, xcd, g, j, sh, r, n);
#pragma unroll
    for (int it = 0; it < 4; ++it) {
        const int c = tid + NTHREADS * it; const int key = c & 255, dc = c >> 8;
        const bool ok = ((n - 1) * 128 + key) >= 0; const u32x4 z = (u32x4){0u, 0u, 0u, 0u};
        const u32x4 kv = ok ? R.kv[it] : z, vv = ok ? R.vv[it] : z;
        *(LAS u32x4*)(lds + key * 144 + dc * 16) = kv;
        const int k32 = key & 31; const int pos = (key & ~31) + 8 * ((k32 & 15) >> 2) + 4 * (k32 >> 4) + (k32 & 3);
        LAS bf16_t* vt = (LAS bf16_t*)(lds + 36864) + (dc * 8) * 264 + pos;
        vt[0 * 264] = (bf16_t)(vv.x & 0xffffu); vt[1 * 264] = (bf16_t)(vv.x >> 16); vt[2 * 264] = (bf16_t)(vv.y & 0xffffu); vt[3 * 264] = (bf16_t)(vv.y >> 16);
        vt[4 * 264] = (bf16_t)(vv.z & 0xffffu); vt[5 * 264] = (bf16_t)(vv.z >> 16); vt[6 * 264] = (bf16_t)(vv.w & 0xffffu); vt[7 * 264] = (bf16_t)(vv.w >> 16);
    }
}
__device__ __forceinline__ void attn_compute(LAS unsigned char* lds, bf16_t* Z1, float* lse, int k, int xcd, bf16x8 q0, bf16x8 q1, int w, int fr, int fq, bool dostore = true) {
    int g, j, sh, r, n; attn_decode(k, xcd, g, j, sh, r, n);
    const int colq = g * 256 + j * 64; const size_t tok_b = (size_t)xcd * SEQ + r; const int qi = 16 * w + fr;
    bf16_t* qp = Z1 + (tok_b + ((size_t)(n * 128 + qi) << sh)) * ZP + colq;
    const int kt0 = (w < 6 ? w : 6) & ~1;
    f32x4 s[10];
#pragma unroll
    for (int t = 0; t < 10; ++t) {
        const LAS unsigned char* kp = lds + (16 * (kt0 + t) + fr) * 144 + fq * 16;
        const bf16x8 a0 = *(const LAS bf16x8*)kp, a1 = *(const LAS bf16x8*)(kp + 64);
        s[t] = mfma16(a0, q0, (f32x4){0.f, 0.f, 0.f, 0.f}); s[t] = mfma16(a1, q1, s[t]);
    }
    constexpr float L2E = 1.4426950408889634f;
    float mx = -1e30f;
#pragma unroll
    for (int t = 0; t < 10; ++t)
#pragma unroll
        for (int i = 0; i < 4; ++i) {
            const int kj = 16 * (kt0 + t) + 4 * fq + i; const int dist = qi + 128 - kj;
            const bool valid = (dist >= 0) && (dist <= 128) && !(n == 0 && kj < 128);
            const float v = valid ? s[t][i] * L2E : -1e30f; s[t][i] = v; mx = fmaxf(mx, v);
        }
    mx = fmaxf(mx, __shfl_xor(mx, 16)); mx = fmaxf(mx, __shfl_xor(mx, 32));
    float l = 0.f;
#pragma unroll
    for (int t = 0; t < 10; ++t)
#pragma unroll
        for (int i = 0; i < 4; ++i) { const float p = __builtin_amdgcn_exp2f(s[t][i] - mx); s[t][i] = p; l += p; }
    l += __shfl_xor(l, 16); l += __shfl_xor(l, 32);
    f32x4 o[4];
#pragma unroll
    for (int dt = 0; dt < 4; ++dt) o[dt] = (f32x4){0.f, 0.f, 0.f, 0.f};
#pragma unroll
    for (int G = 0; G < 5; ++G) {
        u32x4 pw; pw.x = cvt_pk_bf16(s[2 * G][0], s[2 * G][1]); pw.y = cvt_pk_bf16(s[2 * G][2], s[2 * G][3]); pw.z = cvt_pk_bf16(s[2 * G + 1][0], s[2 * G + 1][1]); pw.w = cvt_pk_bf16(s[2 * G + 1][2], s[2 * G + 1][3]);
        const bf16x8 pb = __builtin_bit_cast(bf16x8, pw);
#pragma unroll
        for (int dt = 0; dt < 4; ++dt) {
            const bf16x8 va = *(const LAS bf16x8*)(lds + 36864 + (16 * dt + fr) * 528 + (32 * (kt0 / 2 + G) + 8 * fq) * 2);
            o[dt] = mfma16(va, pb, o[dt]);
        }
    }
    const float rl = 1.0f / l;
    if (!dostore) { if (rl == 123.456f) lse[0] = o[0][0] + o[1][1] + o[2][2] + o[3][3]; return; }
#pragma unroll
    for (int dt = 0; dt < 4; ++dt) { u32x2 wv; wv.x = cvt_pk_bf16(o[dt][0] * rl, o[dt][1] * rl); wv.y = cvt_pk_bf16(o[dt][2] * rl, o[dt][3] * rl); *(u32x2*)(qp + 16 * dt + 4 * fq) = wv; }
    if (fq == 0) lse[(size_t)((g * 4 + j) * 8 + xcd) * SEQ + r * (SEQ >> sh) + n * 128 + qi] = (mx + __log2f(l)) * 0.6931471805599453f;
}
__device__ __forceinline__ void attn_phase(LAS unsigned char* lds, bf16_t* Z1, float* lse, int xcd, int slot, int nslot, int tid, bool dostore = true) {
    asm volatile("" : "+v"(tid));
    const int lane = tid & 63, w = __builtin_amdgcn_readfirstlane(tid >> 6), fr = lane & 15, fq = lane >> 4;
    int k = slot; if (k >= 384) return;
    AttnRegs R0, R1; attn_load(R0, Z1, k, xcd, tid, w, fr, fq);
    for (;;) {
        const int k1 = k + nslot;
        if (k1 < 384) attn_load(R1, Z1, k1, xcd, tid, w, fr, fq);
        attn_stage(R0, lds, k, xcd, tid);
        __syncthreads();
        attn_compute(lds, Z1, lse, k, xcd, R0.q0, R0.q1, w, fr, fq, dostore);
        __syncthreads();
        if (k1 >= 384) break;
        const int k2 = k1 + nslot;
        if (k2 < 384) attn_load(R0, Z1, k2, xcd, tid, w, fr, fq);
        attn_stage(R1, lds, k1, xcd, tid);
        __syncthreads();
        attn_compute(lds, Z1, lse, k1, xcd, R1.q0, R1.q1, w, fr, fq, dostore);
        __syncthreads();
        if (k2 >= 384) break;
        k = k2;
    }
}

__device__ __forceinline__ void gate_unit(LAS unsigned char* lds, const bf16_t* Z1, bf16_t* yb, const bf16_t* wsT, const float* lng, const float* lnb, const float* bbs, int ch, int tid) {
    asm volatile("" : "+v"(tid));
    const int lane = tid & 63, w = __builtin_amdgcn_readfirstlane(tid >> 6), fr = lane & 15, fq = lane >> 4;
    const size_t t0 = (size_t)ch * 128;
    LAS float* st = (LAS float*)lds;
    {
        u32x4 raw[16]; float sm[16], mean[16], q[16];
        const bf16_t* vp = Z1 + (t0 + 16 * w) * ZP + 2816 + lane * 8;
#pragma unroll
        for (int i = 0; i < 16; ++i) raw[i] = *(const u32x4*)(vp + (size_t)i * ZP);
#pragma unroll
        for (int i = 0; i < 16; ++i) sm[i] = ((bf_lo(raw[i].x) + bf_hi(raw[i].x)) + (bf_lo(raw[i].y) + bf_hi(raw[i].y))) + ((bf_lo(raw[i].z) + bf_hi(raw[i].z)) + (bf_lo(raw[i].w) + bf_hi(raw[i].w)));
#pragma unroll
        for (int o = 1; o < 64; o <<= 1)
#pragma unroll
            for (int i = 0; i < 16; ++i) sm[i] += __shfl_xor(sm[i], o);
#pragma unroll
        for (int i = 0; i < 16; ++i) { mean[i] = sm[i] * (1.0f / 512.0f); const float m_ = mean[i];
            const float d0 = bf_lo(raw[i].x) - m_, d1 = bf_hi(raw[i].x) - m_, d2 = bf_lo(raw[i].y) - m_, d3 = bf_hi(raw[i].y) - m_, d4 = bf_lo(raw[i].z) - m_, d5 = bf_hi(raw[i].z) - m_, d6 = bf_lo(raw[i].w) - m_, d7 = bf_hi(raw[i].w) - m_;
            q[i] = ((d0 * d0 + d1 * d1) + (d2 * d2 + d3 * d3)) + ((d4 * d4 + d5 * d5) + (d6 * d6 + d7 * d7)); }
#pragma unroll
        for (int o = 1; o < 64; o <<= 1)
#pragma unroll
            for (int i = 0; i < 16; ++i) q[i] += __shfl_xor(q[i], o);
        if (lane < 16) {
            float mm = mean[0], qq = q[0];
#pragma unroll
            for (int i = 1; i < 16; ++i) { mm = (lane == i) ? mean[i] : mm; qq = (lane == i) ? q[i] : qq; }
            st[2 * (16 * w + lane)] = mm; st[2 * (16 * w + lane) + 1] = rsqrtf(qq * (1.0f / 512.0f) + 1e-6f);
        }
    }
    __syncthreads();
    const int t = 16 * w + fr;
    for (int g = 0; g < 4; ++g) {
        u32x4 wv[4], vv[4]; u32x2 uu[8]; f32x4 lg[4][2], lb[4][2];
#pragma unroll
        for (int it = 0; it < 4; ++it) {
            const int c = tid + NTHREADS * it;
            wv[it] = *(const u32x4*)(wsT + (size_t)(g * 128 + (c >> 4)) * 128 + (c & 15) * 8);
            const int sidx = c & 127, c8 = c >> 7; const int chn = g * 128 + c8 * 8;
            vv[it] = *(const u32x4*)(Z1 + (t0 + sidx) * ZP + 2816 + chn);
            lg[it][0] = *(const f32x4*)(lng + chn); lg[it][1] = *(const f32x4*)(lng + chn + 4); lb[it][0] = *(const f32x4*)(lnb + chn); lb[it][1] = *(const f32x4*)(lnb + chn + 4);
        }
#pragma unroll
        for (int ct = 0; ct < 8; ++ct) uu[ct] = *(const u32x2*)(Z1 + (t0 + t) * ZP + 2304 + g * 128 + 16 * ct + 4 * fq);
        const float bias = bbs[g * 128 + t];
#pragma unroll
        for (int it = 0; it < 4; ++it) {
            const int c = tid + NTHREADS * it;
            *(LAS u32x4*)(lds + 1024 + (c >> 4) * 272 + (c & 15) * 16) = wv[it];
            const int sidx = c & 127, c8 = c >> 7; const u32x4 raw = vv[it];
            const float mean = st[2 * sidx], rstd = st[2 * sidx + 1];
            const float x[8] = {bf_lo(raw.x), bf_hi(raw.x), bf_lo(raw.y), bf_hi(raw.y), bf_lo(raw.z), bf_hi(raw.z), bf_lo(raw.w), bf_hi(raw.w)};
            const float gg[8] = {lg[it][0][0], lg[it][0][1], lg[it][0][2], lg[it][0][3], lg[it][1][0], lg[it][1][1], lg[it][1][2], lg[it][1][3]};
            const float bb[8] = {lb[it][0][0], lb[it][0][1], lb[it][0][2], lb[it][0][3], lb[it][1][0], lb[it][1][1], lb[it][1][2], lb[it][1][3]};
            LAS bf16_t* vt = (LAS bf16_t*)(lds + 35840) + (c8 * 8) * 136 + sidx;
#pragma unroll
            for (int e = 0; e < 8; e += 2) { const unsigned pk = cvt_pk_bf16((x[e] - mean) * rstd * gg[e] + bb[e], (x[e + 1] - mean) * rstd * gg[e + 1] + bb[e + 1]); vt[e * 136] = (bf16_t)(pk & 0xffffu); vt[(e + 1) * 136] = (bf16_t)(pk >> 16); }
        }
        __syncthreads();
        f32x4 acc[8];
        mm128(lds + 35840, lds + 1024, w, fr, fq, acc);
#pragma unroll
        for (int ct = 0; ct < 8; ++ct) {
            const int chn = g * 128 + 16 * ct + 4 * fq; const u32x2 u2 = uu[ct];
            u32x2 o; o.x = cvt_pk_bf16(bf_lo(u2.x) * (acc[ct][0] + bias), bf_hi(u2.x) * (acc[ct][1] + bias)); o.y = cvt_pk_bf16(bf_lo(u2.y) * (acc[ct][2] + bias), bf_hi(u2.y) * (acc[ct][3] + bias));
            *(u32x2*)(yb + (t0 + t) * 512 + chn) = o;
        }
        __syncthreads();
    }
}

struct PoolRegs { u32x4 xr[5], wr4[4]; };
__device__ __forceinline__ void pool_load(PoolRegs& R, const bf16_t* Z1, const bf16_t* wcT, int unit, int tid) {
    const int tile = unit >> 2, gi = unit & 3; const size_t t0 = (size_t)tile * 128; const int tpos0 = (int)(t0 & (SEQ - 1));
#pragma unroll
    for (int it = 0; it < 5; ++it) {
        const int c = tid + NTHREADS * it; const int row = c >> 4, c8 = c & 15; const int tt = row - 15;
        const bool ok = (c < 143 * 16) && (tpos0 + tt >= 0);
        const long trow = ok ? ((long)t0 + tt) : (long)t0;
        R.xr[it] = *(const u32x4*)(Z1 + (size_t)trow * ZP + 3328 + gi * 128 + c8 * 8);
    }
#pragma unroll
    for (int it = 0; it < 4; ++it) { const int c = tid + NTHREADS * it; R.wr4[it] = *(const u32x4*)(wcT + (size_t)(gi * 128 + (c >> 4)) * 128 + (c & 15) * 8); }
}
__device__ __forceinline__ void pool_stage(const PoolRegs& R, LAS unsigned char* lds, int unit, int tid) {
    const int tile = unit >> 2; const size_t t0 = (size_t)tile * 128; const int tpos0 = (int)(t0 & (SEQ - 1));
#pragma unroll
    for (int it = 0; it < 5; ++it) { const int c = tid + NTHREADS * it; const int tt = (c >> 4) - 15; const bool ok = (tpos0 + tt >= 0);
        if (c < 143 * 16) *(LAS u32x4*)(lds + (c >> 4) * 272 + (c & 15) * 16) = ok ? R.xr[it] : (u32x4){0u, 0u, 0u, 0u}; }
#pragma unroll
    for (int it = 0; it < 4; ++it) { const int c = tid + NTHREADS * it; *(LAS u32x4*)(lds + 73728 + (c >> 4) * 272 + (c & 15) * 16) = R.wr4[it]; }
}
__device__ __forceinline__ void pool_compute(LAS unsigned char* lds, bf16_t* yc, const float* cscale, int unit, int tid, int w, int fr, int fq) {
    const int tile = unit >> 2, gi = unit & 3; const size_t t0 = (size_t)tile * 128; const int tpos0 = (int)(t0 & (SEQ - 1)); const int win = 2 << gi;
#pragma unroll
    for (int it = 0; it < 4; ++it) {
        const int c = tid + NTHREADS * it; const int t = c >> 4, c8 = c & 15;
        const int cnt = (tpos0 + t + 1 < win) ? (tpos0 + t + 1) : win;
        float sm[8] = {0.f, 0.f, 0.f, 0.f, 0.f, 0.f, 0.f, 0.f};
        for (int i = 0; i < cnt; ++i) { const u32x4 raw = *(const LAS u32x4*)(lds + (t + 15 - i) * 272 + c8 * 16);
            sm[0] += bf_lo(raw.x); sm[1] += bf_hi(raw.x); sm[2] += bf_lo(raw.y); sm[3] += bf_hi(raw.y); sm[4] += bf_lo(raw.z); sm[5] += bf_hi(raw.z); sm[6] += bf_lo(raw.w); sm[7] += bf_hi(raw.w); }
        const u32x4 xt = *(const LAS u32x4*)(lds + (t + 15) * 272 + c8 * 16); const float ic = 1.0f / (float)cnt;
        u32x4 o; o.x = cvt_pk_bf16(sm[0] * ic - bf_lo(xt.x), sm[1] * ic - bf_hi(xt.x)); o.y = cvt_pk_bf16(sm[2] * ic - bf_lo(xt.y), sm[3] * ic - bf_hi(xt.y));
        o.z = cvt_pk_bf16(sm[4] * ic - bf_lo(xt.z), sm[5] * ic - bf_hi(xt.z)); o.w = cvt_pk_bf16(sm[6] * ic - bf_lo(xt.w), sm[7] * ic - bf_hi(xt.w));
        *(LAS u32x4*)(lds + 38912 + t * 272 + c8 * 16) = o;
    }
    __syncthreads();
    f32x4 acc[8];
    mm128(lds + 73728, lds + 38912, w, fr, fq, acc);
    const int t = 16 * w + fr;
#pragma unroll
    for (int dt = 0; dt < 8; ++dt) {
        const int d = gi * 128 + 16 * dt + 4 * fq; const f32x4 sc = *(const f32x4*)(cscale + d);
        u32x2 o; o.x = cvt_pk_bf16(acc[dt][0] * sc[0], acc[dt][1] * sc[1]); o.y = cvt_pk_bf16(acc[dt][2] * sc[2], acc[dt][3] * sc[3]);
        *(u32x2*)(yc + (t0 + t) * 512 + d) = o;
    }
}
__device__ __forceinline__ void pool_phase(LAS unsigned char* lds, const bf16_t* Z1, bf16_t* yc, const bf16_t* wcT, const float* cscale, int xcd, int slot, int nslot, int tid) {
    asm volatile("" : "+v"(tid));
    const int lane = tid & 63, w = __builtin_amdgcn_readfirstlane(tid >> 6), fr = lane & 15, fq = lane >> 4;
    int k = slot; if (k >= 128) return;
    PoolRegs R; pool_load(R, Z1, wcT, xcd * 128 + k, tid);
    for (;;) {
        pool_stage(R, lds, xcd * 128 + k, tid);
        __syncthreads();
        const int kn = k + nslot;
        if (kn < 128) pool_load(R, Z1, wcT, xcd * 128 + kn, tid);
        pool_compute(lds, yc, cscale, xcd * 128 + k, tid, w, fr, fq);
        __syncthreads();
        if (kn >= 128) break;
        k = kn;
    }
}

typedef unsigned v4u __attribute__((ext_vector_type(4)));
#define XB_TMO      128
#define XB_XCNT(j)  (256  + 64 * (j))
#define XB_XSUB(j)  (1280 + 64 * (j))
#define XB_XGEN(j)  (2304 + 64 * (j))
#define XB_TOP      3328
#define XB_TOPGEN   3392
#define XCD_BAR_WORDS 3456
#define XB_SPIN_CAP (1u << 18)

__device__ __forceinline__ unsigned xb_ld(unsigned* p)              { return __hip_atomic_load(p, __ATOMIC_RELAXED, __HIP_MEMORY_SCOPE_AGENT); }
__device__ __forceinline__ unsigned xb_add(unsigned* p, unsigned v) { return __hip_atomic_fetch_add(p, v, __ATOMIC_RELAXED, __HIP_MEMORY_SCOPE_AGENT); }
__device__ __forceinline__ unsigned xb_xcc_id() { return (unsigned)__builtin_amdgcn_s_getreg((3 << 11) | 20) & 0xFu; }
#define XB_SPIN(cond, bar) do { unsigned _sp = 0; while (cond) { __builtin_amdgcn_s_sleep(1); \
    if ((++_sp & 255u) == 0u) { if (xb_ld(&(bar)[XB_TMO])) break; if (_sp > XB_SPIN_CAP) { atomicAdd(&(bar)[XB_TMO], 1u); break; } } } } while (0)

struct XcdBarrier {
    unsigned* bar; unsigned x;
    volatile LAS unsigned* st;
};

__device__ __forceinline__ XcdBarrier xcd_barrier_post(unsigned* bar, volatile LAS unsigned* st) {
    XcdBarrier b; b.bar = bar; b.x = xb_xcc_id(); b.st = st;
    if (threadIdx.x == 0) (void)xb_add(&bar[XB_XCNT(b.x)], 1u);
    return b;
}
__device__ __forceinline__ void xcd_barrier_complete(unsigned* bar, unsigned x, unsigned& nloc, unsigned& nx) {
    const unsigned G = gridDim.x * gridDim.y * gridDim.z;
    unsigned sum, cnt, mine, sp = 0u;
    for (;;) {
        sum = 0u; cnt = 0u; mine = 0u;
#pragma unroll
        for (unsigned j = 0; j < 16; ++j) { const unsigned c = xb_ld(&bar[XB_XCNT(j)]); sum += c; cnt += (c > 0u) ? 1u : 0u; mine = (j == x) ? c : mine; }
        if (sum == G) break;
        __builtin_amdgcn_s_sleep(1);
        if ((++sp & 255u) == 0u) { if (xb_ld(&bar[XB_TMO])) break; if (sp > XB_SPIN_CAP) { atomicAdd(&bar[XB_TMO], 1u); break; } }
    }
    nloc = mine > 0u ? mine : 1u; nx = cnt > 0u ? cnt : 1u;
}

__device__ __forceinline__ void xcd_barrier(const XcdBarrier& b) {
    asm volatile("s_waitcnt vmcnt(0)" ::: "memory");
    __syncthreads();
    if (threadIdx.x == 0) {
        unsigned* bar = b.bar;
        __builtin_amdgcn_s_waitcnt(0);
        unsigned nloc = b.st[0], nx = b.st[1];
        if (nloc == 0u) { xcd_barrier_complete(bar, b.x, nloc, nx); b.st[0] = nloc; b.st[1] = nx; }
        const unsigned old = xb_add(&bar[XB_XSUB(b.x)], 1u);
        const unsigned gen = old / nloc;
        if (old + 1u == (gen + 1u) * nloc) {
            __builtin_amdgcn_fence(__ATOMIC_RELEASE, "agent");
            asm volatile("s_waitcnt vmcnt(0)" ::: "memory");
            const unsigned og = xb_add(&bar[XB_TOP], 1u);
            const unsigned tg = og / nx;
            if (og + 1u == (tg + 1u) * nx) xb_add(&bar[XB_TOPGEN], 1u);
            else XB_SPIN(xb_ld(&bar[XB_TOPGEN]) == tg, bar);
            __builtin_amdgcn_fence(__ATOMIC_ACQUIRE, "agent");
            xb_add(&bar[XB_XGEN(b.x)], 1u);
            asm volatile("s_waitcnt vmcnt(0)" ::: "memory");
        } else {
            XB_SPIN(xb_ld(&bar[XB_XGEN(b.x)]) == gen, bar);
            __builtin_amdgcn_fence(__ATOMIC_ACQUIRE, "agent");
            asm volatile("s_waitcnt vmcnt(0)" ::: "memory");
        }
    }
    __syncthreads();
}


__device__ __forceinline__ void grid_seam(unsigned* bar, unsigned target) {
    asm volatile("s_waitcnt vmcnt(0) lgkmcnt(0)" ::: "memory");
    __syncthreads();
    if (threadIdx.x == 0) {
        __builtin_amdgcn_fence(__ATOMIC_RELEASE, "agent"); asm volatile("s_waitcnt vmcnt(0)" ::: "memory");
        __hip_atomic_fetch_add(bar, 1u, __ATOMIC_RELAXED, __HIP_MEMORY_SCOPE_AGENT);
        unsigned spins = 0;
        while (__hip_atomic_load(bar, __ATOMIC_RELAXED, __HIP_MEMORY_SCOPE_AGENT) < target) { __builtin_amdgcn_s_sleep(2); if (++spins > (1u << 24)) break; }
        __builtin_amdgcn_fence(__ATOMIC_ACQUIRE, "agent"); asm volatile("s_waitcnt vmcnt(0)" ::: "memory");
    }
    __syncthreads();
}

__device__ __forceinline__ float* rowss_arr(float* dout, unsigned char* ws, int k) { return k < 6 ? dout + (size_t)k * NT * 16 : (float*)(ws + WS_RS6); }
#ifndef MK_WITH_MEMSET
#define MK_NO_MEMSET 1
#endif
#ifndef MK_ALIGN
#define MK_ALIGN true
#endif
#ifndef MK_SP2
#define MK_SP2 true
#endif
#ifndef MK_LOCAL_SEAMS
#define SEAM_LOCAL() SEAM()
#else
#define SEAM_LOCAL() grid_seam((unsigned*)(a.ws + WS_BAR) + 4096 + 64 * (bid & 7), nseam_local_ += (unsigned)(G >> 3))
#endif
#ifdef MK_FLAT_BAR
#define SEAM() grid_seam((unsigned*)(a.ws + WS_BAR) + 4096, nseam * (unsigned)G)
#else
#define SEAM() xcd_barrier(xbar)
#endif
struct Args { const float* in[23]; float* out; unsigned char* ws; int ph_lo, ph_hi; };

__device__ __forceinline__ void titem_desc(TItem& I, const Args& a, bf16_t* Wb, bf16_t* wcT, int it0) {
    I.ksc = nullptr; I.cs = 1.f; int map = 0, it;
    if (it0 < 2 * 13056) {
        const int l = it0 >= 13056 ? 1 : 0; const int r = it0 - l * 13056; bf16_t* Wl = Wb + (size_t)l * W_LAYER;
        if (r < 1408)       { it = r;         I.src = a.in[2] + (size_t)l * DM * FF; I.K = DM; I.N = FF; I.dst = Wl + WO_GU1; I.ksc = a.in[1] + l * DM; map = 1; }
        else if (r < 2816)  { it = r - 1408;  I.src = a.in[3] + (size_t)l * DM * FF; I.K = DM; I.N = FF; I.dst = Wl + WO_GU1; I.ksc = a.in[1] + l * DM; map = 2; }
        else if (r < 4224)  { it = r - 2816;  I.src = a.in[4] + (size_t)l * DM * FF; I.K = FF; I.N = DM; I.dst = Wl + WO_D1; I.cs = 0.5f; }
        else if (r < 7680)  { it = r - 4224;  I.src = a.in[6] + (size_t)l * DM * 6912; I.K = DM; I.N = 6912; I.dst = Wl + WO_IN; I.ksc = a.in[5] + l * DM; }
        else if (r < 7808)  { it = r - 7680;  I.src = a.in[14] + (size_t)l * 256 * DM; I.K = 256; I.N = DM; I.dst = Wl + WO_PA; }
        else if (r < 8064)  { it = r - 7808;  I.src = a.in[15] + (size_t)l * 512 * DM; I.K = 512; I.N = DM; I.dst = Wl + WO_PB; }
        else if (r < 8320)  { it = r - 8064;  I.src = a.in[16] + (size_t)l * 512 * DM; I.K = 512; I.N = DM; I.dst = Wl + WO_PC; }
        else if (r < 8832)  { it = r - 8320;  I.src = a.in[17] + (size_t)l * DM * DM; I.K = DM; I.N = DM; I.dst = Wl + WO_OUT; }
        else if (r < 10240) { it = r - 8832;  I.src = a.in[19] + (size_t)l * DM * FF; I.K = DM; I.N = FF; I.dst = Wl + WO_GU2; I.ksc = a.in[18] + l * DM; map = 1; }
        else if (r < 11648) { it = r - 10240; I.src = a.in[20] + (size_t)l * DM * FF; I.K = DM; I.N = FF; I.dst = Wl + WO_GU2; I.ksc = a.in[18] + l * DM; map = 2; }
        else                { it = r - 11648; I.src = a.in[21] + (size_t)l * DM * FF; I.K = FF; I.N = DM; I.dst = Wl + WO_D2; I.cs = 0.5f; }
    } else { const int q = (it0 - 2 * 13056) >> 3; it = (it0 - 2 * 13056) & 7; I.src = a.in[12] + (size_t)q * 16384; I.K = 128; I.N = 128; I.dst = wcT + (size_t)q * 16384; }
    const int nblk = I.N / 32; const int kb = it / nblk, nb = it % nblk; I.n0 = 32 * nb; I.k0 = 64 * kb;
    I.drow0 = (map == 0) ? I.n0 : ((I.n0 >> 7) * 256 + (I.n0 & 127) + (map == 2 ? 128 : 0));
}

__global__ void __launch_bounds__(NTHREADS, 2) mega_fwd(Args a) {
    extern __shared__ __attribute__((aligned(16))) unsigned char lds_raw[];
    cg::grid_group grid = cg::this_grid();
    LAS unsigned char* lds = (LAS unsigned char*)lds_raw;
    const int G = gridDim.x, bid = blockIdx.x;
    const int ph_lo = a.ph_lo, ph_hi = a.ph_hi;
    volatile LAS unsigned* bst = (volatile LAS unsigned*)(lds + LDS_STAGE);
    if (threadIdx.x < 2) bst[threadIdx.x] = 0u;
#ifdef MK_NO_MEMSET
    if (ph_hi - ph_lo == 26) {
        if (blockIdx.x == 0) { for (int i = threadIdx.x; i < 8192; i += NTHREADS) __hip_atomic_store((unsigned*)(a.ws + WS_BAR) + i, 0u, __ATOMIC_RELAXED, __HIP_MEMORY_SCOPE_AGENT); asm volatile("s_waitcnt vmcnt(0)" ::: "memory"); }
        __syncthreads();
        grid.sync();
    }
#endif
    __syncthreads();
    const XcdBarrier xbar = xcd_barrier_post((unsigned*)(a.ws + WS_BAR), bst);
#ifndef MK_NO_MEMSET
    if (ph_hi - ph_lo == 26) grid.sync();
#endif

    if (ph_lo <= 0) {
        int tid = threadIdx.x; asm volatile("" : "+v"(tid));
        const int lane = tid & 63, wave = __builtin_amdgcn_readfirstlane(tid >> 6);
        unsigned char* ws = a.ws;
        bf16_t* Wb = (bf16_t*)(ws + WS_W); bf16_t* wcT = (bf16_t*)(ws + WS_WCT); bf16_t* wsT = (bf16_t*)(ws + WS_WST); bf16_t* xb = (bf16_t*)(ws + WS_XB); float* rowss = rowss_arr(a.out, ws, 0);
        const int gw = bid * 8 + wave, NGW = G * 8;
        LAS float* scr = (LAS float*)(lds + wave * 16384);
        for (int it0 = gw; it0 < 2 * 13056 + 64; it0 += 2 * NGW) {
            TItem I0, I1; TRegs R0, R1;
            titem_desc(I0, a, Wb, wcT, it0);
            const int it1 = it0 + NGW; const bool two = it1 < 2 * 13056 + 64;
            titem_load(R0, I0, lane);
            if (two) { titem_desc(I1, a, Wb, wcT, it1); titem_load(R1, I1, lane); }
            titem_finish(R0, I0, scr, lane);
            if (two) titem_finish(R1, I1, scr, lane);
        }
        const int xcd = bid & 7, slot = bid >> 3, nslot = G >> 3;
        for (int i = bid * NTHREADS + tid; i < 2 * 4 * 128 * 128; i += G * NTHREADS) {
            const int t = (i >> 7) & 127, s = i & 127; const float v = (s <= t) ? a.in[10][i] : 0.f;
            wsT[i] = (bf16_t)(cvt_pk_bf16(v, 0.f) & 0xffffu);
        }
        const float* x = a.in[0];
        for (int m0 = xcd * SEQ + slot * 8 + wave; m0 < (xcd + 1) * SEQ; m0 += 4 * nslot * 8) {
            f32x4 v[4][4]; float ss[4];
#pragma unroll
            for (int q = 0; q < 4; ++q) { const int m = m0 + q * nslot * 8; const int mc = m < (xcd + 1) * SEQ ? m : m0; const f32x4* xr = (const f32x4*)(x + (size_t)mc * DM) + lane;
#pragma unroll
                for (int jj = 0; jj < 4; ++jj) v[q][jj] = xr[64 * jj]; }
#pragma unroll
            for (int q = 0; q < 4; ++q) { ss[q] = 0.f;
#pragma unroll
                for (int jj = 0; jj < 4; ++jj) ss[q] += (v[q][jj][0] * v[q][jj][0] + v[q][jj][1] * v[q][jj][1]) + (v[q][jj][2] * v[q][jj][2] + v[q][jj][3] * v[q][jj][3]); }
#pragma unroll
            for (int o = 1; o < 64; o <<= 1)
#pragma unroll
                for (int q = 0; q < 4; ++q) ss[q] += __shfl_xor(ss[q], o);
#pragma unroll
            for (int q = 0; q < 4; ++q) { const int m = m0 + q * nslot * 8; if (m < (xcd + 1) * SEQ) {
                u32x2* o8 = (u32x2*)(xb + (size_t)m * DM) + lane;
#pragma unroll
                for (int jj = 0; jj < 4; ++jj) { u32x2 o; o.x = cvt_pk_bf16(v[q][jj][0], v[q][jj][1]); o.y = cvt_pk_bf16(v[q][jj][2], v[q][jj][3]); o8[64 * jj] = o; }
                if (lane < 4) ((f32x4*)(rowss + (size_t)m * 16))[lane] = (f32x4){lane == 0 ? ss[q] : 0.f, 0.f, 0.f, 0.f}; } }
        }
    }
    unsigned nseam = 0, nseam_local_ = 0;
    if (ph_lo <= 0 && ph_hi > 1) { ++nseam; SEAM(); }

    for (int lst = 0; lst < 24; ++lst) {
        if (lst + 1 < ph_lo || lst + 1 >= ph_hi) continue;
        int lq = __builtin_amdgcn_readfirstlane(lst / 12), st = __builtin_amdgcn_readfirstlane(lst % 12), zoff = __builtin_amdgcn_readfirstlane(0);
        asm volatile("" : "+s"(lq), "+s"(st), "+s"(zoff));
        unsigned char* ws = a.ws + zoff;
        const int l = lq;
        bf16_t* RA = (bf16_t*)(ws + WS_A);
        const bf16_t* Wl = (const bf16_t*)(ws + WS_W) + (size_t)l * W_LAYER;
        bool isg = true, sync = true;
        pg8::Gemm g{nullptr, nullptr, NT, 0, 0};
        pg8::EpiMix e{}; e.mode = 0; e.rs = nullptr; e.aux = nullptr; e.ob = nullptr; e.ldo = 0;
        switch (st) {
            case 0: g.A = (bf16_t*)(ws + WS_XB); g.Bt = Wl + WO_GU1; g.N = 2 * FF; g.K = DM; e.mode = pg8::EM_SWIGLU; e.rs = rowss_arr(a.out, ws, 3 * l); e.ob = RA; e.ldo = FF; break;
            case 1: g.A = RA; g.Bt = Wl + WO_D1; g.N = DM; g.K = FF; e.mode = pg8::EM_RESID; e.aux = (l == 0) ? (const void*)a.in[0] : nullptr; e.ob = (bf16_t*)(ws + WS_XB); e.ldo = DM; e.rs = rowss_arr(a.out, ws, 3 * l + 1); break;
            case 2: g.A = (bf16_t*)(ws + WS_XB); g.Bt = Wl + WO_IN; g.N = ZP; g.K = DM; e.mode = pg8::EM_Z1; e.rs = rowss_arr(a.out, ws, 3 * l + 1); e.ob = RA; e.ldo = ZP; break;
            case 3: isg = false; break;
            case 4: isg = false; break;
            case 5: g.A = (bf16_t*)(ws + WS_XB); g.Bt = Wl + WO_IN + (size_t)ZP * DM; g.N = 3072; g.K = DM; e.mode = pg8::EM_GATE; e.rs = rowss_arr(a.out, ws, 3 * l + 1); e.aux = a.in[7] + l * 3072; e.ob = RA; e.ldo = 3072; break;
            case 6: g.A = (bf16_t*)(ws + WS_YA); g.Bt = Wl + WO_PA; g.N = DM; g.K = 256; e.mode = pg8::EM_PROJ0; e.aux = RA; e.ob = (bf16_t*)(ws + WS_MERGED); e.ldo = DM; sync = false; break;
            case 7: g.A = (bf16_t*)(ws + WS_YB); g.Bt = Wl + WO_PB; g.N = DM; g.K = 512; e.mode = pg8::EM_PROJ1; e.aux = RA + 1024; e.ob = (bf16_t*)(ws + WS_MERGED); e.ldo = DM; sync = false; break;
            case 8: g.A = (bf16_t*)(ws + WS_YC); g.Bt = Wl + WO_PC; g.N = DM; g.K = 512; e.mode = pg8::EM_PROJ1; e.aux = RA + 2048; e.ob = (bf16_t*)(ws + WS_MERGED); e.ldo = DM; break;
            case 9: g.A = (bf16_t*)(ws + WS_MERGED); g.Bt = Wl + WO_OUT; g.N = DM; g.K = DM; e.mode = pg8::EM_RESID; e.aux = nullptr; e.ob = (bf16_t*)(ws + WS_XB); e.ldo = DM; e.rs = rowss_arr(a.out, ws, 3 * l + 2); break;
            case 10: g.A = (bf16_t*)(ws + WS_XB); g.Bt = Wl + WO_GU2; g.N = 2 * FF; g.K = DM; e.mode = pg8::EM_SWIGLU; e.rs = rowss_arr(a.out, ws, 3 * l + 2); e.ob = RA; e.ldo = FF; break;
            default: g.A = RA; g.Bt = Wl + WO_D2; g.N = DM; g.K = FF; e.mode = pg8::EM_RESID; e.aux = nullptr; e.ob = (bf16_t*)(ws + WS_XB); e.ldo = DM; e.rs = rowss_arr(a.out, ws, 3 * l + 3); break;
        }
        if (isg) {
            pg8::StaticOrder S; S.init(NT, g.N, G, bid);
            pg8::gemm_phase<pg8::EpiMix, pg8::StaticOrder, MK_ALIGN, MK_SP2>(lds, g, S, e);
        } else if (st == 3) {
            const int tid = threadIdx.x;
            float* lse = (float*)(ws + WS_LSE);
            const int xcd = bid & 7, slot = bid >> 3, nslot = G >> 3;
            attn_phase(lds, RA, lse, xcd, slot, nslot, tid);
            for (int k = slot; k < 32; k += nslot) gate_unit(lds, RA, (bf16_t*)(ws + WS_YB), (const bf16_t*)(ws + WS_WST) + (size_t)l * 65536, a.in[8] + l * 512, a.in[9] + l * 512, a.in[11] + l * 512, xcd * 32 + k, tid);
            pool_phase(lds, RA, (bf16_t*)(ws + WS_YC), (const bf16_t*)(ws + WS_WCT) + (size_t)l * 65536, a.in[13] + l * 512, xcd, slot, nslot, tid);
        } else {
            int tid = threadIdx.x; asm volatile("" : "+v"(tid));
            const float* lse = (const float*)(ws + WS_LSE); bf16_t* ya = (bf16_t*)(ws + WS_YA);
            const int xcd = bid & 7, slot = bid >> 3, nslot = G >> 3;
            for (int i = xcd * (SEQ * 32) + slot * NTHREADS + tid; i < (xcd + 1) * (SEQ * 32); i += nslot * NTHREADS) {
                const int tok = i >> 5, j = (i >> 3) & 3, d8 = i & 7;
                const int bb = tok >> 12, tq = tok & (SEQ - 1);
                const float l0 = lse[(size_t)((0 * 4 + j) * 8 + bb) * SEQ + tq], l1 = lse[(size_t)((1 * 4 + j) * 8 + bb) * SEQ + (tq & 3) * (SEQ >> 2) + (tq >> 2)], l2 = lse[(size_t)((2 * 4 + j) * 8 + bb) * SEQ + (tq & 15) * (SEQ >> 4) + (tq >> 4)];
                const float mx = fmaxf(l0, fmaxf(l1, l2)); float e0 = __expf(l0 - mx), e1 = __expf(l1 - mx), e2 = __expf(l2 - mx); const float inv = 1.0f / (e0 + e1 + e2); e0 *= inv; e1 *= inv; e2 *= inv;
                const bf16_t* op = RA + (size_t)tok * ZP + j * 64 + d8 * 8;
                const u32x4 o0 = *(const u32x4*)op, o1 = *(const u32x4*)(op + 256), o2 = *(const u32x4*)(op + 512);
                u32x4 r;
                r.x = cvt_pk_bf16(e0 * bf_lo(o0.x) + e1 * bf_lo(o1.x) + e2 * bf_lo(o2.x), e0 * bf_hi(o0.x) + e1 * bf_hi(o1.x) + e2 * bf_hi(o2.x));
                r.y = cvt_pk_bf16(e0 * bf_lo(o0.y) + e1 * bf_lo(o1.y) + e2 * bf_lo(o2.y), e0 * bf_hi(o0.y) + e1 * bf_hi(o1.y) + e2 * bf_hi(o2.y));
                r.z = cvt_pk_bf16(e0 * bf_lo(o0.z) + e1 * bf_lo(o1.z) + e2 * bf_lo(o2.z), e0 * bf_hi(o0.z) + e1 * bf_hi(o1.z) + e2 * bf_hi(o2.z));
                r.w = cvt_pk_bf16(e0 * bf_lo(o0.w) + e1 * bf_lo(o1.w) + e2 * bf_lo(o2.w), e0 * bf_hi(o0.w) + e1 * bf_hi(o1.w) + e2 * bf_hi(o2.w));
                *(u32x4*)(ya + (size_t)tok * 256 + j * 64 + d8 * 8) = r;
            }
        }
        if (sync && lst + 2 < ph_hi) { ++nseam; if (st == 1 || st == 4 || st == 9) { SEAM(); } else { SEAM_LOCAL(); } }
    }
    if (ph_hi > 25) {
        int tid = threadIdx.x; asm volatile("" : "+v"(tid));
        const int lane = tid & 63, wave = __builtin_amdgcn_readfirstlane(tid >> 6);
        const float* fn = a.in[22]; const float* rs6 = (const float*)(a.ws + WS_RS6); float* X = a.out; const bf16_t* xb = (const bf16_t*)(a.ws + WS_XB);
        const int xcd = bid & 7, slot = bid >> 3, nslot = G >> 3;
        for (int m = xcd * SEQ + slot * 8 + wave; m < (xcd + 1) * SEQ; m += nslot * 8) {
            const float rs = pg8::rstd_of(rs6, m);
            const u32x4* xr = (const u32x4*)(xb + (size_t)m * DM) + lane; f32x4* orow = (f32x4*)(X + (size_t)m * DM) + 2 * lane; const f32x4* gr = (const f32x4*)fn + 2 * lane;
#pragma unroll
            for (int jj = 0; jj < 2; ++jj) { const u32x4 v = xr[64 * jj]; const f32x4 g0 = gr[128 * jj], g1 = gr[128 * jj + 1];
                f32x4 o0 = (f32x4){bf_lo(v.x), bf_hi(v.x), bf_lo(v.y), bf_hi(v.y)} * rs * g0, o1 = (f32x4){bf_lo(v.z), bf_hi(v.z), bf_lo(v.w), bf_hi(v.w)} * rs * g1;
                orow[128 * jj] = o0; orow[128 * jj + 1] = o1; }
        }
    }
}

extern "C" void kernel_launch(void* const* d_in, const int* in_sizes, int n_in, void* d_out, int out_size, void* d_ws, size_t ws_size, hipStream_t stream) {
    static int grid = 0;
    if (grid == 0) {
        if (n_in != 23 || in_sizes[0] != NT * DM || out_size != NT * DM || ws_size < WS_END) { fprintf(stderr, "kernel_launch: unexpected problem (n_in %d, in0 %d, out %d, ws %zu)\n", n_in, n_in > 0 ? in_sizes[0] : -1, out_size, ws_size); grid = -1; return; }
        int dev = 0, cus = 0, per_cu = 0;
        if (hipGetDevice(&dev) != hipSuccess || hipDeviceGetAttribute(&cus, hipDeviceAttributeMultiprocessorCount, dev) != hipSuccess) { grid = -1; return; }
        if (hipFuncSetAttribute((const void*)mega_fwd, hipFuncAttributeMaxDynamicSharedMemorySize, LDS_BYTES) != hipSuccess) { fprintf(stderr, "kernel_launch: hipFuncSetAttribute failed\n"); grid = -1; return; }
        if (hipOccupancyMaxActiveBlocksPerMultiprocessor(&per_cu, (const void*)mega_fwd, NTHREADS, LDS_BYTES) != hipSuccess || per_cu < 1) { fprintf(stderr, "kernel_launch: occupancy query says %d\n", per_cu); per_cu = 1; }
        (void)hipGetLastError();
        grid = cus & ~7;
    }
    if (grid < 0) return;
#ifndef MK_NO_MEMSET
    (void)hipMemsetAsync((char*)d_ws + WS_BAR, 0, 32768, stream);
#endif
    Args a{};
    for (int i = 0; i < 23; ++i) a.in[i] = (const float*)d_in[i];
    a.out = (float*)d_out; a.ws = (unsigned char*)d_ws;
#ifndef MK_N_LAUNCHES
#define MK_N_LAUNCHES 1
#endif
#if MK_N_LAUNCHES == 1
    a.ph_lo = 0; a.ph_hi = 26;
    void* args[] = {&a};
    hipError_t e = hipLaunchCooperativeKernel((const void*)mega_fwd, dim3(grid), dim3(NTHREADS), args, LDS_BYTES, stream);
    if (e != hipSuccess) fprintf(stderr, "cooperative launch failed: %s (grid %d)\n", hipGetErrorString(e), grid);
#else
    for (int ph = 0; ph < 26; ++ph) {
        int hi = ph + 1; const int stp = (ph >= 1 && ph <= 24) ? (ph - 1) % 12 : -1; if (stp == 6) hi = ph + 3;
        a.ph_lo = ph; a.ph_hi = hi;
        hipLaunchKernelGGL(mega_fwd, dim3(grid), dim3(NTHREADS), LDS_BYTES, stream, a);
        ph = hi - 1;
    }
#endif
}
```
